# Optimizing an MI355X kernel written in HIP

```python
import numpy as np
import jax
import jax.numpy as jnp
from jax import lax

D_MODEL = 2048
BATCH = 4
SEQ = 2048
DEPTH = 2

EPS = 1e-6
F32 = jnp.float32

MIX_WIDTH = D_MODEL
NSA_HEAD_DIM = 128
NSA_WIDTH = MIX_WIDTH // 2
NSA_HEADS = NSA_WIDTH // NSA_HEAD_DIM
NSA_KV_GROUPS = 2
NSA_HPG = NSA_HEADS // NSA_KV_GROUPS
KV_WIDTH = NSA_KV_GROUPS * NSA_HEAD_DIM
CMP_BLOCK = 32
CMP_STRIDE = 16
CMP_HIDDEN = 256
SLC_BLOCK = 64
SLC_TOPN = 16
N_LOCAL_FORCED = 2
WINDOW = 512
WIN_Q_BLOCK = 128
SLC_Q_BLOCK = 64
ROT_DIM = NSA_HEAD_DIM // 4
ROPE_THETA = 500000.0
MAX_POS_OFFSET = 1024
HGRN_WIDTH = MIX_WIDTH - NSA_WIDTH
HGRN_HEADS = 8
HGRN_VAL_DIM = HGRN_WIDTH // HGRN_HEADS
HGRN_KEY_DIM = 128
HGRN_FDIM = HGRN_HEADS * HGRN_KEY_DIM
HGRN_CHUNK = 64
IN_SPLITS = (NSA_WIDTH, KV_WIDTH, KV_WIDTH, KV_WIDTH, KV_WIDTH, KV_WIDTH, KV_WIDTH, 3 * NSA_HEADS, HGRN_FDIM, HGRN_FDIM, HGRN_WIDTH, HGRN_WIDTH)
IN_WIDTH = sum(IN_SPLITS)
PEER_HEADS = 8
PEER_N_KEYS = 128
PEER_N_EXPERTS = PEER_N_KEYS * PEER_N_KEYS
PEER_TOPK = 16
PEER_QUERY_DIM = 256
PEER_TOKEN_CHUNK = 128

kernel_name = 'hymba_nsa_hgrn2_peer_adaln_trunk'


def rms_norm(x, gain):
    xf = x.astype(F32)
    y = xf * lax.rsqrt(jnp.mean(xf * xf, axis=-1, keepdims=True) + EPS)
    return (y * gain.astype(F32)).astype(x.dtype)


def ada_modulate(x, gain, shift, scale):
    return rms_norm(x, gain) * (1.0 + scale[:, None, :]) + shift[:, None, :]


def rope_tables(positions):
    inv = ROPE_THETA ** (-jnp.arange(0, ROT_DIM, 2, dtype=F32) / ROT_DIM)
    ang = positions.astype(F32)[:, :, None] * inv
    return jnp.cos(ang)[:, :, None, :], jnp.sin(ang)[:, :, None, :]


def partial_rope(t, cos, sin):
    half = ROT_DIM // 2
    c = cos.astype(t.dtype)
    s = sin.astype(t.dtype)
    t1 = t[..., :half]
    t2 = t[..., half:ROT_DIM]
    return jnp.concatenate([t1 * c - t2 * s, t2 * c + t1 * s, t[..., ROT_DIM:]], axis=-1)


def compress_blocks(t, pos_emb, w1, b1, w2, b2):
    B, S, G, d = t.shape
    n_cmp = (S - CMP_BLOCK) // CMP_STRIDE + 1
    tok = np.arange(n_cmp)[:, None] * CMP_STRIDE + np.arange(CMP_BLOCK)[None, :]
    blk = t[:, tok] + pos_emb[None, None, :, None, :]
    flat = blk.transpose(0, 1, 3, 2, 4).reshape(B, n_cmp, G, CMP_BLOCK * d)
    return jax.nn.gelu(flat @ w1 + b1) @ w2 + b2


def cmp_to_slc_weights(n_cmp, n_slc):
    cs = np.arange(n_cmp) * CMP_STRIDE
    ce = cs + CMP_BLOCK
    ss = np.arange(n_slc) * SLC_BLOCK
    se = ss + SLC_BLOCK
    ov = np.clip(np.minimum(ce[:, None], se[None, :]) - np.maximum(cs[:, None], ss[None, :]), 0, None)
    return (ov / CMP_BLOCK).astype(np.float32)


def nsa_compressed(q, kc, vc):
    B, S, H, d = q.shape
    n_cmp = kc.shape[1]
    qg = q.reshape(B, S, NSA_KV_GROUPS, NSA_HPG, d)
    s = jnp.einsum('bsghd,bngd->bghsn', qg, kc, preferred_element_type=F32) * (d ** -0.5)
    valid = (np.arange(n_cmp) * CMP_STRIDE + CMP_BLOCK - 1)[None, :] <= np.arange(S)[:, None]
    s = jnp.where(valid, s, -jnp.inf)
    m = jnp.max(s, axis=-1, keepdims=True)
    m = jnp.where(jnp.isfinite(m), m, 0.0)
    e = jnp.where(valid, jnp.exp(s - m), 0.0)
    p = e / jnp.maximum(jnp.sum(e, axis=-1, keepdims=True), 1e-30)
    o = jnp.einsum('bghsn,bngd->bsghd', p.astype(vc.dtype), vc).reshape(B, S, H, d)
    return o, p


def nsa_select(p_cmp, S):
    n_cmp = p_cmp.shape[-1]
    n_slc = S // SLC_BLOCK
    w = jnp.asarray(cmp_to_slc_weights(n_cmp, n_slc))
    imp = jnp.einsum('bghsn,nj->bgsj', p_cmp, w)
    t = np.arange(S)[:, None]
    j = np.arange(n_slc)[None, :]
    causal = j * SLC_BLOCK <= t
    back = t // SLC_BLOCK - j
    forced = (j == 0) | ((back >= 0) & (back < N_LOCAL_FORCED))
    score = jnp.where(forced, jnp.inf, jnp.where(causal, imp, -jnp.inf))
    _, idx = lax.top_k(score, min(SLC_TOPN, n_slc))
    return idx


def nsa_selected(qr, ks, vs, idx):
    B, S, H, d = qr.shape
    G, HPG, L, C = NSA_KV_GROUPS, NSA_HPG, SLC_BLOCK, SLC_Q_BLOCK
    n_slc = S // L
    n_sel = idx.shape[-1]
    nqc = S // C
    k_blk = ks.reshape(B, n_slc, L, G, d).transpose(0, 3, 1, 2, 4)
    v_blk = vs.reshape(B, n_slc, L, G, d).transpose(0, 3, 1, 2, 4)
    q_ch = qr.reshape(B, nqc, C, G, HPG, d).transpose(1, 0, 3, 4, 2, 5)
    i_ch = idx.reshape(B, G, nqc, C, n_sel).transpose(2, 0, 1, 3, 4)
    starts = jnp.arange(nqc, dtype=jnp.int32) * C
    bi = jnp.arange(B)[:, None, None, None]
    gi = jnp.arange(G)[None, :, None, None]
    offs = jnp.arange(L, dtype=jnp.int32)
    qoff = jnp.arange(C, dtype=jnp.int32)

    def block(args):
        qc, ic, st = args
        kg = k_blk[bi, gi, ic]
        vg = v_blk[bi, gi, ic]
        s = jnp.einsum('bghqd,bgqnld->bghqnl', qc, kg, preferred_element_type=F32) * (d ** -0.5)
        kpos = ic[..., None] * L + offs
        ok = kpos <= (st + qoff)[None, None, :, None, None]
        s = jnp.where(ok[:, :, None], s, -jnp.inf)
        p = jax.nn.softmax(s.reshape(B, G, HPG, C, n_sel * L), axis=-1).reshape(s.shape)
        return jnp.einsum('bghqnl,bgqnld->bghqd', p.astype(vg.dtype), vg)

    o = lax.map(block, (q_ch, i_ch, starts))
    return o.transpose(1, 0, 4, 2, 3, 5).reshape(B, S, H, d)


def nsa_window(qr, kw, vw):
    B, S, H, d = qr.shape
    G, HPG, QB = NSA_KV_GROUPS, NSA_HPG, WIN_Q_BLOCK
    nb = S // QB
    wb = WINDOW // QB
    KW = (wb + 1) * QB
    pad = ((0, 0), (wb * QB, 0), (0, 0), (0, 0))
    kp = jnp.pad(kw, pad).reshape(B, nb + wb, QB, G, d)
    vp = jnp.pad(vw, pad).reshape(B, nb + wb, QB, G, d)
    band = np.arange(nb)[:, None] + np.arange(wb + 1)[None, :]
    kb = kp[:, band].reshape(B, nb, KW, G, d)
    vb = vp[:, band].reshape(B, nb, KW, G, d)
    qb = qr.reshape(B, nb, QB, G, HPG, d)
    s = jnp.einsum('bnqghd,bnkgd->bnghqk', qb, kb, preferred_element_type=F32) * (d ** -0.5)
    qpos = np.arange(nb)[:, None] * QB + np.arange(QB)[None, :]
    kpos = (np.arange(nb)[:, None] - wb) * QB + np.arange(KW)[None, :]
    diff = qpos[:, :, None] - kpos[:, None, :]
    ok = (diff >= 0) & (diff < WINDOW) & (kpos[:, None, :] >= 0)
    s = jnp.where(ok[None, :, None, None], s, -jnp.inf)
    p = jax.nn.softmax(s, axis=-1)
    return jnp.einsum('bnghqk,bnkgd->bnqghd', p.astype(vb.dtype), vb).reshape(B, S, H, d)


def nsa_mixer(q, k_cmp, v_cmp, k_slc, v_slc, k_win, v_win, gate_logits, cos, sin,
              ck_pos, ck_w1, ck_b1, ck_w2, ck_b2, cv_pos, cv_w1, cv_b1, cv_w2, cv_b2):
    B, S, _ = q.shape
    H, G, d = NSA_HEADS, NSA_KV_GROUPS, NSA_HEAD_DIM
    q = q.reshape(B, S, H, d)
    kv = lambda t: t.reshape(B, S, G, d)
    kc = compress_blocks(kv(k_cmp), ck_pos, ck_w1, ck_b1, ck_w2, ck_b2)
    vc = compress_blocks(kv(v_cmp), cv_pos, cv_w1, cv_b1, cv_w2, cv_b2)
    o_cmp, p_cmp = nsa_compressed(q, kc, vc)
    idx = nsa_select(p_cmp, S)
    qr = partial_rope(q, cos, sin)
    o_slc = nsa_selected(qr, partial_rope(kv(k_slc), cos, sin), kv(v_slc), idx)
    o_win = nsa_window(qr, partial_rope(kv(k_win), cos, sin), kv(v_win))
    gate = jax.nn.sigmoid(gate_logits.reshape(B, S, H, 3))
    o = gate[..., 0:1] * o_cmp + gate[..., 1:2] * o_slc + gate[..., 2:3] * o_win
    return o.reshape(B, S, H * d)


def hgrn2_mixer(q, f, i, g, lb, norm_gain):
    B, S, _ = q.shape
    H, dk, dv, C = HGRN_HEADS, HGRN_KEY_DIM, HGRN_VAL_DIM, HGRN_CHUNK
    nc = S // C

    def heads(t, dd):
        return t.reshape(B, nc, C, H, dd).transpose(1, 0, 3, 2, 4).astype(F32)

    qh = heads(jax.nn.silu(q), dk)
    fh = heads(f, dk)
    vh = heads(i, dv)
    lbh = lb.astype(F32).reshape(H, 1, dk)
    log_f = jnp.logaddexp(jnp.log(lbh), jnp.log1p(-lbh) + jax.nn.log_sigmoid(fh))
    kh = -jnp.expm1(log_f)
    causal = np.tril(np.ones((C, C), dtype=bool))

    def step(state, xs):
        qc, kc, vc, lc = xs
        A = jnp.cumsum(lc, axis=-2)
        inter = jnp.einsum('bhtd,bhde->bhte', qc * jnp.exp(A), state)
        rel = A[:, :, :, None, :] - A[:, :, None, :, :]
        decay = jnp.exp(jnp.where(causal[:, :, None], rel, -jnp.inf))
        attn = jnp.einsum('bhtd,bhsd,bhtsd->bhts', qc, kc, decay)
        intra = jnp.einsum('bhts,bhse->bhte', attn, vc)
        A_end = A[:, :, -1:, :]
        state = jnp.exp(A_end[:, :, 0, :])[..., None] * state + jnp.einsum('bhsd,bhse->bhde', kc * jnp.exp(A_end - A), vc)
        return state, inter + intra

    s0 = jnp.zeros((B, H, dk, dv), F32)
    _, o = lax.scan(step, s0, (qh, kh, vh, log_f))
    o = o.transpose(1, 0, 3, 2, 4).reshape(B, S, H, dv)
    o = o * lax.rsqrt(jnp.mean(o * o, axis=-1, keepdims=True) + EPS) * norm_gain.astype(F32).reshape(H, dv)
    o = o * jax.nn.sigmoid(g.astype(F32).reshape(B, S, H, dv))
    return o.reshape(B, S, H * dv).astype(q.dtype)


def peer_ffn(h, wq, sub_keys, u, v):
    B, S, D = h.shape
    T = B * S
    PH, K, NK = PEER_HEADS, PEER_TOPK, PEER_N_KEYS
    xt = h.reshape(T, D)
    q = (xt @ wq).reshape(T, PH, 2, PEER_QUERY_DIM // 2)
    s = jnp.einsum('thpd,hpkd->thpk', q, sub_keys, preferred_element_type=F32)
    s_top, i_top = lax.top_k(s, K)
    cand_s = (s_top[:, :, 0, :, None] + s_top[:, :, 1, None, :]).reshape(T, PH, K * K)
    cand_i = (i_top[:, :, 0, :, None] * NK + i_top[:, :, 1, None, :]).reshape(T, PH, K * K)
    best_s, best_pos = lax.top_k(cand_s, K)
    experts = jnp.take_along_axis(cand_i, best_pos, axis=-1)
    gates = jax.nn.softmax(best_s, axis=-1).astype(h.dtype)
    n_ch = T // PEER_TOKEN_CHUNK

    def chunk(args):
        xc, ec, gc = args
        act = jax.nn.gelu(jnp.einsum('td,thkd->thk', xc, u[ec]))
        return jnp.einsum('thk,thkd->td', gc * act, v[ec])

    out = lax.map(chunk, (xt.reshape(n_ch, PEER_TOKEN_CHUNK, D),
                          experts.reshape(n_ch, PEER_TOKEN_CHUNK, PH, K),
                          gates.reshape(n_ch, PEER_TOKEN_CHUNK, PH, K)))
    return out.reshape(B, S, D)


def setup_inputs(seed: int = 0) -> dict:
    key = jax.random.key(seed)
    ks = jax.random.split(key, 32)
    L, D = DEPTH, D_MODEL
    nrm = lambda k, shape, scale: jax.random.normal(k, shape, F32) * scale
    lk = CMP_BLOCK * NSA_HEAD_DIM
    x = nrm(ks[0], (BATCH, SEQ, D), 1.0)
    c = nrm(ks[1], (BATCH, D), 1.0)
    positions = (jax.random.randint(ks[2], (BATCH, 1), 0, MAX_POS_OFFSET, dtype=jnp.int32)
                 + jnp.arange(SEQ, dtype=jnp.int32)[None, :]).astype(jnp.int32)
    return {
        'x': x,
        'c': c,
        'positions': positions,
        'norm_mix': 1.0 + nrm(ks[3], (L, D), 0.02),
        'norm_ffn': 1.0 + nrm(ks[4], (L, D), 0.02),
        'w_ada': nrm(ks[5], (L, D, 6 * D), 0.5 * D ** -0.5),
        'b_ada': nrm(ks[6], (L, 6 * D), 0.01),
        'w_in': nrm(ks[7], (L, D, IN_WIDTH), D ** -0.5),
        'w_out': nrm(ks[8], (L, MIX_WIDTH, D), MIX_WIDTH ** -0.5),
        'cmp_k_pos': nrm(ks[9], (L, CMP_BLOCK, NSA_HEAD_DIM), 0.1),
        'cmp_k_w1': nrm(ks[10], (L, lk, CMP_HIDDEN), lk ** -0.5),
        'cmp_k_b1': nrm(ks[11], (L, CMP_HIDDEN), 0.01),
        'cmp_k_w2': nrm(ks[12], (L, CMP_HIDDEN, NSA_HEAD_DIM), CMP_HIDDEN ** -0.5),
        'cmp_k_b2': nrm(ks[13], (L, NSA_HEAD_DIM), 0.01),
        'cmp_v_pos': nrm(ks[14], (L, CMP_BLOCK, NSA_HEAD_DIM), 0.1),
        'cmp_v_w1': nrm(ks[15], (L, lk, CMP_HIDDEN), lk ** -0.5),
        'cmp_v_b1': nrm(ks[16], (L, CMP_HIDDEN), 0.01),
        'cmp_v_w2': nrm(ks[17], (L, CMP_HIDDEN, NSA_HEAD_DIM), CMP_HIDDEN ** -0.5),
        'cmp_v_b2': nrm(ks[18], (L, NSA_HEAD_DIM), 0.01),
        'hgrn_norm': 1.0 + nrm(ks[19], (L, HGRN_WIDTH), 0.02),
        'hgrn_lb': nrm(ks[20], (L, HGRN_FDIM), 0.5),
        'peer_wq': nrm(ks[21], (L, D, PEER_HEADS * PEER_QUERY_DIM), D ** -0.5),
        'peer_keys': nrm(ks[22], (L, PEER_HEADS, 2, PEER_N_KEYS, PEER_QUERY_DIM // 2), (PEER_QUERY_DIM // 2) ** -0.5),
        'peer_u': nrm(ks[23], (L, PEER_N_EXPERTS, D), D ** -0.5),
        'peer_v': nrm(ks[24], (L, PEER_N_EXPERTS, D), 1.0),
        'final_norm': 1.0 + nrm(ks[25], (D,), 0.02),
    }


def reference(x, c, positions, norm_mix, norm_ffn, w_ada, b_ada, w_in, w_out,
              cmp_k_pos, cmp_k_w1, cmp_k_b1, cmp_k_w2, cmp_k_b2,
              cmp_v_pos, cmp_v_w1, cmp_v_b1, cmp_v_w2, cmp_v_b2,
              hgrn_norm, hgrn_lb, peer_wq, peer_keys, peer_u, peer_v, final_norm):
    cos, sin = rope_tables(positions)
    c_act = jax.nn.silu(c)
    lb_all = jnp.cumsum(jax.nn.softmax(hgrn_lb.astype(F32), axis=0), axis=0)
    lb_all = lb_all - lb_all[0:1]
    split_at = [int(v) for v in np.cumsum(IN_SPLITS)[:-1]]
    for l in range(DEPTH):
        mod = c_act @ w_ada[l] + b_ada[l]
        sh1, sc1, g1, sh2, sc2, g2 = jnp.split(mod, 6, axis=-1)
        h = ada_modulate(x, norm_mix[l], sh1, sc1)
        q, kc, vc, ks, vs, kw, vw, gl, hq, hf, hi, hg = jnp.split(h @ w_in[l], split_at, axis=-1)
        o_nsa = nsa_mixer(q, kc, vc, ks, vs, kw, vw, gl, cos, sin,
                          cmp_k_pos[l], cmp_k_w1[l], cmp_k_b1[l], cmp_k_w2[l], cmp_k_b2[l],
                          cmp_v_pos[l], cmp_v_w1[l], cmp_v_b1[l], cmp_v_w2[l], cmp_v_b2[l])
        o_hgrn = hgrn2_mixer(hq, hf, hi, hg, lb_all[l], hgrn_norm[l])
        mix = jnp.concatenate([o_nsa, o_hgrn], axis=-1) @ w_out[l]
        x = x + g1[:, None, :] * mix
        h = ada_modulate(x, norm_ffn[l], sh2, sc2)
        x = x + g2[:, None, :] * peer_ffn(h, peer_wq[l], peer_keys[l], peer_u[l], peer_v[l])
    return rms_norm(x, final_norm)
```

```cpp
#include <hip/hip_runtime.h>
#include <cstdio>
#include <cstdint>
#ifndef MK_ONE_LAUNCH
#define MK_ONE_LAUNCH 0
#endif
namespace pg8 {
#define PG8_LAS __attribute__((address_space(3)))
typedef unsigned short bf16_t;
typedef short bf16x8 __attribute__((ext_vector_type(8)));
typedef float f32x4 __attribute__((ext_vector_type(4)));
typedef unsigned u32x4 __attribute__((ext_vector_type(4)));
constexpr int BM = 256, BK = 64, HALF = 128, HTB = HALF * BK * 2  , STAGE_BYTES = 8 * HTB, NXCD = 8, WGM = 8;

__host__ __device__ __forceinline__ int lds_byte(int r, int c) { const int st = (r >> 4) * 2 + (c >> 5), rr = r & 15, cc = c & 31, ob = rr * 64 + cc * 2; return st * 1024 + (ob ^ (((ob >> 9) & 1) << 5)); }
__host__ __device__ __forceinline__ void stage_rc(int b, int& R, int& C) { const int st = b / 1024, sb = b % 1024, swz = sb ^ (((sb >> 9) & 1) << 5); R = (st >> 1) * 16 + swz / 64; C = (st & 1) * 32 + (swz % 64) / 2; }
__host__ __device__ __forceinline__ int perm32(int rho) { const int n = rho >> 4, i = rho & 15; return 8 * (i >> 2) + 4 * n + (i & 3); }

struct Unit { int pm, pn; };
struct Gemm { const bf16_t* A; const bf16_t* Bt; int M, N, K; };

struct StaticOrder {
    int nM, nN, nwg, G, c;
    __host__ __device__ void init(int M, int N, int G_, int c_) { nM = M / BM; nN = N / BM; nwg = nM * nN; G = G_; c = c_; }
    __host__ __device__ bool next(int i, Unit& u) const {
        const long L = (long)i * G + c; if (L >= nwg) return false;
        int wgid = (int)L; { const int q = nwg / NXCD, r = nwg % NXCD, xcd = wgid % NXCD, off = wgid / NXCD; wgid = (xcd < r ? xcd * (q + 1) : r * (q + 1) + (xcd - r) * q) + off; }
        const int nig = WGM * nN, gid = wgid / nig, fm = gid * WGM, gsz = (nM - fm) < WGM ? (nM - fm) : WGM;
        u.pm = fm + ((wgid % nig) % gsz); u.pn = (wgid % nig) / gsz; return true;
    }
    __device__ __forceinline__ void a_ready(const Unit&) const {}
    __device__ __forceinline__ void done(const Unit&) const {}
};

__device__ __forceinline__ unsigned cvt_pk_bf16(float lo, float hi) { unsigned r; asm volatile("v_cvt_pk_bf16_f32 %0, %1, %2" : "=v"(r) : "v"(lo), "v"(hi)); return r; }
typedef float f32x2 __attribute__((ext_vector_type(2)));
struct EpiStoreBf16 {
    static constexpr bool PERM = true, AFTER_DRAIN = false;
    bf16_t* O; int ldc;
    __device__ __forceinline__ void operator()(const f32x4 (&acc)[2][2][4][2], const Unit& u, int wr, int wc, int fr, int fq) const {
        const int row0 = u.pm * BM + wr * 64 + fr, col0 = u.pn * BM + wc * 32 + 8 * fq;
#pragma unroll
        for (int ai = 0; ai < 2; ++ai)
#pragma unroll
            for (int m = 0; m < 4; ++m) { bf16_t* rowp = O + (size_t)(row0 + ai * HALF + m * 16) * ldc + col0;
#pragma unroll
                for (int bj = 0; bj < 2; ++bj) { const f32x4 v0 = acc[ai][bj][m][0], v1 = acc[ai][bj][m][1];
                    u32x4 w; w.x = cvt_pk_bf16(v0[0], v0[1]); w.y = cvt_pk_bf16(v0[2], v0[3]); w.z = cvt_pk_bf16(v1[0], v1[1]); w.w = cvt_pk_bf16(v1[2], v1[3]);
                    *(u32x4*)(rowp + bj * HALF) = w; } }
    }
};
struct EpiResGate {
    static constexpr bool PERM = false, AFTER_DRAIN = false;
    const float* base; float* out; int ldc; const float* gate; int gate_stride; int rows_per_b;
    __device__ __forceinline__ void operator()(const f32x4 (&acc)[2][2][4][2], const Unit& u, int wr, int wc, int fr, int fq) const {
        const int row0 = u.pm * BM + wr * 64 + fr, col0 = u.pn * BM + wc * 32 + 4 * fq;
        const float* gp = gate + (size_t)((u.pm * BM) / rows_per_b) * gate_stride + col0;
        f32x4 gv[2][2];
#pragma unroll
        for (int bj = 0; bj < 2; ++bj)
#pragma unroll
            for (int n = 0; n < 2; ++n) gv[bj][n] = *(const f32x4*)(gp + bj * HALF + n * 16);
#pragma unroll
        for (int ai = 0; ai < 2; ++ai)
#pragma unroll
            for (int m = 0; m < 4; ++m) { const size_t off = (size_t)(row0 + ai * HALF + m * 16) * ldc + col0;
#pragma unroll
                for (int bj = 0; bj < 2; ++bj)
#pragma unroll
                    for (int n = 0; n < 2; ++n) { const f32x4 x = *(const f32x4*)(base + off + bj * HALF + n * 16);

#ifdef EXP_NO_MIX
                        *(f32x4*)(out + off + bj * HALF + n * 16) = x; } }
#else
                        *(f32x4*)(out + off + bj * HALF + n * 16) = x + gv[bj][n] * acc[ai][bj][m][n]; } }
#endif
    }
};

template <class Epi, class Sched, bool ALIGN_EPI = false, bool SP2 = false>
__device__ __forceinline__ void gemm_phase(PG8_LAS unsigned char* lds, const Gemm g, const Sched& S, const Epi& E) {
    const int tid = threadIdx.x, wid = __builtin_amdgcn_readfirstlane(tid >> 6), lane = tid & 63, wr = wid >> 2, wc = wid & 3, fr = lane & 15, fq = lane >> 4;
    const int K = g.K, nt = K / BK;
    unsigned voffA[2], voffB[2];
#pragma unroll
    for (int i = 0; i < 2; ++i) { int R, C; stage_rc(tid * 16 + i * 8192, R, C); const int Rb = Epi::PERM ? ((R & ~31) + perm32(R & 31)) : R;
        voffA[i] = (unsigned)(R * K + C) * 2u; voffB[i] = (unsigned)(Rb * K + C) * 2u; }
    const size_t kstep = (size_t)(BK * 2);
    const size_t hstep = (size_t)HALF * K * 2;
    const size_t tstep = 2 * hstep;
    const unsigned ldsw = (unsigned)wid * 1024u;
    const int aoff = lds_byte(wr * 64 + fr, fq * 8), boff = lds_byte(wc * 32 + fr, fq * 8);
#define PG8_SA(b, h) (((b) * 2 + (h)) * HTB)
#define PG8_SB(b, h) ((4 + (b) * 2 + (h)) * HTB)
#define PG8_STAGE(bufoff, gbase, voff) do { _Pragma("unroll") for (int _i = 0; _i < 2; ++_i) \
        __builtin_amdgcn_global_load_lds((const unsigned*)((const char*)(gbase) + (voff)[_i]), (PG8_LAS unsigned*)(lds + (bufoff) + ldsw + _i * 8192), 16, 0, 0); } while (0)
#define PG8_LDA(dst, b, h) do { _Pragma("unroll") for (int m = 0; m < 4; ++m) _Pragma("unroll") for (int k = 0; k < 2; ++k) dst[m][k] = *(const PG8_LAS bf16x8*)(lds + PG8_SA(b, h) + aoff + m * 2048 + k * 1024); } while (0)
#define PG8_LDB(dst, b, h) do { _Pragma("unroll") for (int n = 0; n < 2; ++n) _Pragma("unroll") for (int k = 0; k < 2; ++k) dst[n][k] = *(const PG8_LAS bf16x8*)(lds + PG8_SB(b, h) + boff + n * 2048 + k * 1024); } while (0)
#define PG8_MMA(ai, bj, At, Bt) do { __builtin_amdgcn_s_setprio(1); _Pragma("unroll") for (int m = 0; m < 4; ++m) _Pragma("unroll") for (int n = 0; n < 2; ++n) _Pragma("unroll") for (int k = 0; k < 2; ++k) \
        acc[ai][bj][m][n] = __builtin_amdgcn_mfma_f32_16x16x32_bf16(Bt[n][k], At[m][k], acc[ai][bj][m][n], 0, 0, 0); __builtin_amdgcn_s_setprio(0); } while (0)
#define PG8_WAIT_V(n) asm volatile("s_waitcnt vmcnt(" #n ")" ::: "memory")
#define PG8_WAIT_L(n) asm volatile("s_waitcnt lgkmcnt(" #n ")" ::: "memory")
#define PG8_BAR __builtin_amdgcn_s_barrier()
#define PG8_SCHED __builtin_amdgcn_sched_barrier(0)
    Unit cur, nxt; int ui = 0;
    if (!S.next(0, cur)) return;
    f32x4 acc[2][2][4][2];
#pragma unroll
    for (int a = 0; a < 2; ++a)
#pragma unroll
        for (int b = 0; b < 2; ++b)
#pragma unroll
            for (int m = 0; m < 4; ++m)
#pragma unroll
                for (int n = 0; n < 2; ++n) acc[a][b][m][n] = (f32x4){0.f, 0.f, 0.f, 0.f};
    bf16x8 At[4][2], B0[2][2], B1[2][2];
    const char* cA = (const char*)g.A + (size_t)cur.pm * tstep; const char* cB = (const char*)g.Bt + (size_t)cur.pn * tstep;
    S.a_ready(cur);
    if constexpr (SP2) {
        PG8_STAGE(PG8_SB(0, 0), cB, voffB); PG8_STAGE(PG8_SB(0, 1), cB + hstep, voffB); PG8_STAGE(PG8_SA(0, 0), cA, voffA); PG8_STAGE(PG8_SA(0, 1), cA + hstep, voffA);
        if (wr == 1) PG8_BAR;
        PG8_WAIT_V(2); PG8_BAR;
        PG8_STAGE(PG8_SB(1, 0), cB + kstep, voffB); PG8_STAGE(PG8_SA(1, 0), cA + kstep, voffA); PG8_STAGE(PG8_SB(1, 1), cB + hstep + kstep, voffB);
        PG8_WAIT_V(6); PG8_BAR;
    } else {
        PG8_STAGE(PG8_SB(0, 0), cB, voffB); PG8_STAGE(PG8_SA(0, 0), cA, voffA); PG8_STAGE(PG8_SB(0, 1), cB + hstep, voffB); PG8_STAGE(PG8_SA(0, 1), cA + hstep, voffA);
        if (wr == 1) PG8_BAR;
        PG8_WAIT_V(4); PG8_BAR;
        PG8_STAGE(PG8_SB(1, 0), cB + kstep, voffB); PG8_STAGE(PG8_SA(1, 0), cA + kstep, voffA); PG8_STAGE(PG8_SB(1, 1), cB + hstep + kstep, voffB);
        PG8_WAIT_V(6); PG8_BAR;
    }
    for (;;) {
        const bool has_next = S.next(ui + 1, nxt);
        const char* nA = has_next ? (const char*)g.A + (size_t)nxt.pm * tstep : cA; const char* nB = has_next ? (const char*)g.Bt + (size_t)nxt.pn * tstep : cB;
        for (int t = 0; t < nt; t += 2) {
            const bool last = (t == nt - 2);
            const char* a1 = cA + (size_t)(t + 1) * kstep;
            const char* a2 = last ? nA : cA + (size_t)(t + 2) * kstep; const char* b2 = last ? nB : cB + (size_t)(t + 2) * kstep;
            const char* a3 = a2 + kstep; const char* b3 = b2 + kstep;
            if (last && has_next) S.a_ready(nxt);
            if constexpr (SP2) {
            PG8_LDB(B0, 0, 0); PG8_LDB(B1, 0, 1); PG8_SCHED; PG8_LDA(At, 0, 0); PG8_STAGE(PG8_SA(1, 1), a1 + hstep, voffA);
            PG8_WAIT_V(8); PG8_WAIT_L(0); PG8_BAR; PG8_MMA(0, 0, At, B0); PG8_MMA(0, 1, At, B1); PG8_BAR; PG8_SCHED;
            PG8_LDA(At, 0, 1); PG8_STAGE(PG8_SB(0, 0), b2, voffB); PG8_STAGE(PG8_SB(0, 1), b2 + hstep, voffB); PG8_STAGE(PG8_SA(0, 0), a2, voffA);
            PG8_WAIT_V(8); PG8_WAIT_L(0); PG8_BAR; PG8_MMA(1, 0, At, B0); PG8_MMA(1, 1, At, B1); PG8_BAR; PG8_SCHED;
            PG8_LDB(B0, 1, 0); PG8_LDB(B1, 1, 1); PG8_SCHED; PG8_LDA(At, 1, 0); PG8_STAGE(PG8_SA(0, 1), a2 + hstep, voffA);
            PG8_WAIT_V(8); PG8_WAIT_L(0); PG8_BAR; PG8_MMA(0, 0, At, B0); PG8_MMA(0, 1, At, B1); PG8_BAR; PG8_SCHED;
            PG8_LDA(At, 1, 1); PG8_STAGE(PG8_SB(1, 0), b3, voffB); PG8_STAGE(PG8_SB(1, 1), b3 + hstep, voffB); PG8_STAGE(PG8_SA(1, 0), a3, voffA);
            PG8_WAIT_V(8); PG8_WAIT_L(0); PG8_BAR; PG8_MMA(1, 0, At, B0); PG8_MMA(1, 1, At, B1); PG8_BAR; PG8_SCHED;
            } else {
            PG8_LDB(B0, 0, 0); PG8_SCHED; PG8_LDA(At, 0, 0); PG8_STAGE(PG8_SA(1, 1), a1 + hstep, voffA);
            PG8_WAIT_L(8); PG8_BAR; PG8_WAIT_L(0); PG8_MMA(0, 0, At, B0); PG8_BAR; PG8_SCHED;
            PG8_LDB(B1, 0, 1); PG8_STAGE(PG8_SB(0, 0), b2, voffB);
            PG8_BAR; PG8_WAIT_L(0); PG8_MMA(0, 1, At, B1); PG8_BAR;
            PG8_LDA(At, 0, 1); PG8_STAGE(PG8_SA(0, 0), a2, voffA);
            PG8_BAR; PG8_WAIT_L(0); PG8_MMA(1, 0, At, B0); PG8_BAR; PG8_SCHED;
            PG8_STAGE(PG8_SB(0, 1), b2 + hstep, voffB);
            PG8_WAIT_V(6); PG8_BAR; PG8_MMA(1, 1, At, B1); PG8_BAR;
            PG8_LDB(B0, 1, 0); PG8_SCHED; PG8_LDA(At, 1, 0); PG8_STAGE(PG8_SA(0, 1), a2 + hstep, voffA);
            PG8_WAIT_L(8); PG8_BAR; PG8_WAIT_L(0); PG8_MMA(0, 0, At, B0); PG8_BAR; PG8_SCHED;
            PG8_LDB(B1, 1, 1); PG8_STAGE(PG8_SB(1, 0), b3, voffB);
            PG8_BAR; PG8_WAIT_L(0); PG8_MMA(0, 1, At, B1); PG8_BAR;
            PG8_LDA(At, 1, 1); PG8_STAGE(PG8_SA(1, 0), a3, voffA);
            PG8_BAR; PG8_WAIT_L(0); PG8_MMA(1, 0, At, B0); PG8_BAR; PG8_SCHED;
            PG8_STAGE(PG8_SB(1, 1), b3 + hstep, voffB);
            PG8_WAIT_V(6); PG8_BAR; PG8_MMA(1, 1, At, B1); PG8_BAR;
            }
        }
        if constexpr (ALIGN_EPI) { if (wr == 0) PG8_BAR; }
        if constexpr (!Epi::AFTER_DRAIN) { E(acc, cur, wr, wc, fr, fq); S.done(cur); }
        if (!has_next) break;
#pragma unroll
        for (int a = 0; a < 2; ++a)
#pragma unroll
            for (int b = 0; b < 2; ++b)
#pragma unroll
                for (int m = 0; m < 4; ++m)
#pragma unroll
                    for (int n = 0; n < 2; ++n) acc[a][b][m][n] = (f32x4){0.f, 0.f, 0.f, 0.f};
        cur = nxt; cA = nA; cB = nB; ++ui;
        if constexpr (ALIGN_EPI) { if (wr == 1) PG8_BAR; }
    }
    PG8_WAIT_V(0);
    if constexpr (!ALIGN_EPI) { if (wr == 0) PG8_BAR; }
    PG8_BAR;
    if constexpr (Epi::AFTER_DRAIN) { E.fused(acc, cur, wr, wc, fr, fq, lds, wid, lane); S.done(cur); }
#undef PG8_SA
#undef PG8_SB
#undef PG8_STAGE
#undef PG8_LDA
#undef PG8_LDB
#undef PG8_MMA
#undef PG8_WAIT_V
#undef PG8_WAIT_L
#undef PG8_BAR
#undef PG8_SCHED
}
}

#ifndef PG8_SP2
#define PG8_SP2 true
#endif
#ifndef PG8_ALIGN
#define PG8_ALIGN true
#endif
#define GAS __attribute__((address_space(1)))
#define LAS __attribute__((address_space(3)))
typedef unsigned short bf16;
typedef unsigned v4u __attribute__((ext_vector_type(4)));
typedef unsigned v2u __attribute__((ext_vector_type(2)));
typedef float f32x4 __attribute__((ext_vector_type(4)));
typedef float f32x2 __attribute__((ext_vector_type(2)));
typedef short bf16x8 __attribute__((ext_vector_type(8)));
typedef __bf16 bf16x2_t __attribute__((ext_vector_type(2)));
typedef GAS unsigned gu32;

constexpr int NB = 4, S = 2048, D = 2048, T = NB * S, DEPTH = 2;
constexpr int INW = 6680, NPROJ = 6912;
constexpr int C_Q = 0, C_KC = 1024, C_VC = 1280, C_KS = 1536, C_VS = 1792, C_KW = 2048, C_VW = 2304, C_HQ = 2560, C_HF = 3584, C_HI = 4608, C_HG = 5632, C_GL = 6656;
constexpr int NCMP = 127;
constexpr float EPS = 1e-6f;
constexpr float ATT_SCALE = 0.08838834764831845f;
__host__ __device__ __forceinline__ int winmap(int n) { return n < 2560 ? n : (n < 2584 ? C_GL + (n - 2560) : n - 24); }

constexpr size_t MiB = 1u << 20;
constexpr size_t WS_CTL = 0, CTL_ZERO_BYTES = 2 * MiB;
constexpr size_t WS_MOD = 256 * 1024;
constexpr size_t WS_B1P = 1 * MiB;
constexpr size_t WS_WINT = 2 * MiB, WS_WOUTT = 56 * MiB, WS_WQT = 72 * MiB, WS_W1T = 88 * MiB, WS_PU = 96 * MiB, WS_PV = 224 * MiB;
constexpr size_t WS_H = 352 * MiB, WS_PROJ = 384 * MiB, WS_OMIX = 492 * MiB, WS_OACC = 524 * MiB, WS_XA = 556 * MiB, WS_XB = 620 * MiB;
constexpr size_t WS_PQ = 684 * MiB, WS_EIDX = 716 * MiB, WS_EGATE = 720 * MiB, WS_MISC = 724 * MiB, WS_HRAW = 732 * MiB, WS_PARTS = 764 * MiB, WS_END = 772 * MiB;
constexpr size_t MS_KC = 0, MS_ROPEC = 1 * MiB, MS_ROPES = 1 * MiB + 512 * 1024, MS_SEL = 2 * MiB, MS_HID = 4 * MiB;
constexpr int CW_BAR = 4096;

constexpr int LDS_BYTES = 147456;
constexpr int MISC_OFF = 131072 + 320;

#define RLX_AGENT __ATOMIC_RELAXED, __HIP_MEMORY_SCOPE_AGENT
__device__ __forceinline__ float bf2f(bf16 b) { return __uint_as_float(((unsigned)b) << 16); }
__device__ __forceinline__ unsigned f2bf(float f) { unsigned u = __float_as_uint(f); return (u + 0x7fffu + ((u >> 16) & 1u)) >> 16; }
__device__ __forceinline__ unsigned pk2(float lo, float hi) { return f2bf(lo) | (f2bf(hi) << 16); }
__device__ __forceinline__ float wave_sum(float v) {
#pragma unroll
    for (int o = 1; o < 64; o <<= 1) v += __shfl_xor(v, o);
    return v;
}
__device__ __forceinline__ float wave_max(float v) {
#pragma unroll
    for (int o = 1; o < 64; o <<= 1) v = fmaxf(v, __shfl_xor(v, o));
    return v;
}
__device__ __forceinline__ float sigmoidf_(float x) { return 1.0f / (1.0f + __expf(-x)); }
__device__ __forceinline__ float siluf_(float x) { return x / (1.0f + __expf(-x)); }
__device__ __forceinline__ float gelu_tanh(float x) { const float u = 0.7978845608028654f * (x + 0.044715f * x * x * x); const float e = __expf(2.0f * u); return 0.5f * x * (1.0f + (1.0f - 2.0f / (e + 1.0f))); }
#define XB_TMO      128
#define XB_XCNT(j)  (256  + 64 * (j))
#define XB_XSUB(j)  (1280 + 64 * (j))
#define XB_XGEN(j)  (2304 + 64 * (j))
#define XB_TOP      3328
#define XB_TOPGEN   3392
#define XCD_BAR_WORDS 3456
#define XB_SPIN_CAP (1u << 18)

__device__ __forceinline__ unsigned xb_ld(unsigned* p)              { return __hip_atomic_load(p, __ATOMIC_RELAXED, __HIP_MEMORY_SCOPE_AGENT); }
__device__ __forceinline__ unsigned xb_add(unsigned* p, unsigned v) { return __hip_atomic_fetch_add(p, v, __ATOMIC_RELAXED, __HIP_MEMORY_SCOPE_AGENT); }
__device__ __forceinline__ unsigned xb_xcc_id() { return (unsigned)__builtin_amdgcn_s_getreg((3 << 11) | 20) & 0xFu; }
#define XB_SPIN(cond, bar) do { unsigned _sp = 0; while (cond) { __builtin_amdgcn_s_sleep(1); \
    if ((++_sp & 255u) == 0u) { if (xb_ld(&(bar)[XB_TMO])) break; if (_sp > XB_SPIN_CAP) { atomicAdd(&(bar)[XB_TMO], 1u); break; } } } } while (0)

struct XcdBarrier {
    unsigned* bar; unsigned x;
    volatile LAS unsigned* st;
};

__device__ __forceinline__ XcdBarrier xcd_barrier_post(unsigned* bar, volatile LAS unsigned* st) {
    XcdBarrier b; b.bar = bar; b.x = xb_xcc_id(); b.st = st;
    if (threadIdx.x == 0) (void)xb_add(&bar[XB_XCNT(b.x)], 1u);
    return b;
}
__device__ __forceinline__ void xcd_barrier_complete(unsigned* bar, unsigned x, unsigned& nloc, unsigned& nx) {
    const unsigned G = gridDim.x * gridDim.y * gridDim.z;
    unsigned sum, cnt, mine, sp = 0u;
    for (;;) {
        sum = 0u; cnt = 0u; mine = 0u;
#pragma unroll
        for (unsigned j = 0; j < 16; ++j) { const unsigned c = xb_ld(&bar[XB_XCNT(j)]); sum += c; cnt += (c > 0u) ? 1u : 0u; mine = (j == x) ? c : mine; }
        if (sum == G) break;
        __builtin_amdgcn_s_sleep(1);
        if ((++sp & 255u) == 0u) { if (xb_ld(&bar[XB_TMO])) break; if (sp > XB_SPIN_CAP) { atomicAdd(&bar[XB_TMO], 1u); break; } }
    }
    nloc = mine > 0u ? mine : 1u; nx = cnt > 0u ? cnt : 1u;
}

__device__ __forceinline__ void xcd_barrier(const XcdBarrier& b) {
    asm volatile("s_waitcnt vmcnt(0)" ::: "memory");
    __syncthreads();
    if (threadIdx.x == 0) {
        unsigned* bar = b.bar;
        __builtin_amdgcn_s_waitcnt(0);
        unsigned nloc = b.st[0], nx = b.st[1];
        if (nloc == 0u) { xcd_barrier_complete(bar, b.x, nloc, nx); b.st[0] = nloc; b.st[1] = nx; }
        const unsigned old = xb_add(&bar[XB_XSUB(b.x)], 1u);
        const unsigned gen = old / nloc;
        if (old + 1u == (gen + 1u) * nloc) {
            __builtin_amdgcn_fence(__ATOMIC_RELEASE, "agent");
            asm volatile("s_waitcnt vmcnt(0)" ::: "memory");
            const unsigned og = xb_add(&bar[XB_TOP], 1u);
            const unsigned tg = og / nx;
            if (og + 1u == (tg + 1u) * nx) xb_add(&bar[XB_TOPGEN], 1u);
            else XB_SPIN(xb_ld(&bar[XB_TOPGEN]) == tg, bar);
            __builtin_amdgcn_fence(__ATOMIC_ACQUIRE, "agent");
            xb_add(&bar[XB_XGEN(b.x)], 1u);
            asm volatile("s_waitcnt vmcnt(0)" ::: "memory");
        } else {
            XB_SPIN(xb_ld(&bar[XB_XGEN(b.x)]) == gen, bar);
            __builtin_amdgcn_fence(__ATOMIC_ACQUIRE, "agent");
            asm volatile("s_waitcnt vmcnt(0)" ::: "memory");
        }
    }
    __syncthreads();
}

struct Args { const void* in[26]; float* out; unsigned char* ws; int layer, pad; };
typedef const __attribute__((address_space(4))) Args* KA;
struct Frame {
    LAS unsigned char* lds;
    int tid, lane, wave, vb, G;
};
enum { I_X = 0, I_C, I_POS, I_NMIX, I_NFFN, I_WADA, I_BADA, I_WIN, I_WOUT, I_CKPOS, I_CKW1, I_CKB1, I_CKW2, I_CKB2, I_CVPOS, I_CVW1, I_CVB1, I_CVW2, I_CVB2, I_HNORM, I_HLB, I_PWQ, I_PKEYS, I_PU, I_PV, I_FNORM };

template <bool MAPPED>
__device__ __forceinline__ void p0_transpose_item(const float* W, int K, int N, bf16* WT, LAS float* scr, int item, int lane) {
    const int nblk = (N + 31) / 32, kb = item / nblk, nb = item % nblk, k0 = 64 * kb, n0 = 32 * nb;
    const int ncol = n0 + (lane & 31);
#pragma unroll 8
    for (int i = 0; i < 32; ++i) { const int kk = 2 * i + (lane >> 5); scr[kk * 33 + (lane & 31)] = (ncol < N) ? W[(size_t)(k0 + kk) * N + ncol] : 0.f; }
    asm volatile("s_waitcnt lgkmcnt(0)" ::: "memory");
    const int c = lane & 7;
#pragma unroll
    for (int j = 0; j < 4; ++j) { const int n = (lane >> 3) + 8 * j; const LAS float* s = scr + (8 * c) * 33 + n;
        v4u o; o.x = pk2(s[0 * 33], s[1 * 33]); o.y = pk2(s[2 * 33], s[3 * 33]); o.z = pk2(s[4 * 33], s[5 * 33]); o.w = pk2(s[6 * 33], s[7 * 33]);
        if (n0 + n < N) { const int row = MAPPED ? winmap(n0 + n) : (n0 + n); *(v4u*)(WT + (size_t)row * K + k0 + 8 * c) = o; } }
    asm volatile("s_waitcnt lgkmcnt(0)" ::: "memory");
}

__device__ __forceinline__ void p0_prologue(KA a, Frame& F) {
    unsigned char* ws = a->ws;
    LAS float* scr = (LAS float*)(F.lds + F.wave * 16384);
    const int gw = F.vb * 8 + F.wave, NGW = F.G * 8;
    const long gt = (long)F.vb * 512 + F.tid, GT = (long)F.G * 512;
    {
        constexpr int I_IN = (D / 64) * ((INW + 31) / 32);
        constexpr int I_SQ = (D / 64) * (D / 32);
        constexpr int I_W1 = (4096 / 64) * (256 / 32);
        constexpr int NITEMS = 2 * I_IN + 4 * I_SQ + 4 * I_W1;
        for (int it = gw; it < NITEMS; it += NGW) {
            int r = it;
            if (r < 2 * I_IN) { const int l = r / I_IN; p0_transpose_item<true>((const float*)a->in[I_WIN] + (size_t)l * D * INW, D, INW, (bf16*)(ws + WS_WINT) + (size_t)l * NPROJ * D, scr, r % I_IN, F.lane); continue; }
            r -= 2 * I_IN;
            if (r < 2 * I_SQ) { const int l = r / I_SQ; p0_transpose_item<false>((const float*)a->in[I_WOUT] + (size_t)l * D * D, D, D, (bf16*)(ws + WS_WOUTT) + (size_t)l * D * D, scr, r % I_SQ, F.lane); continue; }
            r -= 2 * I_SQ;
            if (r < 2 * I_SQ) { const int l = r / I_SQ; p0_transpose_item<false>((const float*)a->in[I_PWQ] + (size_t)l * D * D, D, D, (bf16*)(ws + WS_WQT) + (size_t)l * D * D, scr, r % I_SQ, F.lane); continue; }
            r -= 2 * I_SQ;
            { const int lk = r / I_W1, l = lk >> 1, kv = lk & 1;
              p0_transpose_item<false>((const float*)a->in[kv ? I_CVW1 : I_CKW1] + (size_t)l * 4096 * 256, 4096, 256, (bf16*)(ws + WS_W1T) + (size_t)lk * 256 * 4096, scr, r % I_W1, F.lane); }
        }
    }
    {
        constexpr int CH = (NPROJ - INW) * D / 8;
        for (long i = gt; i < 2L * CH; i += GT) { const int l = (int)(i / CH); const long c = i % CH;
            *(v4u*)((bf16*)(ws + WS_WINT) + (size_t)l * NPROJ * D + (size_t)INW * D + c * 8) = (v4u){0u, 0u, 0u, 0u}; }
    }
    {
        constexpr long NCH = 2L * 16384 * 2048 / 8;
        const f32x4* su = (const f32x4*)a->in[I_PU]; const f32x4* sv = (const f32x4*)a->in[I_PV];
        v4u* du = (v4u*)(ws + WS_PU); v4u* dv = (v4u*)(ws + WS_PV);
        for (long i = gt; i < NCH; i += GT) {
            const f32x4 a0 = su[2 * i], a1 = su[2 * i + 1], b0 = sv[2 * i], b1 = sv[2 * i + 1];
            du[i] = (v4u){pk2(a0.x, a0.y), pk2(a0.z, a0.w), pk2(a1.x, a1.y), pk2(a1.z, a1.w)};
            dv[i] = (v4u){pk2(b0.x, b0.y), pk2(b0.z, b0.w), pk2(b1.x, b1.y), pk2(b1.z, b1.w)};
        }
    }
    {
        const int* pos = (const int*)a->in[I_POS]; float* rc = (float*)(ws + WS_MISC + MS_ROPEC); float* rs = (float*)(ws + WS_MISC + MS_ROPES);
        for (long i = gt; i < (long)T * 16; i += GT) { const int m = (int)(i >> 4), j = (int)(i & 15);
            const float inv = powf(500000.0f, -(float)(2 * j) / 32.0f); const float ang = (float)pos[m] * inv;
            rc[i] = cosf(ang); rs[i] = sinf(ang); }
    }
    {
        LAS float* cs = (LAS float*)(F.lds + 131072 - 4096);
        const float* cin = (const float*)a->in[I_C]; float* parts = (float*)(ws + WS_PARTS);
        for (int it = F.vb; it < 2 * 16 * 6; it += F.G) {
            const int l = it / 96, kc = (it % 96) / 6, cb = it % 6;
            __syncthreads();
            { const int b = F.tid >> 7, k = F.tid & 127; cs[F.tid] = siluf_(cin[b * D + kc * 128 + k]); }
            __syncthreads();
            const int col = cb * 2048 + F.tid * 4;
            const float* w = (const float*)a->in[I_WADA] + ((size_t)l * D + kc * 128) * 12288 + col;
            f32x4 acc[4];
#pragma unroll
            for (int b = 0; b < 4; ++b) acc[b] = (f32x4){0.f, 0.f, 0.f, 0.f};
            if (kc == 0) { const f32x4 bv = *(const f32x4*)((const float*)a->in[I_BADA] + (size_t)l * 12288 + col);
#pragma unroll
                for (int b = 0; b < 4; ++b) acc[b] = bv; }
#pragma unroll 8
            for (int k = 0; k < 128; ++k) { const f32x4 wv = *(const f32x4*)(w + (size_t)k * 12288);
#pragma unroll
                for (int b = 0; b < 4; ++b) acc[b] += wv * cs[b * 128 + k]; }
#pragma unroll
            for (int b = 0; b < 4; ++b) *(f32x4*)(parts + (((size_t)kc * 2 + l) * 4 + b) * 12288 + col) = acc[b];
        }
        __syncthreads();
    }
    {
        float* b1p = (float*)(ws + WS_B1P);
        for (int it = F.vb; it < 64; it += F.G) {
            const int lk = it >> 4, l = lk >> 1, kv = lk & 1, kc = it & 15;
            if (F.tid < 256) {
                const int c = F.tid;
                const float* w1 = (const float*)a->in[kv ? I_CVW1 : I_CKW1] + (size_t)l * 4096 * 256;
                const float* pe = (const float*)a->in[kv ? I_CVPOS : I_CKPOS] + (size_t)l * 4096;
                float acc = (kc == 0) ? ((const float*)a->in[kv ? I_CVB1 : I_CKB1])[l * 256 + c] : 0.f;
                const int k0 = kc * 256;
#pragma unroll 8
                for (int k = 0; k < 256; ++k) acc += pe[k0 + k] * w1[(size_t)(k0 + k) * 256 + c];
                b1p[(kc * 4 + lk) * 256 + c] = acc;
            }
        }
    }
}

template <bool PART>
__device__ __forceinline__ void norm_phase(Frame& F, unsigned char* ws, const float* x, const float* gain, int l, int sh_off, int sc_off, bf16* out) {
    LAS float* shs = (LAS float*)F.lds; LAS float* scs = shs + 2048;
    const float* parts = (const float*)(ws + WS_PARTS); float* mod = (float*)(ws + WS_MOD);
    if (PART) {
        const long gt = (long)F.vb * 512 + F.tid, GT = (long)F.G * 512;
        for (long i = gt; i < 2L * 4 * 12288; i += GT) { float sacc = 0.f;
#pragma unroll
            for (int kc = 0; kc < 16; ++kc) sacc += parts[(size_t)kc * 2 * 4 * 12288 + i];
            mod[i] = sacc; }
    }
    for (int rb = F.vb; rb < T / 32; rb += F.G) {
        const int m0 = rb * 32, b = m0 / S;
        __syncthreads();
        for (int c = F.tid; c < 2048; c += 512) {
            float s0 = 0.f, s1 = 0.f;
            if (PART) {
#pragma unroll
                for (int kc = 0; kc < 16; ++kc) { const float* pp = parts + (((size_t)kc * 2 + l) * 4 + b) * 12288; s0 += pp[sh_off + c]; s1 += pp[sc_off + c]; }
            } else { const float* mp = mod + ((size_t)l * 4 + b) * 12288; s0 = mp[sh_off + c]; s1 = mp[sc_off + c]; }
            shs[c] = s0; scs[c] = s1 + 1.0f;
        }
        __syncthreads();
        for (int r = 0; r < 4; ++r) {
            const int m = m0 + F.wave * 4 + r;
            const float* xr = x + (size_t)m * D;
            f32x4 v[8]; float ss = 0.f;
#pragma unroll
            for (int j = 0; j < 8; ++j) { v[j] = *(const f32x4*)(xr + F.lane * 4 + 256 * j); ss += v[j].x * v[j].x + v[j].y * v[j].y + v[j].z * v[j].z + v[j].w * v[j].w; }
            const float rr = rsqrtf(wave_sum(ss) * (1.0f / D) + EPS);
#pragma unroll
            for (int j = 0; j < 8; ++j) { const int c = F.lane * 4 + 256 * j;
                const f32x4 g = *(const f32x4*)(gain + c), s1 = *(const LAS f32x4*)(scs + c), s0 = *(const LAS f32x4*)(shs + c);
                const f32x4 y = (v[j] * rr) * g * s1 + s0;
                *(v2u*)(out + (size_t)m * D + c) = (v2u){pk2(y.x, y.y), pk2(y.z, y.w)}; }
        }
    }
    __syncthreads();
}

__device__ __forceinline__ void cmp1_naive(KA a, Frame& F, int l) {
    const bf16* proj = (const bf16*)(a->ws + WS_PROJ); float* hid = (float*)(a->ws + WS_MISC + MS_HID);
    const long gt = (long)F.vb * 512 + F.tid, GT = (long)F.G * 512;
    constexpr int ROWS = NB * NCMP * 2;
    for (long i = gt; i < 2L * ROWS * 256; i += GT) {
        const int c = (int)(i & 255); const int row = (int)((i >> 8) % ROWS), kv = (int)((i >> 8) / ROWS);
        const int g = row & 1, n = (row >> 1) % NCMP, b = (row >> 1) / NCMP;
        const float* w1 = (const float*)a->in[kv ? I_CVW1 : I_CKW1] + (size_t)l * 4096 * 256 + c;
        const float* pe = (const float*)a->in[kv ? I_CVPOS : I_CKPOS] + (size_t)l * 4096;
        const bf16* ap = proj + (size_t)(b * S + 16 * n) * NPROJ + (kv ? C_VC : C_KC) + g * 128;
        float acc = ((const float*)a->in[kv ? I_CVB1 : I_CKB1])[l * 256 + c];
        for (int tl = 0; tl < 32; ++tl) {
#pragma unroll 8
            for (int d = 0; d < 128; ++d) acc += (bf2f(ap[(size_t)tl * NPROJ + d]) + pe[tl * 128 + d]) * w1[(size_t)(tl * 128 + d) * 256];
        }
        hid[i] = gelu_tanh(acc);
    }
}
__device__ __forceinline__ void cmp2_naive(KA a, Frame& F, int l) {
    const float* hid = (const float*)(a->ws + WS_MISC + MS_HID); float* kc = (float*)(a->ws + WS_MISC + MS_KC);
    const long gt = (long)F.vb * 512 + F.tid, GT = (long)F.G * 512;
    constexpr int ROWS = NB * NCMP * 2;
    for (long i = gt; i < 2L * ROWS * 128; i += GT) {
        const int j = (int)(i & 127); const int row = (int)((i >> 7) % ROWS), kv = (int)((i >> 7) / ROWS);
        const float* w2 = (const float*)a->in[kv ? I_CVW2 : I_CKW2] + (size_t)l * 256 * 128 + j;
        const float* hr = hid + ((size_t)kv * ROWS + row) * 256;
        float acc = ((const float*)a->in[kv ? I_CVB2 : I_CKB2])[l * 128 + j];
#pragma unroll 8
        for (int c = 0; c < 256; ++c) acc += hr[c] * w2[(size_t)c * 128];
        const int g = row & 1, n = (row >> 1) % NCMP, b = (row >> 1) / NCMP;
        kc[((((size_t)kv * NB + b) * 128 + n) * 2 + g) * 128 + j] = acc;
    }
}

__device__ __forceinline__ void hgrn_naive(KA a, Frame& F, int l) {
    if (F.wave != 0 || F.vb >= 128) return;
    const bf16* proj = (const bf16*)(a->ws + WS_PROJ); float* hraw = (float*)(a->ws + WS_HRAW);
    LAS float* fs = (LAS float*)(F.lds + 65536); LAS float* ks = fs + 128; LAS float* qs = fs + 256;
    const int item = F.vb, eq = item & 3, h = (item >> 2) & 7, b = item >> 5;
    const int e = eq * 32 + (F.lane & 31), dh = F.lane >> 5;
    const float* lbp = (const float*)a->in[I_HLB];
    float lb0, lb1;
    { const float a0 = lbp[h * 128 + F.lane], a1 = lbp[1024 + h * 128 + F.lane]; lb0 = (l == 0) ? 0.f : 1.0f / (1.0f + __expf(a0 - a1));
      const float c0 = lbp[h * 128 + 64 + F.lane], c1 = lbp[1024 + h * 128 + 64 + F.lane]; lb1 = (l == 0) ? 0.f : 1.0f / (1.0f + __expf(c0 - c1)); }
    float st[64];
#pragma unroll
    for (int d = 0; d < 64; ++d) st[d] = 0.f;
    for (int t = 0; t < S; ++t) {
        const bf16* pr = proj + (size_t)(b * S + t) * NPROJ;
        const float f0 = lb0 + (1.0f - lb0) * sigmoidf_(bf2f(pr[C_HF + h * 128 + F.lane])), f1 = lb1 + (1.0f - lb1) * sigmoidf_(bf2f(pr[C_HF + h * 128 + 64 + F.lane]));
        fs[F.lane] = f0; fs[64 + F.lane] = f1; ks[F.lane] = 1.0f - f0; ks[64 + F.lane] = 1.0f - f1;
        qs[F.lane] = siluf_(bf2f(pr[C_HQ + h * 128 + F.lane])); qs[64 + F.lane] = siluf_(bf2f(pr[C_HQ + h * 128 + 64 + F.lane]));
        const float v = bf2f(pr[C_HI + h * 128 + e]);
        asm volatile("s_waitcnt lgkmcnt(0)" ::: "memory");
        float o = 0.f;
#pragma unroll
        for (int d = 0; d < 64; ++d) { st[d] = fs[dh * 64 + d] * st[d] + ks[dh * 64 + d] * v; o += st[d] * qs[dh * 64 + d]; }
        o += __shfl_xor(o, 32);
        if (dh == 0) hraw[(size_t)(b * S + t) * 1024 + h * 128 + e] = o;
        asm volatile("s_waitcnt lgkmcnt(0)" ::: "memory");
    }
}
__device__ __forceinline__ void hgrn_norm_naive(KA a, Frame& F, int l) {
    const bf16* proj = (const bf16*)(a->ws + WS_PROJ); const float* hraw = (const float*)(a->ws + WS_HRAW); bf16* omix = (bf16*)(a->ws + WS_OMIX);
    const float* gn = (const float*)a->in[I_HNORM] + l * 1024;
    const int gw = F.vb * 8 + F.wave, NGW = F.G * 8;
    for (int i = gw; i < T * 8; i += NGW) { const int m = i >> 3, h = i & 7;
        const float o0 = hraw[(size_t)m * 1024 + h * 128 + F.lane], o1 = hraw[(size_t)m * 1024 + h * 128 + 64 + F.lane];
        const float r = rsqrtf(wave_sum(o0 * o0 + o1 * o1) * (1.0f / 128.0f) + EPS);
        const bf16* pr = proj + (size_t)m * NPROJ + C_HG + h * 128;
#ifdef EXP_NO_HGRN
        omix[(size_t)m * D + 1024 + h * 128 + F.lane] = 0; omix[(size_t)m * D + 1024 + h * 128 + 64 + F.lane] = 0; continue;
#endif
        omix[(size_t)m * D + 1024 + h * 128 + F.lane] = (bf16)f2bf(o0 * r * gn[h * 128 + F.lane] * sigmoidf_(bf2f(pr[F.lane])));
        omix[(size_t)m * D + 1024 + h * 128 + 64 + F.lane] = (bf16)f2bf(o1 * r * gn[h * 128 + 64 + F.lane] * sigmoidf_(bf2f(pr[64 + F.lane])));
    }
}

__device__ __forceinline__ void catt_naive(KA a, Frame& F) {
    const bf16* proj = (const bf16*)(a->ws + WS_PROJ); const float* kc = (const float*)(a->ws + WS_MISC + MS_KC); const float* vc = kc + (size_t)NB * 128 * 2 * 128;
    float* oacc = (float*)(a->ws + WS_OACC); unsigned* sel = (unsigned*)(a->ws + WS_MISC + MS_SEL);
    LAS float* qs = (LAS float*)(F.lds + F.wave * 2048); LAS float* ps = qs + 128;
    const int gw = F.vb * 8 + F.wave, NGW = F.G * 8;
    for (int i = gw; i < NB * 2 * S; i += NGW) {
        const int s = i % S, g = (i / S) & 1, b = i / (2 * S), m = b * S + s;
        const int nv = s >= 31 ? (s - 31) / 16 + 1 : 0;
        const bf16* pr = proj + (size_t)m * NPROJ;
        float imp = 0.f;
        for (int hh = 0; hh < 4; ++hh) {
            const int head = g * 4 + hh;
            qs[F.lane] = bf2f(pr[C_Q + head * 128 + F.lane]); qs[64 + F.lane] = bf2f(pr[C_Q + head * 128 + 64 + F.lane]);
            asm volatile("s_waitcnt lgkmcnt(0)" ::: "memory");
            float sc[2];
#pragma unroll
            for (int u = 0; u < 2; ++u) { const int n = F.lane + 64 * u; float acc = 0.f;
                if (n < nv) { const float* kr = kc + (((size_t)b * 128 + n) * 2 + g) * 128;
#pragma unroll 8
                    for (int d = 0; d < 128; ++d) acc += qs[d] * kr[d]; }
                sc[u] = (n < nv) ? acc * ATT_SCALE : -__builtin_inff(); }
            float mx = wave_max(fmaxf(sc[0], sc[1])); if (!(mx > -1e30f)) mx = 0.f;
            const float e0 = (F.lane < nv) ? __expf(sc[0] - mx) : 0.f, e1 = (F.lane + 64 < nv) ? __expf(sc[1] - mx) : 0.f;
            const float den = fmaxf(wave_sum(e0 + e1), 1e-30f);
            ps[F.lane] = e0 / den; ps[64 + F.lane] = e1 / den;
            asm volatile("s_waitcnt lgkmcnt(0)" ::: "memory");
            float o0 = 0.f, o1 = 0.f;
            for (int n = 0; n < nv; ++n) { const float p = ps[n]; const float* vr = vc + (((size_t)b * 128 + n) * 2 + g) * 128; o0 += p * vr[F.lane]; o1 += p * vr[64 + F.lane]; }
            const float g0 = sigmoidf_(bf2f(pr[C_GL + head * 3 + 0]));
            oacc[(size_t)m * 1024 + head * 128 + F.lane] = g0 * o0; oacc[(size_t)m * 1024 + head * 128 + 64 + F.lane] = g0 * o1;
            if (F.lane < 32) { const int j = F.lane; float v = ps[4 * j] + ps[4 * j + 1] + ps[4 * j + 2] + 0.5f * (4 * j + 3 < NCMP ? ps[4 * j + 3] : 0.f); if (j > 0) v += 0.5f * ps[4 * j - 1]; imp += v; }
            asm volatile("s_waitcnt lgkmcnt(0)" ::: "memory");
        }
        const int qb = s >> 6, j = F.lane & 31;
        const bool forced = (j == 0) || (j == qb) || (j + 1 == qb);
        const float score = forced ? __builtin_inff() : (j <= qb ? imp : -__builtin_inff());
        int rank = 0;
#pragma unroll
        for (int k = 0; k < 32; ++k) { const float o = __shfl(score, k); rank += (o > score || (o == score && k < j)) ? 1 : 0; }
        const unsigned long long bal = __ballot(F.lane < 32 && rank < 16 && j <= qb);
        if (F.lane == 0) sel[i] = (unsigned)bal;
    }
}

__device__ __forceinline__ float dot_rope(const LAS float* qs, const bf16* kr, const float* cr, const float* sr) {
    float acc = 0.f;
#pragma unroll
    for (int d = 0; d < 16; ++d) { const float k1 = bf2f(kr[d]), k2 = bf2f(kr[d + 16]), c = cr[d], sn = sr[d];
        acc += qs[d] * (k1 * c - k2 * sn) + qs[d + 16] * (k2 * c + k1 * sn); }
#pragma unroll 8
    for (int d = 32; d < 128; ++d) acc += qs[d] * bf2f(kr[d]);
    return acc;
}
__device__ __forceinline__ void satt_naive(KA a, Frame& F) {
    const bf16* proj = (const bf16*)(a->ws + WS_PROJ); const float* oacc = (const float*)(a->ws + WS_OACC); bf16* omix = (bf16*)(a->ws + WS_OMIX);
    const unsigned* sel = (const unsigned*)(a->ws + WS_MISC + MS_SEL);
    const float* rc = (const float*)(a->ws + WS_MISC + MS_ROPEC); const float* rs = (const float*)(a->ws + WS_MISC + MS_ROPES);
    LAS float* qs = (LAS float*)(F.lds + F.wave * 8192); LAS float* ps = qs + 128;
    const int gw = F.vb * 8 + F.wave, NGW = F.G * 8;
    for (int i = gw; i < NB * 8 * S; i += NGW) {
        const int s = i % S, head = (i / S) & 7, b = i / (8 * S), m = b * S + s, g = head >> 2;
        const bf16* pr = proj + (size_t)m * NPROJ;
        { const float q0 = bf2f(pr[C_Q + head * 128 + F.lane]), q1 = bf2f(pr[C_Q + head * 128 + 64 + F.lane]);
          float qo = q0; const float other = __shfl_xor(q0, 16);
          if (F.lane < 32) { const int dd = F.lane & 15; const float c = rc[m * 16 + dd], sn = rs[m * 16 + dd];
              qo = (F.lane < 16) ? q0 * c - other * sn : q0 * c + other * sn; }
          qs[F.lane] = qo; qs[64 + F.lane] = q1; }
        asm volatile("s_waitcnt lgkmcnt(0)" ::: "memory");
        float res0 = oacc[(size_t)m * 1024 + head * 128 + F.lane], res1 = oacc[(size_t)m * 1024 + head * 128 + 64 + F.lane];
        const float g1 = sigmoidf_(bf2f(pr[C_GL + head * 3 + 1])), g2 = sigmoidf_(bf2f(pr[C_GL + head * 3 + 2]));
        {
            const unsigned mask = sel[(b * 2 + g) * S + s];
            unsigned mm = mask; float mx = -__builtin_inff();
#pragma nounroll
            for (int u = 0; u < 16; ++u) { float v = -__builtin_inff();
                if (mm) { const int j = __builtin_ctz(mm); mm &= mm - 1; const int key = 64 * j + F.lane;
                    if (key <= s) { const int mk = b * S + key; v = dot_rope(qs, proj + (size_t)mk * NPROJ + C_KS + g * 128, rc + mk * 16, rs + mk * 16) * ATT_SCALE; } }
                ps[u * 64 + F.lane] = v; mx = fmaxf(mx, v); }
            mx = wave_max(mx);
            float sum = 0.f;
#pragma nounroll
            for (int u = 0; u < 16; ++u) { const float e = __expf(ps[u * 64 + F.lane] - mx); ps[u * 64 + F.lane] = e; sum += e; }
            sum = wave_sum(sum);
            asm volatile("s_waitcnt lgkmcnt(0)" ::: "memory");
            float o0 = 0.f, o1 = 0.f; mm = mask;
            for (int u = 0; u < 16 && mm; ++u) { const int j = __builtin_ctz(mm); mm &= mm - 1;
                const int kmax = min(63, s - 64 * j);
                for (int k = 0; k <= kmax; ++k) { const float p = ps[u * 64 + k]; const bf16* vr = proj + (size_t)(b * S + 64 * j + k) * NPROJ + C_VS + g * 128;
                    o0 += p * bf2f(vr[F.lane]); o1 += p * bf2f(vr[64 + F.lane]); } }
            res0 += g1 * o0 / sum; res1 += g1 * o1 / sum;
            asm volatile("s_waitcnt lgkmcnt(0)" ::: "memory");
        }
        {
            float mx = -__builtin_inff();
#pragma nounroll
            for (int u = 0; u < 8; ++u) { const int key = s - 511 + 64 * u + F.lane; float v = -__builtin_inff();
                if (key >= 0) { const int mk = b * S + key; v = dot_rope(qs, proj + (size_t)mk * NPROJ + C_KW + g * 128, rc + mk * 16, rs + mk * 16) * ATT_SCALE; }
                ps[u * 64 + F.lane] = v; mx = fmaxf(mx, v); }
            mx = wave_max(mx);
            float sum = 0.f;
#pragma nounroll
            for (int u = 0; u < 8; ++u) { const float e = __expf(ps[u * 64 + F.lane] - mx); ps[u * 64 + F.lane] = e; sum += e; }
            sum = wave_sum(sum);
            asm volatile("s_waitcnt lgkmcnt(0)" ::: "memory");
            float o0 = 0.f, o1 = 0.f;
            const int k0 = max(0, 511 - s);
            for (int k = k0; k < 512; ++k) { const float p = ps[k]; const bf16* vr = proj + (size_t)(b * S + s - 511 + k) * NPROJ + C_VW + g * 128;
                o0 += p * bf2f(vr[F.lane]); o1 += p * bf2f(vr[64 + F.lane]); }
            res0 += g2 * o0 / sum; res1 += g2 * o1 / sum;
            asm volatile("s_waitcnt lgkmcnt(0)" ::: "memory");
        }
#ifdef EXP_NO_NSA
        res0 = 0.f; res1 = 0.f;
#endif
        omix[(size_t)m * D + head * 128 + F.lane] = (bf16)f2bf(res0); omix[(size_t)m * D + head * 128 + 64 + F.lane] = (bf16)f2bf(res1);
    }
}

__device__ __forceinline__ void wave_argmax(float& v, int& i) {
#pragma unroll
    for (int o = 1; o < 64; o <<= 1) { const float ov = __shfl_xor(v, o); const int oi = __shfl_xor(i, o); if (ov > v || (ov == v && oi < i)) { v = ov; i = oi; } }
}
__device__ __forceinline__ void peer_topk(KA a, Frame& F, int l) {
    const bf16* pq = (const bf16*)(a->ws + WS_PQ); int* eidx = (int*)(a->ws + WS_EIDX); float* egate = (float*)(a->ws + WS_EGATE);
    const float* keys = (const float*)a->in[I_PKEYS] + (size_t)l * 8 * 2 * 128 * 128;
    LAS float* qs = (LAS float*)(F.lds + F.wave * 1024);
    const int gw = F.vb * 8 + F.wave, NGW = F.G * 8;
    const float NEG = -__builtin_inff();
    for (int i = gw; i < T * 8; i += NGW) {
        const int t = i >> 3, h = i & 7;
        const bf16* qr = pq + (size_t)t * D + h * 256;
#pragma unroll
        for (int u = 0; u < 4; ++u) qs[u * 64 + F.lane] = bf2f(qr[u * 64 + F.lane]);
        asm volatile("s_waitcnt lgkmcnt(0)" ::: "memory");
        float sv[2]; int si[2];
#pragma unroll
        for (int p = 0; p < 2; ++p) {
            const float* kp = keys + ((size_t)(h * 2 + p) * 128) * 128;
            float c0 = 0.f, c1 = 0.f;
#pragma unroll 4
            for (int d = 0; d < 128; ++d) { const float q = qs[p * 128 + d]; c0 += q * kp[(size_t)F.lane * 128 + d]; c1 += q * kp[(size_t)(F.lane + 64) * 128 + d]; }
            float tv = NEG; int ti = 0;
#pragma nounroll
            for (int r = 0; r < 16; ++r) {
                float bv; int bi; if (c1 > c0) { bv = c1; bi = F.lane + 64; } else { bv = c0; bi = F.lane; }
                wave_argmax(bv, bi);
                if (bi == F.lane) c0 = NEG; if (bi == F.lane + 64) c1 = NEG;
                if (F.lane == r) { tv = bv; ti = bi; }
            }
            sv[p] = tv; si[p] = ti;
        }
        float cv[4]; const int bsel = F.lane & 15; const float s2 = __shfl(sv[1], bsel);
#pragma unroll
        for (int r = 0; r < 4; ++r) cv[r] = __shfl(sv[0], (F.lane >> 4) + 4 * r) + s2;
        float tv = NEG; int tp = 0;
#pragma nounroll
        for (int r = 0; r < 16; ++r) {
            float bv = cv[0]; int bi = F.lane;
#pragma unroll
            for (int u = 1; u < 4; ++u) if (cv[u] > bv) { bv = cv[u]; bi = F.lane + 64 * u; }
            wave_argmax(bv, bi);
#pragma unroll
            for (int u = 0; u < 4; ++u) if (bi == F.lane + 64 * u) cv[u] = NEG;
            if (F.lane == r) { tv = bv; tp = bi; }
        }
        const int ia = __shfl(si[0], (tp >> 4) & 15), ib = __shfl(si[1], tp & 15);
        const float top = __shfl(tv, 0);
        float e = (F.lane < 16) ? __expf(tv - top) : 0.f;
        float sum = e;
#pragma unroll
        for (int o = 1; o < 16; o <<= 1) sum += __shfl_xor(sum, o);
        if (F.lane < 16) { eidx[(size_t)t * 128 + h * 16 + F.lane] = ia * 128 + ib; egate[(size_t)t * 128 + h * 16 + F.lane] = e / sum; }
    }
}

template <bool LAST>
__device__ __forceinline__ void peer_gather(KA a, Frame& F, int l, const float* x1, float* xo, const float* gate2  ) {
    const bf16* hb = (const bf16*)(a->ws + WS_H); const int* eidx = (const int*)(a->ws + WS_EIDX); const float* egate = (const float*)(a->ws + WS_EGATE);
    const bf16* pu = (const bf16*)(a->ws + WS_PU) + (size_t)l * 16384 * 2048; const bf16* pv = (const bf16*)(a->ws + WS_PV) + (size_t)l * 16384 * 2048;
    const int gw = F.vb * 8 + F.wave, NGW = F.G * 8;
    for (int t = gw; t < T; t += NGW) {
        v4u xh[4];
#pragma unroll
        for (int j = 0; j < 4; ++j) xh[j] = *(const v4u*)(hb + (size_t)t * D + 512 * j + 8 * F.lane);
        f32x2 acc[4][4];
#pragma unroll
        for (int j = 0; j < 4; ++j)
#pragma unroll
            for (int q = 0; q < 4; ++q) acc[j][q] = (f32x2){0.f, 0.f};
        const int* ei = eidx + (size_t)t * 128; const float* eg = egate + (size_t)t * 128;
#pragma unroll 2
        for (int k = 0; k < 128; ++k) {
            const int e = __builtin_amdgcn_readfirstlane(ei[k]); const float gk = __uint_as_float(__builtin_amdgcn_readfirstlane(__float_as_uint(eg[k])));
            const bf16* ur = pu + (size_t)e * 2048 + 8 * F.lane; const bf16* vr = pv + (size_t)e * 2048 + 8 * F.lane;
            v4u uu[4], vv[4];
#pragma unroll
            for (int j = 0; j < 4; ++j) { uu[j] = *(const v4u*)(ur + 512 * j); vv[j] = *(const v4u*)(vr + 512 * j); }
            float d = 0.f;
#pragma unroll
            for (int j = 0; j < 4; ++j) {
                const unsigned uw[4] = {uu[j].x, uu[j].y, uu[j].z, uu[j].w}, xw[4] = {xh[j].x, xh[j].y, xh[j].z, xh[j].w};
#pragma unroll
                for (int q = 0; q < 4; ++q) d += __uint_as_float(uw[q] << 16) * __uint_as_float(xw[q] << 16) + __uint_as_float(uw[q] & 0xffff0000u) * __uint_as_float(xw[q] & 0xffff0000u);
            }
            d = wave_sum(d);
            const float cf = gk * gelu_tanh(d);
#pragma unroll
            for (int j = 0; j < 4; ++j) {
                const unsigned w[4] = {vv[j].x, vv[j].y, vv[j].z, vv[j].w};
#pragma unroll
                for (int q = 0; q < 4; ++q) { const f32x2 vf = (f32x2){__uint_as_float(w[q] << 16), __uint_as_float(w[q] & 0xffff0000u)}; acc[j][q] += vf * cf; }
            }
        }
        const int b = t / S; const float* g2 = gate2 + (size_t)b * 12288;
        f32x4 o[4][2]; float ss = 0.f;
#pragma unroll
        for (int j = 0; j < 4; ++j)
#pragma unroll
            for (int hf = 0; hf < 2; ++hf) { const int c = 512 * j + 8 * F.lane + 4 * hf;
                const f32x4 xv = *(const f32x4*)(x1 + (size_t)t * D + c), gv = *(const f32x4*)(g2 + c);
                const f32x4 av = (f32x4){acc[j][2 * hf].x, acc[j][2 * hf].y, acc[j][2 * hf + 1].x, acc[j][2 * hf + 1].y};
#ifdef EXP_NO_PEER
                o[j][hf] = xv;
#elif defined(EXP_NEG_PEER)
                o[j][hf] = xv - gv * av;
#else
                o[j][hf] = xv + gv * av;
#endif
                ss += o[j][hf].x * o[j][hf].x + o[j][hf].y * o[j][hf].y + o[j][hf].z * o[j][hf].z + o[j][hf].w * o[j][hf].w; }
        if (LAST) { const float r = rsqrtf(wave_sum(ss) * (1.0f / D) + EPS); const float* fn = (const float*)a->in[I_FNORM];
#pragma unroll
            for (int j = 0; j < 4; ++j)
#pragma unroll
                for (int hf = 0; hf < 2; ++hf) { const int c = 512 * j + 8 * F.lane + 4 * hf; *(f32x4*)(xo + (size_t)t * D + c) = (o[j][hf] * r) * *(const f32x4*)(fn + c); } }
        else {
#pragma unroll
            for (int j = 0; j < 4; ++j)
#pragma unroll
                for (int hf = 0; hf < 2; ++hf) { const int c = 512 * j + 8 * F.lane + 4 * hf; *(f32x4*)(xo + (size_t)t * D + c) = o[j][hf]; } }
    }
}

#ifdef SKIP0
#define SK0(...)
#else
#define SK0(...) __VA_ARGS__
#endif
#ifdef SKIP1
#define SK1(...)
#else
#define SK1(...) __VA_ARGS__
#endif
#ifdef SKIP2
#define SK2(...)
#else
#define SK2(...) __VA_ARGS__
#endif
#ifdef SKIP3
#define SK3(...)
#else
#define SK3(...) __VA_ARGS__
#endif
#ifdef SKIP4
#define SK4(...)
#else
#define SK4(...) __VA_ARGS__
#endif
#ifdef SKIP5
#define SK5(...)
#else
#define SK5(...) __VA_ARGS__
#endif
#ifdef SKIP6
#define SK6(...)
#else
#define SK6(...) __VA_ARGS__
#endif

constexpr int NKIND = 12;
#define FRESH() ({ KA _p = (KA)__builtin_amdgcn_kernarg_segment_ptr(); asm volatile("" : "+s"(_p)); _p; })
template <int KIND>
__device__ __forceinline__ void run_phase(Frame& F, unsigned char* ws, const int l) {
    float* mod = (float*)(ws + WS_MOD);
    bf16* Hb = (bf16*)(ws + WS_H); bf16* proj = (bf16*)(ws + WS_PROJ); bf16* omix = (bf16*)(ws + WS_OMIX); bf16* pq = (bf16*)(ws + WS_PQ);
    float* XA = (float*)(ws + WS_XA); float* XB = (float*)(ws + WS_XB);
    const float* mod_l = mod + (size_t)l * 4 * 12288;
    if constexpr (KIND == 0) { SK0(p0_prologue(FRESH(), F);) }
    if constexpr (KIND == 1) { if (l == 0) norm_phase<true>(F, ws, (const float*)FRESH()->in[I_X], (const float*)FRESH()->in[I_NMIX], 0, 0, 2048, Hb); else norm_phase<false>(F, ws, XB, (const float*)FRESH()->in[I_NMIX] + l * D, l, 0, 2048, Hb); }
    if constexpr (KIND == 2) {
        pg8::Gemm g{Hb, (const bf16*)(ws + WS_WINT) + (size_t)l * NPROJ * D, T, NPROJ, D}; pg8::StaticOrder So; So.init(T, NPROJ, F.G, (int)blockIdx.x);
        pg8::EpiStoreBf16 E{proj, NPROJ};
        pg8::gemm_phase<pg8::EpiStoreBf16, pg8::StaticOrder, PG8_ALIGN, PG8_SP2>(F.lds, g, So, E);
    }
    if constexpr (KIND == 3) { SK1(cmp1_naive(FRESH(), F, l);) SK2(hgrn_naive(FRESH(), F, l);) }
    if constexpr (KIND == 4) { SK1(cmp2_naive(FRESH(), F, l);) }
    if constexpr (KIND == 5) { SK3(catt_naive(FRESH(), F);) }
    if constexpr (KIND == 6) { SK4(satt_naive(FRESH(), F);) SK2(hgrn_norm_naive(FRESH(), F, l);) }
    if constexpr (KIND == 7) {
        pg8::Gemm g{omix, (const bf16*)(ws + WS_WOUTT) + (size_t)l * D * D, T, D, D}; pg8::StaticOrder So; So.init(T, D, F.G, (int)blockIdx.x);
        pg8::EpiResGate E{(l == 0) ? (const float*)FRESH()->in[I_X] : XB, XA, D, mod_l + 2 * 2048, 12288, S};
        pg8::gemm_phase<pg8::EpiResGate, pg8::StaticOrder, PG8_ALIGN, PG8_SP2>(F.lds, g, So, E);
    }
    if constexpr (KIND == 8) norm_phase<false>(F, ws, XA, (const float*)FRESH()->in[I_NFFN] + l * D, l, 3 * 2048, 4 * 2048, Hb);
    if constexpr (KIND == 9) {
        pg8::Gemm g{Hb, (const bf16*)(ws + WS_WQT) + (size_t)l * D * D, T, D, D}; pg8::StaticOrder So; So.init(T, D, F.G, (int)blockIdx.x);
        pg8::EpiStoreBf16 E{pq, D};
        pg8::gemm_phase<pg8::EpiStoreBf16, pg8::StaticOrder, PG8_ALIGN, PG8_SP2>(F.lds, g, So, E);
    }
    if constexpr (KIND == 10) { SK5(peer_topk(FRESH(), F, l);) }
    if constexpr (KIND == 11) {
        SK6(if (l == DEPTH - 1) peer_gather<true>(FRESH(), F, l, XA, FRESH()->out, mod_l + 5 * 2048);
        else peer_gather<false>(FRESH(), F, l, XA, XB, mod_l + 5 * 2048);)
    }
}
__device__ __forceinline__ void frame_init(Frame& F, unsigned char* lds_raw) {
    F.lds = (LAS unsigned char*)lds_raw;
    F.tid = threadIdx.x; F.lane = F.tid & 63; F.wave = __builtin_amdgcn_readfirstlane(F.tid >> 6);
    F.G = gridDim.x; { const int bx = blockIdx.x; F.vb = (F.G % 8 == 0) ? (bx % 8) * (F.G / 8) + bx / 8 : bx; }
}
#if !MK_ONE_LAUNCH
template <int KIND>
__global__ void __launch_bounds__(512, 2) k_phase(Args a) {
    extern __shared__ __attribute__((aligned(16))) unsigned char lds_raw[];
    Frame F; frame_init(F, lds_raw);
    run_phase<KIND>(F, a.ws, a.layer);
}
#else
__global__ void __launch_bounds__(512, 2) trunk_fwd(Args a) {
    extern __shared__ __attribute__((aligned(16))) unsigned char lds_raw[];
    Frame F; frame_init(F, lds_raw);
    volatile LAS unsigned* MISC = (volatile LAS unsigned*)(F.lds + MISC_OFF);
    if (F.tid < 32) MISC[F.tid] = 0u;
    __syncthreads();
    unsigned char* ws = a.ws;
    XcdBarrier bar = xcd_barrier_post((unsigned*)(ws + WS_CTL) + CW_BAR, MISC + 8);
    run_phase<0>(F, ws, 0); xcd_barrier(bar);
#pragma unroll
    for (int l = 0; l < DEPTH; ++l) {
        run_phase<1>(F, ws, l); xcd_barrier(bar);
        run_phase<2>(F, ws, l); xcd_barrier(bar);
        run_phase<3>(F, ws, l); xcd_barrier(bar);
        run_phase<4>(F, ws, l); xcd_barrier(bar);
        run_phase<5>(F, ws, l); xcd_barrier(bar);
        run_phase<6>(F, ws, l); xcd_barrier(bar);
        run_phase<7>(F, ws, l); xcd_barrier(bar);
        run_phase<8>(F, ws, l); xcd_barrier(bar);
        run_phase<9>(F, ws, l); xcd_barrier(bar);
        run_phase<10>(F, ws, l); xcd_barrier(bar);
        run_phase<11>(F, ws, l); if (l + 1 < DEPTH) xcd_barrier(bar);
    }
}
#endif

template <class KF> static bool prep_kernel(KF kf) {
    if (hipFuncSetAttribute((const void*)kf, hipFuncAttributeMaxDynamicSharedMemorySize, LDS_BYTES) != hipSuccess) { fprintf(stderr, "kernel_launch: hipFuncSetAttribute failed\n"); return false; }
    return true;
}
extern "C" void kernel_launch(void* const* d_in, const int* in_sizes, int n_in, void* d_out, int out_size, void* d_ws, size_t ws_size, hipStream_t stream) {
    static int grid = 0;
    if (grid == 0) {
        if (n_in != 26 || out_size != T * D || ws_size < WS_END) { fprintf(stderr, "kernel_launch: unexpected problem (n_in %d, out %d, ws %zu, need %zu)\n", n_in, out_size, ws_size, (size_t)WS_END); grid = -1; return; }
        int dev = 0, cus = 0;
        if (hipGetDevice(&dev) != hipSuccess || hipDeviceGetAttribute(&cus, hipDeviceAttributeMultiprocessorCount, dev) != hipSuccess) { grid = -1; return; }
        bool ok = true;
#if MK_ONE_LAUNCH
        ok = prep_kernel(trunk_fwd);
        int per_cu = 0;
        if (hipOccupancyMaxActiveBlocksPerMultiprocessor(&per_cu, (const void*)trunk_fwd, 512, LDS_BYTES) != hipSuccess || per_cu < 1) { fprintf(stderr, "kernel_launch: occupancy query says %d\n", per_cu); }
#else
        ok = prep_kernel(k_phase<0>) && prep_kernel(k_phase<1>) && prep_kernel(k_phase<2>) && prep_kernel(k_phase<3>) && prep_kernel(k_phase<4>) && prep_kernel(k_phase<5>) && prep_kernel(k_phase<6>)
          && prep_kernel(k_phase<7>) && prep_kernel(k_phase<8>) && prep_kernel(k_phase<9>) && prep_kernel(k_phase<10>) && prep_kernel(k_phase<11>);
#endif
        (void)hipGetLastError();
        if (!ok) { grid = -1; return; }
        grid = cus;
    }
    if (grid < 0) return;
    (void)hipMemsetAsync((char*)d_ws + WS_CTL, 0, CTL_ZERO_BYTES, stream);
    Args a{};
    for (int i = 0; i < 26; ++i) a.in[i] = d_in[i];
    a.out = (float*)d_out; a.ws = (unsigned char*)d_ws; a.layer = 0; a.pad = 0;
#if MK_ONE_LAUNCH
    hipLaunchKernelGGL(trunk_fwd, dim3(grid), dim3(512), LDS_BYTES, stream, a);
#else
    hipLaunchKernelGGL(k_phase<0>, dim3(grid), dim3(512), LDS_BYTES, stream, a);
    for (int l = 0; l < DEPTH; ++l) { a.layer = l;
        hipLaunchKernelGGL(k_phase<1>, dim3(grid), dim3(512), LDS_BYTES, stream, a);
        hipLaunchKernelGGL(k_phase<2>, dim3(grid), dim3(512), LDS_BYTES, stream, a);
        hipLaunchKernelGGL(k_phase<3>, dim3(grid), dim3(512), LDS_BYTES, stream, a);
        hipLaunchKernelGGL(k_phase<4>, dim3(grid), dim3(512), LDS_BYTES, stream, a);
        hipLaunchKernelGGL(k_phase<5>, dim3(grid), dim3(512), LDS_BYTES, stream, a);
        hipLaunchKernelGGL(k_phase<6>, dim3(grid), dim3(512), LDS_BYTES, stream, a);
        hipLaunchKernelGGL(k_phase<7>, dim3(grid), dim3(512), LDS_BYTES, stream, a);
        hipLaunchKernelGGL(k_phase<8>, dim3(grid), dim3(512), LDS_BYTES, stream, a);
        hipLaunchKernelGGL(k_phase<9>, dim3(grid), dim3(512), LDS_BYTES, stream, a);
        hipLaunchKernelGGL(k_phase<10>, dim3(grid), dim3(512), LDS_BYTES, stream, a);
        hipLaunchKernelGGL(k_phase<11>, dim3(grid), dim3(512), LDS_BYTES, stream, a);
    }
#endif
}
```

```cpp
#include <hip/hip_runtime.h>
#include <cstdio>
#include <cstdint>
#ifndef MK_ONE_LAUNCH
#define MK_ONE_LAUNCH 1
#endif
namespace pg8 {
#define PG8_LAS __attribute__((address_space(3)))
typedef unsigned short bf16_t;
typedef short bf16x8 __attribute__((ext_vector_type(8)));
typedef float f32x4 __attribute__((ext_vector_type(4)));
typedef unsigned u32x4 __attribute__((ext_vector_type(4)));
constexpr int BM = 256, BK = 64, HALF = 128, HTB = HALF * BK * 2  , STAGE_BYTES = 8 * HTB, NXCD = 8, WGM = 8;

__host__ __device__ __forceinline__ int lds_byte(int r, int c) { const int st = (r >> 4) * 2 + (c >> 5), rr = r & 15, cc = c & 31, ob = rr * 64 + cc * 2; return st * 1024 + (ob ^ (((ob >> 9) & 1) << 5)); }
__host__ __device__ __forceinline__ void stage_rc(int b, int& R, int& C) { const int st = b / 1024, sb = b % 1024, swz = sb ^ (((sb >> 9) & 1) << 5); R = (st >> 1) * 16 + swz / 64; C = (st & 1) * 32 + (swz % 64) / 2; }
__host__ __device__ __forceinline__ int perm32(int rho) { const int n = rho >> 4, i = rho & 15; return 8 * (i >> 2) + 4 * n + (i & 3); }

struct Unit { int pm, pn; };
struct Gemm { const bf16_t* A; const bf16_t* Bt; int M, N, K; };

struct StaticOrder {
    int nM, nN, nwg, G, c;
    __host__ __device__ void init(int M, int N, int G_, int c_) { nM = M / BM; nN = N / BM; nwg = nM * nN; G = G_; c = c_; }
    __host__ __device__ bool next(int i, Unit& u) const {
        const long L = (long)i * G + c; if (L >= nwg) return false;
        int wgid = (int)L; { const int q = nwg / NXCD, r = nwg % NXCD, xcd = wgid % NXCD, off = wgid / NXCD; wgid = (xcd < r ? xcd * (q + 1) : r * (q + 1) + (xcd - r) * q) + off; }
        const int nig = WGM * nN, gid = wgid / nig, fm = gid * WGM, gsz = (nM - fm) < WGM ? (nM - fm) : WGM;
        u.pm = fm + ((wgid % nig) % gsz); u.pn = (wgid % nig) / gsz; return true;
    }
    __device__ __forceinline__ void a_ready(const Unit&) const {}
    __device__ __forceinline__ void done(const Unit&) const {}
};

__device__ __forceinline__ unsigned cvt_pk_bf16(float lo, float hi) { unsigned r; asm volatile("v_cvt_pk_bf16_f32 %0, %1, %2" : "=v"(r) : "v"(lo), "v"(hi)); return r; }
typedef float f32x2 __attribute__((ext_vector_type(2)));
struct EpiStoreBf16 {
    static constexpr bool PERM = true, AFTER_DRAIN = false;
    bf16_t* O; int ldc;
    __device__ __forceinline__ void operator()(const f32x4 (&acc)[2][2][4][2], const Unit& u, int wr, int wc, int fr, int fq) const {
        const int row0 = u.pm * BM + wr * 64 + fr, col0 = u.pn * BM + wc * 32 + 8 * fq;
#pragma unroll
        for (int ai = 0; ai < 2; ++ai)
#pragma unroll
            for (int m = 0; m < 4; ++m) { bf16_t* rowp = O + (size_t)(row0 + ai * HALF + m * 16) * ldc + col0;
#pragma unroll
                for (int bj = 0; bj < 2; ++bj) { const f32x4 v0 = acc[ai][bj][m][0], v1 = acc[ai][bj][m][1];
                    u32x4 w; w.x = cvt_pk_bf16(v0[0], v0[1]); w.y = cvt_pk_bf16(v0[2], v0[3]); w.z = cvt_pk_bf16(v1[0], v1[1]); w.w = cvt_pk_bf16(v1[2], v1[3]);
                    *(u32x4*)(rowp + bj * HALF) = w; } }
    }
};
struct EpiResGate {
    static constexpr bool PERM = false, AFTER_DRAIN = false;
    const float* base; float* out; int ldc; const float* gate; int gate_stride; int rows_per_b;
    __device__ __forceinline__ void operator()(const f32x4 (&acc)[2][2][4][2], const Unit& u, int wr, int wc, int fr, int fq) const {
        const int row0 = u.pm * BM + wr * 64 + fr, col0 = u.pn * BM + wc * 32 + 4 * fq;
        const float* gp = gate + (size_t)((u.pm * BM) / rows_per_b) * gate_stride + col0;
        f32x4 gv[2][2];
#pragma unroll
        for (int bj = 0; bj < 2; ++bj)
#pragma unroll
            for (int n = 0; n < 2; ++n) gv[bj][n] = *(const f32x4*)(gp + bj * HALF + n * 16);
#pragma unroll
        for (int ai = 0; ai < 2; ++ai)
#pragma unroll
            for (int m = 0; m < 4; ++m) { const size_t off = (size_t)(row0 + ai * HALF + m * 16) * ldc + col0;
#pragma unroll
                for (int bj = 0; bj < 2; ++bj)
#pragma unroll
                    for (int n = 0; n < 2; ++n) { const f32x4 x = *(const f32x4*)(base + off + bj * HALF + n * 16);

#ifdef EXP_NO_MIX
                        *(f32x4*)(out + off + bj * HALF + n * 16) = x; } }
#else
                        *(f32x4*)(out + off + bj * HALF + n * 16) = x + gv[bj][n] * acc[ai][bj][m][n]; } }
#endif
    }
};

template <class Epi, class Sched, bool ALIGN_EPI = false, bool SP2 = false>
__device__ __forceinline__ void gemm_phase(PG8_LAS unsigned char* lds, const Gemm g, const Sched& S, const Epi& E) {
    int tid_l = threadIdx.x; asm volatile("" : "+v"(tid_l));
    const int tid = tid_l, wid = __builtin_amdgcn_readfirstlane(tid >> 6), lane = tid & 63, wr = wid >> 2, wc = wid & 3, fr = lane & 15, fq = lane >> 4;
    const int K = g.K, nt = K / BK;
    unsigned voffA[2], voffB[2];
#pragma unroll
    for (int i = 0; i < 2; ++i) { int R, C; stage_rc(tid * 16 + i * 8192, R, C); const int Rb = Epi::PERM ? ((R & ~31) + perm32(R & 31)) : R;
        voffA[i] = (unsigned)(R * K + C) * 2u; voffB[i] = (unsigned)(Rb * K + C) * 2u; }
    const size_t kstep = (size_t)(BK * 2);
    const size_t hstep = (size_t)HALF * K * 2;
    const size_t tstep = 2 * hstep;
    const unsigned ldsw = (unsigned)wid * 1024u;
    const int aoff = lds_byte(wr * 64 + fr, fq * 8), boff = lds_byte(wc * 32 + fr, fq * 8);
#define PG8_SA(b, h) (((b) * 2 + (h)) * HTB)
#define PG8_SB(b, h) ((4 + (b) * 2 + (h)) * HTB)
#define PG8_STAGE(bufoff, gbase, voff) do { _Pragma("unroll") for (int _i = 0; _i < 2; ++_i) \
        __builtin_amdgcn_global_load_lds((const unsigned*)((const char*)(gbase) + (voff)[_i]), (PG8_LAS unsigned*)(lds + (bufoff) + ldsw + _i * 8192), 16, 0, 0); } while (0)
#define PG8_LDA(dst, b, h) do { _Pragma("unroll") for (int m = 0; m < 4; ++m) _Pragma("unroll") for (int k = 0; k < 2; ++k) dst[m][k] = *(const PG8_LAS bf16x8*)(lds + PG8_SA(b, h) + aoff + m * 2048 + k * 1024); } while (0)
#define PG8_LDB(dst, b, h) do { _Pragma("unroll") for (int n = 0; n < 2; ++n) _Pragma("unroll") for (int k = 0; k < 2; ++k) dst[n][k] = *(const PG8_LAS bf16x8*)(lds + PG8_SB(b, h) + boff + n * 2048 + k * 1024); } while (0)
#define PG8_MMA(ai, bj, At, Bt) do { __builtin_amdgcn_s_setprio(1); _Pragma("unroll") for (int m = 0; m < 4; ++m) _Pragma("unroll") for (int n = 0; n < 2; ++n) _Pragma("unroll") for (int k = 0; k < 2; ++k) \
        acc[ai][bj][m][n] = __builtin_amdgcn_mfma_f32_16x16x32_bf16(Bt[n][k], At[m][k], acc[ai][bj][m][n], 0, 0, 0); __builtin_amdgcn_s_setprio(0); } while (0)
#define PG8_WAIT_V(n) asm volatile("s_waitcnt vmcnt(" #n ")" ::: "memory")
#define PG8_WAIT_L(n) asm volatile("s_waitcnt lgkmcnt(" #n ")" ::: "memory")
#define PG8_BAR __builtin_amdgcn_s_barrier()
#define PG8_SCHED __builtin_amdgcn_sched_barrier(0)
    Unit cur, nxt; int ui = 0;
    if (!S.next(0, cur)) return;
    f32x4 acc[2][2][4][2];
#pragma unroll
    for (int a = 0; a < 2; ++a)
#pragma unroll
        for (int b = 0; b < 2; ++b)
#pragma unroll
            for (int m = 0; m < 4; ++m)
#pragma unroll
                for (int n = 0; n < 2; ++n) acc[a][b][m][n] = (f32x4){0.f, 0.f, 0.f, 0.f};
    bf16x8 At[4][2], B0[2][2], B1[2][2];
    const char* cA = (const char*)g.A + (size_t)cur.pm * tstep; const char* cB = (const char*)g.Bt + (size_t)cur.pn * tstep;
    S.a_ready(cur);
    if constexpr (SP2) {
        PG8_STAGE(PG8_SB(0, 0), cB, voffB); PG8_STAGE(PG8_SB(0, 1), cB + hstep, voffB); PG8_STAGE(PG8_SA(0, 0), cA, voffA); PG8_STAGE(PG8_SA(0, 1), cA + hstep, voffA);
        if (wr == 1) PG8_BAR;
        PG8_WAIT_V(2); PG8_BAR;
        PG8_STAGE(PG8_SB(1, 0), cB + kstep, voffB); PG8_STAGE(PG8_SA(1, 0), cA + kstep, voffA); PG8_STAGE(PG8_SB(1, 1), cB + hstep + kstep, voffB);
        PG8_WAIT_V(6); PG8_BAR;
    } else {
        PG8_STAGE(PG8_SB(0, 0), cB, voffB); PG8_STAGE(PG8_SA(0, 0), cA, voffA); PG8_STAGE(PG8_SB(0, 1), cB + hstep, voffB); PG8_STAGE(PG8_SA(0, 1), cA + hstep, voffA);
        if (wr == 1) PG8_BAR;
        PG8_WAIT_V(4); PG8_BAR;
        PG8_STAGE(PG8_SB(1, 0), cB + kstep, voffB); PG8_STAGE(PG8_SA(1, 0), cA + kstep, voffA); PG8_STAGE(PG8_SB(1, 1), cB + hstep + kstep, voffB);
        PG8_WAIT_V(6); PG8_BAR;
    }
    for (;;) {
        const bool has_next = S.next(ui + 1, nxt);
        const char* nA = has_next ? (const char*)g.A + (size_t)nxt.pm * tstep : cA; const char* nB = has_next ? (const char*)g.Bt + (size_t)nxt.pn * tstep : cB;
        for (int t = 0; t < nt; t += 2) {
            const bool last = (t == nt - 2);
            const char* a1 = cA + (size_t)(t + 1) * kstep;
            const char* a2 = last ? nA : cA + (size_t)(t + 2) * kstep; const char* b2 = last ? nB : cB + (size_t)(t + 2) * kstep;
            const char* a3 = a2 + kstep; const char* b3 = b2 + kstep;
            if (last && has_next) S.a_ready(nxt);
            if constexpr (SP2) {
            PG8_LDB(B0, 0, 0); PG8_LDB(B1, 0, 1); PG8_SCHED; PG8_LDA(At, 0, 0); PG8_STAGE(PG8_SA(1, 1), a1 + hstep, voffA);
            PG8_WAIT_V(8); PG8_WAIT_L(0); PG8_BAR; PG8_MMA(0, 0, At, B0); PG8_MMA(0, 1, At, B1); PG8_BAR; PG8_SCHED;
            PG8_LDA(At, 0, 1); PG8_STAGE(PG8_SB(0, 0), b2, voffB); PG8_STAGE(PG8_SB(0, 1), b2 + hstep, voffB); PG8_STAGE(PG8_SA(0, 0), a2, voffA);
            PG8_WAIT_V(8); PG8_WAIT_L(0); PG8_BAR; PG8_MMA(1, 0, At, B0); PG8_MMA(1, 1, At, B1); PG8_BAR; PG8_SCHED;
            PG8_LDB(B0, 1, 0); PG8_LDB(B1, 1, 1); PG8_SCHED; PG8_LDA(At, 1, 0); PG8_STAGE(PG8_SA(0, 1), a2 + hstep, voffA);
            PG8_WAIT_V(8); PG8_WAIT_L(0); PG8_BAR; PG8_MMA(0, 0, At, B0); PG8_MMA(0, 1, At, B1); PG8_BAR; PG8_SCHED;
            PG8_LDA(At, 1, 1); PG8_STAGE(PG8_SB(1, 0), b3, voffB); PG8_STAGE(PG8_SB(1, 1), b3 + hstep, voffB); PG8_STAGE(PG8_SA(1, 0), a3, voffA);
            PG8_WAIT_V(8); PG8_WAIT_L(0); PG8_BAR; PG8_MMA(1, 0, At, B0); PG8_MMA(1, 1, At, B1); PG8_BAR; PG8_SCHED;
            } else {
            PG8_LDB(B0, 0, 0); PG8_SCHED; PG8_LDA(At, 0, 0); PG8_STAGE(PG8_SA(1, 1), a1 + hstep, voffA);
            PG8_WAIT_L(8); PG8_BAR; PG8_WAIT_L(0); PG8_MMA(0, 0, At, B0); PG8_BAR; PG8_SCHED;
            PG8_LDB(B1, 0, 1); PG8_STAGE(PG8_SB(0, 0), b2, voffB);
            PG8_BAR; PG8_WAIT_L(0); PG8_MMA(0, 1, At, B1); PG8_BAR;
            PG8_LDA(At, 0, 1); PG8_STAGE(PG8_SA(0, 0), a2, voffA);
            PG8_BAR; PG8_WAIT_L(0); PG8_MMA(1, 0, At, B0); PG8_BAR; PG8_SCHED;
            PG8_STAGE(PG8_SB(0, 1), b2 + hstep, voffB);
            PG8_WAIT_V(6); PG8_BAR; PG8_MMA(1, 1, At, B1); PG8_BAR;
            PG8_LDB(B0, 1, 0); PG8_SCHED; PG8_LDA(At, 1, 0); PG8_STAGE(PG8_SA(0, 1), a2 + hstep, voffA);
            PG8_WAIT_L(8); PG8_BAR; PG8_WAIT_L(0); PG8_MMA(0, 0, At, B0); PG8_BAR; PG8_SCHED;
            PG8_LDB(B1, 1, 1); PG8_STAGE(PG8_SB(1, 0), b3, voffB);
            PG8_BAR; PG8_WAIT_L(0); PG8_MMA(0, 1, At, B1); PG8_BAR;
            PG8_LDA(At, 1, 1); PG8_STAGE(PG8_SA(1, 0), a3, voffA);
            PG8_BAR; PG8_WAIT_L(0); PG8_MMA(1, 0, At, B0); PG8_BAR; PG8_SCHED;
            PG8_STAGE(PG8_SB(1, 1), b3 + hstep, voffB);
            PG8_WAIT_V(6); PG8_BAR; PG8_MMA(1, 1, At, B1); PG8_BAR;
            }
        }
        if constexpr (ALIGN_EPI) { if (wr == 0) PG8_BAR; }
        if constexpr (!Epi::AFTER_DRAIN) { E(acc, cur, wr, wc, fr, fq); S.done(cur); }
        if (!has_next) break;
#pragma unroll
        for (int a = 0; a < 2; ++a)
#pragma unroll
            for (int b = 0; b < 2; ++b)
#pragma unroll
                for (int m = 0; m < 4; ++m)
#pragma unroll
                    for (int n = 0; n < 2; ++n) acc[a][b][m][n] = (f32x4){0.f, 0.f, 0.f, 0.f};
        cur = nxt; cA = nA; cB = nB; ++ui;
        if constexpr (ALIGN_EPI) { if (wr == 1) PG8_BAR; }
    }
    PG8_WAIT_V(0);
    if constexpr (!ALIGN_EPI) { if (wr == 0) PG8_BAR; }
    PG8_BAR;
    if constexpr (Epi::AFTER_DRAIN) { E.fused(acc, cur, wr, wc, fr, fq, lds, wid, lane); S.done(cur); }
#undef PG8_SA
#undef PG8_SB
#undef PG8_STAGE
#undef PG8_LDA
#undef PG8_LDB
#undef PG8_MMA
#undef PG8_WAIT_V
#undef PG8_WAIT_L
#undef PG8_BAR
#undef PG8_SCHED
}
}

#ifndef PG8_SP2
#define PG8_SP2 true
#endif
#ifndef PG8_ALIGN
#define PG8_ALIGN true
#endif
#define GAS __attribute__((address_space(1)))
#define LAS __attribute__((address_space(3)))
typedef unsigned short bf16;
typedef unsigned v4u __attribute__((ext_vector_type(4)));
typedef unsigned v2u __attribute__((ext_vector_type(2)));
typedef float f32x4 __attribute__((ext_vector_type(4)));
typedef float f32x2 __attribute__((ext_vector_type(2)));
typedef short bf16x8 __attribute__((ext_vector_type(8)));
typedef __bf16 bf16x2_t __attribute__((ext_vector_type(2)));
typedef GAS unsigned gu32;

constexpr int NB = 4, S = 2048, D = 2048, T = NB * S, DEPTH = 2;
constexpr int INW = 6680, NPROJ = 6912;
constexpr int C_Q = 0, C_KC = 1024, C_VC = 1280, C_KS = 1536, C_VS = 1792, C_KW = 2048, C_VW = 2304, C_HQ = 2560, C_HF = 3584, C_HI = 4608, C_HG = 5632, C_GL = 6656;
constexpr int NCMP = 127;
constexpr float EPS = 1e-6f;
constexpr float ATT_SCALE = 0.08838834764831845f;
__host__ __device__ __forceinline__ int winmap(int n) { return n < 2560 ? n : (n < 2584 ? C_GL + (n - 2560) : n - 24); }

constexpr size_t MiB = 1u << 20;
constexpr size_t WS_CTL = 0, CTL_ZERO_BYTES = 2 * MiB;
constexpr size_t WS_MOD = 256 * 1024;
constexpr size_t WS_B1P = 1 * MiB;
constexpr size_t WS_WINT = 2 * MiB, WS_WOUTT = 56 * MiB, WS_WQT = 72 * MiB, WS_W1T = 88 * MiB, WS_PU = 96 * MiB, WS_PV = 224 * MiB;
constexpr size_t WS_H = 352 * MiB, WS_PROJ = 384 * MiB, WS_OMIX = 492 * MiB, WS_OACC = 524 * MiB, WS_XA = 556 * MiB, WS_XB = 620 * MiB;
constexpr size_t WS_PQ = 684 * MiB, WS_EIDX = 716 * MiB, WS_EGATE = 720 * MiB, WS_MISC = 724 * MiB, WS_HRAW = 732 * MiB, WS_PARTS = 764 * MiB, WS_END = 772 * MiB;
constexpr size_t MS_KC = 0, MS_ROPEC = 1 * MiB, MS_ROPES = 1 * MiB + 512 * 1024, MS_SEL = 2 * MiB, MS_HID = 4 * MiB;
constexpr int CW_BAR = 4096;

constexpr int LDS_BYTES = 147456;
constexpr int MISC_OFF = 131072 + 320;

#define RLX_AGENT __ATOMIC_RELAXED, __HIP_MEMORY_SCOPE_AGENT
__device__ __forceinline__ float bf2f(bf16 b) { return __uint_as_float(((unsigned)b) << 16); }
__device__ __forceinline__ unsigned f2bf(float f) { unsigned u = __float_as_uint(f); return (u + 0x7fffu + ((u >> 16) & 1u)) >> 16; }
__device__ __forceinline__ unsigned pk2(float lo, float hi) { return f2bf(lo) | (f2bf(hi) << 16); }
__device__ __forceinline__ float wave_sum(float v) {
#pragma unroll
    for (int o = 1; o < 64; o <<= 1) v += __shfl_xor(v, o);
    return v;
}
__device__ __forceinline__ float wave_max(float v) {
#pragma unroll
    for (int o = 1; o < 64; o <<= 1) v = fmaxf(v, __shfl_xor(v, o));
    return v;
}
__device__ __forceinline__ float sigmoidf_(float x) { return 1.0f / (1.0f + __expf(-x)); }
__device__ __forceinline__ float siluf_(float x) { return x / (1.0f + __expf(-x)); }
__device__ __forceinline__ float gelu_tanh(float x) { const float u = 0.7978845608028654f * (x + 0.044715f * x * x * x); const float e = __expf(2.0f * u); return 0.5f * x * (1.0f + (1.0f - 2.0f / (e + 1.0f))); }
#define XB_TMO      128
#define XB_XCNT(j)  (256  + 64 * (j))
#define XB_XSUB(j)  (1280 + 64 * (j))
#define XB_XGEN(j)  (2304 + 64 * (j))
#define XB_TOP      3328
#define XB_TOPGEN   3392
#define XCD_BAR_WORDS 3456
#define XB_SPIN_CAP (1u << 18)

__device__ __forceinline__ unsigned xb_ld(unsigned* p)              { return __hip_atomic_load(p, __ATOMIC_RELAXED, __HIP_MEMORY_SCOPE_AGENT); }
__device__ __forceinline__ unsigned xb_add(unsigned* p, unsigned v) { return __hip_atomic_fetch_add(p, v, __ATOMIC_RELAXED, __HIP_MEMORY_SCOPE_AGENT); }
__device__ __forceinline__ unsigned xb_xcc_id() { return (unsigned)__builtin_amdgcn_s_getreg((3 << 11) | 20) & 0xFu; }
#define XB_SPIN(cond, bar) do { unsigned _sp = 0; while (cond) { __builtin_amdgcn_s_sleep(1); \
    if ((++_sp & 255u) == 0u) { if (xb_ld(&(bar)[XB_TMO])) break; if (_sp > XB_SPIN_CAP) { atomicAdd(&(bar)[XB_TMO], 1u); break; } } } } while (0)

struct XcdBarrier {
    unsigned* bar; unsigned x;
    volatile LAS unsigned* st;
};

__device__ __forceinline__ XcdBarrier xcd_barrier_post(unsigned* bar, volatile LAS unsigned* st) {
    XcdBarrier b; b.bar = bar; b.x = xb_xcc_id(); b.st = st;
    if (threadIdx.x == 0) (void)xb_add(&bar[XB_XCNT(b.x)], 1u);
    return b;
}
__device__ __forceinline__ void xcd_barrier_complete(unsigned* bar, unsigned x, unsigned& nloc, unsigned& nx) {
    const unsigned G = gridDim.x * gridDim.y * gridDim.z;
    unsigned sum, cnt, mine, sp = 0u;
    for (;;) {
        sum = 0u; cnt = 0u; mine = 0u;
#pragma unroll
        for (unsigned j = 0; j < 16; ++j) { const unsigned c = xb_ld(&bar[XB_XCNT(j)]); sum += c; cnt += (c > 0u) ? 1u : 0u; mine = (j == x) ? c : mine; }
        if (sum == G) break;
        __builtin_amdgcn_s_sleep(1);
        if ((++sp & 255u) == 0u) { if (xb_ld(&bar[XB_TMO])) break; if (sp > XB_SPIN_CAP) { atomicAdd(&bar[XB_TMO], 1u); break; } }
    }
    nloc = mine > 0u ? mine : 1u; nx = cnt > 0u ? cnt : 1u;
}

__device__ __forceinline__ void xcd_barrier(const XcdBarrier& b) {
    asm volatile("s_waitcnt vmcnt(0)" ::: "memory");
    __syncthreads();
    if (threadIdx.x == 0) {
        unsigned* bar = b.bar;
        __builtin_amdgcn_s_waitcnt(0);
        unsigned nloc = b.st[0], nx = b.st[1];
        if (nloc == 0u) { xcd_barrier_complete(bar, b.x, nloc, nx); b.st[0] = nloc; b.st[1] = nx; }
        const unsigned old = xb_add(&bar[XB_XSUB(b.x)], 1u);
        const unsigned gen = old / nloc;
        if (old + 1u == (gen + 1u) * nloc) {
            __builtin_amdgcn_fence(__ATOMIC_RELEASE, "agent");
            asm volatile("s_waitcnt vmcnt(0)" ::: "memory");
            const unsigned og = xb_add(&bar[XB_TOP], 1u);
            const unsigned tg = og / nx;
            if (og + 1u == (tg + 1u) * nx) xb_add(&bar[XB_TOPGEN], 1u);
            else XB_SPIN(xb_ld(&bar[XB_TOPGEN]) == tg, bar);
            __builtin_amdgcn_fence(__ATOMIC_ACQUIRE, "agent");
            xb_add(&bar[XB_XGEN(b.x)], 1u);
            asm volatile("s_waitcnt vmcnt(0)" ::: "memory");
        } else {
            XB_SPIN(xb_ld(&bar[XB_XGEN(b.x)]) == gen, bar);
            __builtin_amdgcn_fence(__ATOMIC_ACQUIRE, "agent");
            asm volatile("s_waitcnt vmcnt(0)" ::: "memory");
        }
    }
    __syncthreads();
}

struct Args { const void* in[26]; float* out; unsigned char* ws; int layer, pad; };
typedef const __attribute__((address_space(4))) Args* KA;
struct Frame {
    LAS unsigned char* lds;
    int tid, lane, wave, vb, G;
};
enum { I_X = 0, I_C, I_POS, I_NMIX, I_NFFN, I_WADA, I_BADA, I_WIN, I_WOUT, I_CKPOS, I_CKW1, I_CKB1, I_CKW2, I_CKB2, I_CVPOS, I_CVW1, I_CVB1, I_CVW2, I_CVB2, I_HNORM, I_HLB, I_PWQ, I_PKEYS, I_PU, I_PV, I_FNORM };

template <bool MAPPED>
__device__ __forceinline__ void p0_transpose_item(const float* W, int K, int N, bf16* WT, LAS float* scr, int item, int lane) {
    const int nblk = (N + 31) / 32, kb = item / nblk, nb = item % nblk, k0 = 64 * kb, n0 = 32 * nb;
    const int ncol = n0 + (lane & 31);
#pragma unroll 8
    for (int i = 0; i < 32; ++i) { const int kk = 2 * i + (lane >> 5); scr[kk * 33 + (lane & 31)] = (ncol < N) ? W[(size_t)(k0 + kk) * N + ncol] : 0.f; }
    asm volatile("s_waitcnt lgkmcnt(0)" ::: "memory");
    const int c = lane & 7;
#pragma unroll
    for (int j = 0; j < 4; ++j) { const int n = (lane >> 3) + 8 * j; const LAS float* s = scr + (8 * c) * 33 + n;
        v4u o; o.x = pk2(s[0 * 33], s[1 * 33]); o.y = pk2(s[2 * 33], s[3 * 33]); o.z = pk2(s[4 * 33], s[5 * 33]); o.w = pk2(s[6 * 33], s[7 * 33]);
        if (n0 + n < N) { const int row = MAPPED ? winmap(n0 + n) : (n0 + n); *(v4u*)(WT + (size_t)row * K + k0 + 8 * c) = o; } }
    asm volatile("s_waitcnt lgkmcnt(0)" ::: "memory");
}

__device__ __forceinline__ void p0_prologue(KA a, Frame& F) {
    unsigned char* ws = a->ws;
    LAS float* scr = (LAS float*)(F.lds + F.wave * 16384);
    const int gw = F.vb * 8 + F.wave, NGW = F.G * 8;
    const long gt = (long)F.vb * 512 + F.tid, GT = (long)F.G * 512;
    {
        constexpr int I_IN = (D / 64) * ((INW + 31) / 32);
        constexpr int I_SQ = (D / 64) * (D / 32);
        constexpr int I_W1 = (4096 / 64) * (256 / 32);
        constexpr int NITEMS = 2 * I_IN + 4 * I_SQ + 4 * I_W1;
        for (int it = gw; it < NITEMS; it += NGW) {
            int r = it;
            if (r < 2 * I_IN) { const int l = r / I_IN; p0_transpose_item<true>((const float*)a->in[I_WIN] + (size_t)l * D * INW, D, INW, (bf16*)(ws + WS_WINT) + (size_t)l * NPROJ * D, scr, r % I_IN, F.lane); continue; }
            r -= 2 * I_IN;
            if (r < 2 * I_SQ) { const int l = r / I_SQ; p0_transpose_item<false>((const float*)a->in[I_WOUT] + (size_t)l * D * D, D, D, (bf16*)(ws + WS_WOUTT) + (size_t)l * D * D, scr, r % I_SQ, F.lane); continue; }
            r -= 2 * I_SQ;
            if (r < 2 * I_SQ) { const int l = r / I_SQ; p0_transpose_item<false>((const float*)a->in[I_PWQ] + (size_t)l * D * D, D, D, (bf16*)(ws + WS_WQT) + (size_t)l * D * D, scr, r % I_SQ, F.lane); continue; }
            r -= 2 * I_SQ;
            { const int lk = r / I_W1, l = lk >> 1, kv = lk & 1;
              p0_transpose_item<false>((const float*)a->in[kv ? I_CVW1 : I_CKW1] + (size_t)l * 4096 * 256, 4096, 256, (bf16*)(ws + WS_W1T) + (size_t)lk * 256 * 4096, scr, r % I_W1, F.lane); }
        }
    }
    {
        constexpr int CH = (NPROJ - INW) * D / 8;
        for (long i = gt; i < 2L * CH; i += GT) { const int l = (int)(i / CH); const long c = i % CH;
            *(v4u*)((bf16*)(ws + WS_WINT) + (size_t)l * NPROJ * D + (size_t)INW * D + c * 8) = (v4u){0u, 0u, 0u, 0u}; }
    }
    {
        constexpr long NCH = 2L * 16384 * 2048 / 8;
        const f32x4* su = (const f32x4*)a->in[I_PU]; const f32x4* sv = (const f32x4*)a->in[I_PV];
        v4u* du = (v4u*)(ws + WS_PU); v4u* dv = (v4u*)(ws + WS_PV);
        for (long i = gt; i < NCH; i += GT) {
            const f32x4 a0 = su[2 * i], a1 = su[2 * i + 1], b0 = sv[2 * i], b1 = sv[2 * i + 1];
            du[i] = (v4u){pk2(a0.x, a0.y), pk2(a0.z, a0.w), pk2(a1.x, a1.y), pk2(a1.z, a1.w)};
            dv[i] = (v4u){pk2(b0.x, b0.y), pk2(b0.z, b0.w), pk2(b1.x, b1.y), pk2(b1.z, b1.w)};
        }
    }
    {
        const int* pos = (const int*)a->in[I_POS]; float* rc = (float*)(ws + WS_MISC + MS_ROPEC); float* rs = (float*)(ws + WS_MISC + MS_ROPES);
        for (long i = gt; i < (long)T * 16; i += GT) { const int m = (int)(i >> 4), j = (int)(i & 15);
            const float inv = powf(500000.0f, -(float)(2 * j) / 32.0f); const float ang = (float)pos[m] * inv;
            rc[i] = cosf(ang); rs[i] = sinf(ang); }
    }
    {
        LAS float* cs = (LAS float*)(F.lds + 131072 - 4096);
        const float* cin = (const float*)a->in[I_C]; float* parts = (float*)(ws + WS_PARTS);
        for (int it = F.vb; it < 2 * 16 * 6; it += F.G) {
            const int l = it / 96, kc = (it % 96) / 6, cb = it % 6;
            __syncthreads();
            { const int b = F.tid >> 7, k = F.tid & 127; cs[F.tid] = siluf_(cin[b * D + kc * 128 + k]); }
            __syncthreads();
            const int col = cb * 2048 + F.tid * 4;
            const float* w = (const float*)a->in[I_WADA] + ((size_t)l * D + kc * 128) * 12288 + col;
            f32x4 acc[4];
#pragma unroll
            for (int b = 0; b < 4; ++b) acc[b] = (f32x4){0.f, 0.f, 0.f, 0.f};
            if (kc == 0) { const f32x4 bv = *(const f32x4*)((const float*)a->in[I_BADA] + (size_t)l * 12288 + col);
#pragma unroll
                for (int b = 0; b < 4; ++b) acc[b] = bv; }
#pragma unroll 8
            for (int k = 0; k < 128; ++k) { const f32x4 wv = *(const f32x4*)(w + (size_t)k * 12288);
#pragma unroll
                for (int b = 0; b < 4; ++b) acc[b] += wv * cs[b * 128 + k]; }
#pragma unroll
            for (int b = 0; b < 4; ++b) *(f32x4*)(parts + (((size_t)kc * 2 + l) * 4 + b) * 12288 + col) = acc[b];
        }
        __syncthreads();
    }
    {
        float* b1p = (float*)(ws + WS_B1P);
        for (int it = F.vb; it < 64; it += F.G) {
            const int lk = it >> 4, l = lk >> 1, kv = lk & 1, kc = it & 15;
            if (F.tid < 256) {
                const int c = F.tid;
                const float* w1 = (const float*)a->in[kv ? I_CVW1 : I_CKW1] + (size_t)l * 4096 * 256;
                const float* pe = (const float*)a->in[kv ? I_CVPOS : I_CKPOS] + (size_t)l * 4096;
                float acc = (kc == 0) ? ((const float*)a->in[kv ? I_CVB1 : I_CKB1])[l * 256 + c] : 0.f;
                const int k0 = kc * 256;
#pragma unroll 8
                for (int k = 0; k < 256; ++k) acc += pe[k0 + k] * w1[(size_t)(k0 + k) * 256 + c];
                b1p[(kc * 4 + lk) * 256 + c] = acc;
            }
        }
    }
}

template <bool PART>
__device__ __forceinline__ void norm_phase(Frame& F, unsigned char* ws, const float* x, const float* gain, int l, int sh_off, int sc_off, bf16* out) {
    LAS float* shs = (LAS float*)F.lds; LAS float* scs = shs + 2048;
    const float* parts = (const float*)(ws + WS_PARTS); float* mod = (float*)(ws + WS_MOD);
    if (PART) {
        const long gt = (long)F.vb * 512 + F.tid, GT = (long)F.G * 512;
        for (long i = gt; i < 2L * 4 * 12288; i += GT) { float sacc = 0.f;
#pragma unroll
            for (int kc = 0; kc < 16; ++kc) sacc += parts[(size_t)kc * 2 * 4 * 12288 + i];
            mod[i] = sacc; }
    }
    for (int rb = F.vb; rb < T / 32; rb += F.G) {
        const int m0 = rb * 32, b = m0 / S;
        __syncthreads();
        for (int c = F.tid; c < 2048; c += 512) {
            float s0 = 0.f, s1 = 0.f;
            if (PART) {
#pragma unroll
                for (int kc = 0; kc < 16; ++kc) { const float* pp = parts + (((size_t)kc * 2 + l) * 4 + b) * 12288; s0 += pp[sh_off + c]; s1 += pp[sc_off + c]; }
            } else { const float* mp = mod + ((size_t)l * 4 + b) * 12288; s0 = mp[sh_off + c]; s1 = mp[sc_off + c]; }
            shs[c] = s0; scs[c] = s1 + 1.0f;
        }
        __syncthreads();
        for (int r = 0; r < 4; ++r) {
            const int m = m0 + F.wave * 4 + r;
            const float* xr = x + (size_t)m * D;
            f32x4 v[8]; float ss = 0.f;
#pragma unroll
            for (int j = 0; j < 8; ++j) { v[j] = *(const f32x4*)(xr + F.lane * 4 + 256 * j); ss += v[j].x * v[j].x + v[j].y * v[j].y + v[j].z * v[j].z + v[j].w * v[j].w; }
            const float rr = rsqrtf(wave_sum(ss) * (1.0f / D) + EPS);
#pragma unroll
            for (int j = 0; j < 8; ++j) { const int c = F.lane * 4 + 256 * j;
                const f32x4 g = *(const f32x4*)(gain + c), s1 = *(const LAS f32x4*)(scs + c), s0 = *(const LAS f32x4*)(shs + c);
                const f32x4 y = (v[j] * rr) * g * s1 + s0;
                *(v2u*)(out + (size_t)m * D + c) = (v2u){pk2(y.x, y.y), pk2(y.z, y.w)}; }
        }
    }
    __syncthreads();
}

__device__ __forceinline__ void cmp1_naive(KA a, Frame& F, int l) {
    const bf16* proj = (const bf16*)(a->ws + WS_PROJ); float* hid = (float*)(a->ws + WS_MISC + MS_HID);
    const long gt = (long)F.vb * 512 + F.tid, GT = (long)F.G * 512;
    constexpr int ROWS = NB * NCMP * 2;
    for (long i = gt; i < 2L * ROWS * 256; i += GT) {
        const int c = (int)(i & 255); const int row = (int)((i >> 8) % ROWS), kv = (int)((i >> 8) / ROWS);
        const int g = row & 1, n = (row >> 1) % NCMP, b = (row >> 1) / NCMP;
        const float* w1 = (const float*)a->in[kv ? I_CVW1 : I_CKW1] + (size_t)l * 4096 * 256 + c;
        const float* pe = (const float*)a->in[kv ? I_CVPOS : I_CKPOS] + (size_t)l * 4096;
        const bf16* ap = proj + (size_t)(b * S + 16 * n) * NPROJ + (kv ? C_VC : C_KC) + g * 128;
        float acc = ((const float*)a->in[kv ? I_CVB1 : I_CKB1])[l * 256 + c];
        for (int tl = 0; tl < 32; ++tl) {
#pragma unroll 8
            for (int d = 0; d < 128; ++d) acc += (bf2f(ap[(size_t)tl * NPROJ + d]) + pe[tl * 128 + d]) * w1[(size_t)(tl * 128 + d) * 256];
        }
        hid[i] = gelu_tanh(acc);
    }
}
__device__ __forceinline__ void cmp2_naive(KA a, Frame& F, int l) {
    const float* hid = (const float*)(a->ws + WS_MISC + MS_HID); float* kc = (float*)(a->ws + WS_MISC + MS_KC);
    const long gt = (long)F.vb * 512 + F.tid, GT = (long)F.G * 512;
    constexpr int ROWS = NB * NCMP * 2;
    for (long i = gt; i < 2L * ROWS * 128; i += GT) {
        const int j = (int)(i & 127); const int row = (int)((i >> 7) % ROWS), kv = (int)((i >> 7) / ROWS);
        const float* w2 = (const float*)a->in[kv ? I_CVW2 : I_CKW2] + (size_t)l * 256 * 128 + j;
        const float* hr = hid + ((size_t)kv * ROWS + row) * 256;
        float acc = ((const float*)a->in[kv ? I_CVB2 : I_CKB2])[l * 128 + j];
#pragma unroll 8
        for (int c = 0; c < 256; ++c) acc += hr[c] * w2[(size_t)c * 128];
        const int g = row & 1, n = (row >> 1) % NCMP, b = (row >> 1) / NCMP;
        kc[((((size_t)kv * NB + b) * 128 + n) * 2 + g) * 128 + j] = acc;
    }
}

__device__ __forceinline__ void hgrn_naive(KA a, Frame& F, int l) {
    if (F.wave != 0 || F.vb >= 128) return;
    const bf16* proj = (const bf16*)(a->ws + WS_PROJ); float* hraw = (float*)(a->ws + WS_HRAW);
    LAS float* fs = (LAS float*)(F.lds + 65536); LAS float* ks = fs + 128; LAS float* qs = fs + 256;
    const int item = F.vb, eq = item & 3, h = (item >> 2) & 7, b = item >> 5;
    const int e = eq * 32 + (F.lane & 31), dh = F.lane >> 5;
    const float* lbp = (const float*)a->in[I_HLB];
    float lb0, lb1;
    { const float a0 = lbp[h * 128 + F.lane], a1 = lbp[1024 + h * 128 + F.lane]; lb0 = (l == 0) ? 0.f : 1.0f / (1.0f + __expf(a0 - a1));
      const float c0 = lbp[h * 128 + 64 + F.lane], c1 = lbp[1024 + h * 128 + 64 + F.lane]; lb1 = (l == 0) ? 0.f : 1.0f / (1.0f + __expf(c0 - c1)); }
    float st[64];
#pragma unroll
    for (int d = 0; d < 64; ++d) st[d] = 0.f;
    for (int t = 0; t < S; ++t) {
        const bf16* pr = proj + (size_t)(b * S + t) * NPROJ;
        const float f0 = lb0 + (1.0f - lb0) * sigmoidf_(bf2f(pr[C_HF + h * 128 + F.lane])), f1 = lb1 + (1.0f - lb1) * sigmoidf_(bf2f(pr[C_HF + h * 128 + 64 + F.lane]));
        fs[F.lane] = f0; fs[64 + F.lane] = f1; ks[F.lane] = 1.0f - f0; ks[64 + F.lane] = 1.0f - f1;
        qs[F.lane] = siluf_(bf2f(pr[C_HQ + h * 128 + F.lane])); qs[64 + F.lane] = siluf_(bf2f(pr[C_HQ + h * 128 + 64 + F.lane]));
        const float v = bf2f(pr[C_HI + h * 128 + e]);
        asm volatile("s_waitcnt lgkmcnt(0)" ::: "memory");
        float o = 0.f;
#pragma unroll
        for (int d = 0; d < 64; ++d) { st[d] = fs[dh * 64 + d] * st[d] + ks[dh * 64 + d] * v; o += st[d] * qs[dh * 64 + d]; }
        o += __shfl_xor(o, 32);
        if (dh == 0) hraw[(size_t)(b * S + t) * 1024 + h * 128 + e] = o;
        asm volatile("s_waitcnt lgkmcnt(0)" ::: "memory");
    }
}
__device__ __forceinline__ void hgrn_norm_naive(KA a, Frame& F, int l) {
    const bf16* proj = (const bf16*)(a->ws + WS_PROJ); const float* hraw = (const float*)(a->ws + WS_HRAW); bf16* omix = (bf16*)(a->ws + WS_OMIX);
    const float* gn = (const float*)a->in[I_HNORM] + l * 1024;
    const int gw = F.vb * 8 + F.wave, NGW = F.G * 8;
    for (int i = gw; i < T * 8; i += NGW) { const int m = i >> 3, h = i & 7;
        const float o0 = hraw[(size_t)m * 1024 + h * 128 + F.lane], o1 = hraw[(size_t)m * 1024 + h * 128 + 64 + F.lane];
        const float r = rsqrtf(wave_sum(o0 * o0 + o1 * o1) * (1.0f / 128.0f) + EPS);
        const bf16* pr = proj + (size_t)m * NPROJ + C_HG + h * 128;
#ifdef EXP_NO_HGRN
        omix[(size_t)m * D + 1024 + h * 128 + F.lane] = 0; omix[(size_t)m * D + 1024 + h * 128 + 64 + F.lane] = 0; continue;
#endif
        omix[(size_t)m * D + 1024 + h * 128 + F.lane] = (bf16)f2bf(o0 * r * gn[h * 128 + F.lane] * sigmoidf_(bf2f(pr[F.lane])));
        omix[(size_t)m * D + 1024 + h * 128 + 64 + F.lane] = (bf16)f2bf(o1 * r * gn[h * 128 + 64 + F.lane] * sigmoidf_(bf2f(pr[64 + F.lane])));
    }
}

__device__ __forceinline__ void catt_naive(KA a, Frame& F) {
    const bf16* proj = (const bf16*)(a->ws + WS_PROJ); const float* kc = (const float*)(a->ws + WS_MISC + MS_KC); const float* vc = kc + (size_t)NB * 128 * 2 * 128;
    float* oacc = (float*)(a->ws + WS_OACC); unsigned* sel = (unsigned*)(a->ws + WS_MISC + MS_SEL);
    LAS float* qs = (LAS float*)(F.lds + F.wave * 2048); LAS float* ps = qs + 128;
    const int gw = F.vb * 8 + F.wave, NGW = F.G * 8;
    for (int i = gw; i < NB * 2 * S; i += NGW) {
        const int s = i % S, g = (i / S) & 1, b = i / (2 * S), m = b * S + s;
        const int nv = s >= 31 ? (s - 31) / 16 + 1 : 0;
        const bf16* pr = proj + (size_t)m * NPROJ;
        float imp = 0.f;
        for (int hh = 0; hh < 4; ++hh) {
            const int head = g * 4 + hh;
            qs[F.lane] = bf2f(pr[C_Q + head * 128 + F.lane]); qs[64 + F.lane] = bf2f(pr[C_Q + head * 128 + 64 + F.lane]);
            asm volatile("s_waitcnt lgkmcnt(0)" ::: "memory");
            float sc[2];
#pragma unroll
            for (int u = 0; u < 2; ++u) { const int n = F.lane + 64 * u; float acc = 0.f;
                if (n < nv) { const float* kr = kc + (((size_t)b * 128 + n) * 2 + g) * 128;
#pragma unroll 8
                    for (int d = 0; d < 128; ++d) acc += qs[d] * kr[d]; }
                sc[u] = (n < nv) ? acc * ATT_SCALE : -__builtin_inff(); }
            float mx = wave_max(fmaxf(sc[0], sc[1])); if (!(mx > -1e30f)) mx = 0.f;
            const float e0 = (F.lane < nv) ? __expf(sc[0] - mx) : 0.f, e1 = (F.lane + 64 < nv) ? __expf(sc[1] - mx) : 0.f;
            const float den = fmaxf(wave_sum(e0 + e1), 1e-30f);
            ps[F.lane] = e0 / den; ps[64 + F.lane] = e1 / den;
            asm volatile("s_waitcnt lgkmcnt(0)" ::: "memory");
            float o0 = 0.f, o1 = 0.f;
            for (int n = 0; n < nv; ++n) { const float p = ps[n]; const float* vr = vc + (((size_t)b * 128 + n) * 2 + g) * 128; o0 += p * vr[F.lane]; o1 += p * vr[64 + F.lane]; }
            const float g0 = sigmoidf_(bf2f(pr[C_GL + head * 3 + 0]));
            oacc[(size_t)m * 1024 + head * 128 + F.lane] = g0 * o0; oacc[(size_t)m * 1024 + head * 128 + 64 + F.lane] = g0 * o1;
            if (F.lane < 32) { const int j = F.lane; float v = ps[4 * j] + ps[4 * j + 1] + ps[4 * j + 2] + 0.5f * (4 * j + 3 < NCMP ? ps[4 * j + 3] : 0.f); if (j > 0) v += 0.5f * ps[4 * j - 1]; imp += v; }
            asm volatile("s_waitcnt lgkmcnt(0)" ::: "memory");
        }
        const int qb = s >> 6, j = F.lane & 31;
        const bool forced = (j == 0) || (j == qb) || (j + 1 == qb);
        const float score = forced ? __builtin_inff() : (j <= qb ? imp : -__builtin_inff());
        int rank = 0;
#pragma unroll
        for (int k = 0; k < 32; ++k) { const float o = __shfl(score, k); rank += (o > score || (o == score && k < j)) ? 1 : 0; }
        const unsigned long long bal = __ballot(F.lane < 32 && rank < 16 && j <= qb);
        if (F.lane == 0) sel[i] = (unsigned)bal;
    }
}

__device__ __forceinline__ float dot_rope(const LAS float* qs, const bf16* kr, const float* cr, const float* sr) {
    float acc = 0.f;
#pragma unroll
    for (int d = 0; d < 16; ++d) { const float k1 = bf2f(kr[d]), k2 = bf2f(kr[d + 16]), c = cr[d], sn = sr[d];
        acc += qs[d] * (k1 * c - k2 * sn) + qs[d + 16] * (k2 * c + k1 * sn); }
#pragma unroll 8
    for (int d = 32; d < 128; ++d) acc += qs[d] * bf2f(kr[d]);
    return acc;
}
__device__ __forceinline__ void satt_naive(KA a, Frame& F) {
    const bf16* proj = (const bf16*)(a->ws + WS_PROJ); const float* oacc = (const float*)(a->ws + WS_OACC); bf16* omix = (bf16*)(a->ws + WS_OMIX);
    const unsigned* sel = (const unsigned*)(a->ws + WS_MISC + MS_SEL);
    const float* rc = (const float*)(a->ws + WS_MISC + MS_ROPEC); const float* rs = (const float*)(a->ws + WS_MISC + MS_ROPES);
    LAS float* qs = (LAS float*)(F.lds + F.wave * 8192); LAS float* ps = qs + 128;
    const int gw = F.vb * 8 + F.wave, NGW = F.G * 8;
    for (int i = gw; i < NB * 8 * S; i += NGW) {
        const int s = i % S, head = (i / S) & 7, b = i / (8 * S), m = b * S + s, g = head >> 2;
        const bf16* pr = proj + (size_t)m * NPROJ;
        { const float q0 = bf2f(pr[C_Q + head * 128 + F.lane]), q1 = bf2f(pr[C_Q + head * 128 + 64 + F.lane]);
          float qo = q0; const float other = __shfl_xor(q0, 16);
          if (F.lane < 32) { const int dd = F.lane & 15; const float c = rc[m * 16 + dd], sn = rs[m * 16 + dd];
              qo = (F.lane < 16) ? q0 * c - other * sn : q0 * c + other * sn; }
          qs[F.lane] = qo; qs[64 + F.lane] = q1; }
        asm volatile("s_waitcnt lgkmcnt(0)" ::: "memory");
        float res0 = oacc[(size_t)m * 1024 + head * 128 + F.lane], res1 = oacc[(size_t)m * 1024 + head * 128 + 64 + F.lane];
        const float g1 = sigmoidf_(bf2f(pr[C_GL + head * 3 + 1])), g2 = sigmoidf_(bf2f(pr[C_GL + head * 3 + 2]));
        {
            const unsigned mask = sel[(b * 2 + g) * S + s];
            unsigned mm = mask; float mx = -__builtin_inff();
#pragma nounroll
            for (int u = 0; u < 16; ++u) { float v = -__builtin_inff();
                if (mm) { const int j = __builtin_ctz(mm); mm &= mm - 1; const int key = 64 * j + F.lane;
                    if (key <= s) { const int mk = b * S + key; v = dot_rope(qs, proj + (size_t)mk * NPROJ + C_KS + g * 128, rc + mk * 16, rs + mk * 16) * ATT_SCALE; } }
                ps[u * 64 + F.lane] = v; mx = fmaxf(mx, v); }
            mx = wave_max(mx);
            float sum = 0.f;
#pragma nounroll
            for (int u = 0; u < 16; ++u) { const float e = __expf(ps[u * 64 + F.lane] - mx); ps[u * 64 + F.lane] = e; sum += e; }
            sum = wave_sum(sum);
            asm volatile("s_waitcnt lgkmcnt(0)" ::: "memory");
            float o0 = 0.f, o1 = 0.f; mm = mask;
            for (int u = 0; u < 16 && mm; ++u) { const int j = __builtin_ctz(mm); mm &= mm - 1;
                const int kmax = min(63, s - 64 * j);
                for (int k = 0; k <= kmax; ++k) { const float p = ps[u * 64 + k]; const bf16* vr = proj + (size_t)(b * S + 64 * j + k) * NPROJ + C_VS + g * 128;
                    o0 += p * bf2f(vr[F.lane]); o1 += p * bf2f(vr[64 + F.lane]); } }
            res0 += g1 * o0 / sum; res1 += g1 * o1 / sum;
            asm volatile("s_waitcnt lgkmcnt(0)" ::: "memory");
        }
        {
            float mx = -__builtin_inff();
#pragma nounroll
            for (int u = 0; u < 8; ++u) { const int key = s - 511 + 64 * u + F.lane; float v = -__builtin_inff();
                if (key >= 0) { const int mk = b * S + key; v = dot_rope(qs, proj + (size_t)mk * NPROJ + C_KW + g * 128, rc + mk * 16, rs + mk * 16) * ATT_SCALE; }
                ps[u * 64 + F.lane] = v; mx = fmaxf(mx, v); }
            mx = wave_max(mx);
            float sum = 0.f;
#pragma nounroll
            for (int u = 0; u < 8; ++u) { const float e = __expf(ps[u * 64 + F.lane] - mx); ps[u * 64 + F.lane] = e; sum += e; }
            sum = wave_sum(sum);
            asm volatile("s_waitcnt lgkmcnt(0)" ::: "memory");
            float o0 = 0.f, o1 = 0.f;
            const int k0 = max(0, 511 - s);
            for (int k = k0; k < 512; ++k) { const float p = ps[k]; const bf16* vr = proj + (size_t)(b * S + s - 511 + k) * NPROJ + C_VW + g * 128;
                o0 += p * bf2f(vr[F.lane]); o1 += p * bf2f(vr[64 + F.lane]); }
            res0 += g2 * o0 / sum; res1 += g2 * o1 / sum;
            asm volatile("s_waitcnt lgkmcnt(0)" ::: "memory");
        }
#ifdef EXP_NO_NSA
        res0 = 0.f; res1 = 0.f;
#endif
        omix[(size_t)m * D + head * 128 + F.lane] = (bf16)f2bf(res0); omix[(size_t)m * D + head * 128 + 64 + F.lane] = (bf16)f2bf(res1);
    }
}

__device__ __forceinline__ void wave_argmax(float& v, int& i) {
#pragma unroll
    for (int o = 1; o < 64; o <<= 1) { const float ov = __shfl_xor(v, o); const int oi = __shfl_xor(i, o); if (ov > v || (ov == v && oi < i)) { v = ov; i = oi; } }
}
__device__ __forceinline__ void peer_topk(KA a, Frame& F, int l) {
    const bf16* pq = (const bf16*)(a->ws + WS_PQ); int* eidx = (int*)(a->ws + WS_EIDX); float* egate = (float*)(a->ws + WS_EGATE);
    const float* keys = (const float*)a->in[I_PKEYS] + (size_t)l * 8 * 2 * 128 * 128;
    LAS float* qs = (LAS float*)(F.lds + F.wave * 1024);
    const int gw = F.vb * 8 + F.wave, NGW = F.G * 8;
    const float NEG = -__builtin_inff();
    for (int i = gw; i < T * 8; i += NGW) {
        const int t = i >> 3, h = i & 7;
        const bf16* qr = pq + (size_t)t * D + h * 256;
#pragma unroll
        for (int u = 0; u < 4; ++u) qs[u * 64 + F.lane] = bf2f(qr[u * 64 + F.lane]);
        asm volatile("s_waitcnt lgkmcnt(0)" ::: "memory");
        float sv[2]; int si[2];
#pragma unroll
        for (int p = 0; p < 2; ++p) {
            const float* kp = keys + ((size_t)(h * 2 + p) * 128) * 128;
            float c0 = 0.f, c1 = 0.f;
#pragma unroll 4
            for (int d = 0; d < 128; ++d) { const float q = qs[p * 128 + d]; c0 += q * kp[(size_t)F.lane * 128 + d]; c1 += q * kp[(size_t)(F.lane + 64) * 128 + d]; }
            float tv = NEG; int ti = 0;
#pragma nounroll
            for (int r = 0; r < 16; ++r) {
                float bv; int bi; if (c1 > c0) { bv = c1; bi = F.lane + 64; } else { bv = c0; bi = F.lane; }
                wave_argmax(bv, bi);
                if (bi == F.lane) c0 = NEG; if (bi == F.lane + 64) c1 = NEG;
                if (F.lane == r) { tv = bv; ti = bi; }
            }
            sv[p] = tv; si[p] = ti;
        }
        float cv[4]; const int bsel = F.lane & 15; const float s2 = __shfl(sv[1], bsel);
#pragma unroll
        for (int r = 0; r < 4; ++r) cv[r] = __shfl(sv[0], (F.lane >> 4) + 4 * r) + s2;
        float tv = NEG; int tp = 0;
#pragma nounroll
        for (int r = 0; r < 16; ++r) {
            float bv = cv[0]; int bi = F.lane;
#pragma unroll
            for (int u = 1; u < 4; ++u) if (cv[u] > bv) { bv = cv[u]; bi = F.lane + 64 * u; }
            wave_argmax(bv, bi);
#pragma unroll
            for (int u = 0; u < 4; ++u) if (bi == F.lane + 64 * u) cv[u] = NEG;
            if (F.lane == r) { tv = bv; tp = bi; }
        }
        const int ia = __shfl(si[0], (tp >> 4) & 15), ib = __shfl(si[1], tp & 15);
        const float top = __shfl(tv, 0);
        float e = (F.lane < 16) ? __expf(tv - top) : 0.f;
        float sum = e;
#pragma unroll
        for (int o = 1; o < 16; o <<= 1) sum += __shfl_xor(sum, o);
        if (F.lane < 16) { eidx[(size_t)t * 128 + h * 16 + F.lane] = ia * 128 + ib; egate[(size_t)t * 128 + h * 16 + F.lane] = e / sum; }
    }
}

template <bool LAST>
__device__ __forceinline__ void peer_gather(KA a, Frame& F, int l, const float* x1, float* xo, const float* gate2  ) {
    const bf16* hb = (const bf16*)(a->ws + WS_H); const int* eidx = (const int*)(a->ws + WS_EIDX); const float* egate = (const float*)(a->ws + WS_EGATE);
    const bf16* pu = (const bf16*)(a->ws + WS_PU) + (size_t)l * 16384 * 2048; const bf16* pv = (const bf16*)(a->ws + WS_PV) + (size_t)l * 16384 * 2048;
    const int gw = F.vb * 8 + F.wave, NGW = F.G * 8;
    for (int t = gw; t < T; t += NGW) {
        v4u xh[4];
#pragma unroll
        for (int j = 0; j < 4; ++j) xh[j] = *(const v4u*)(hb + (size_t)t * D + 512 * j + 8 * F.lane);
        f32x2 acc[4][4];
#pragma unroll
        for (int j = 0; j < 4; ++j)
#pragma unroll
            for (int q = 0; q < 4; ++q) acc[j][q] = (f32x2){0.f, 0.f};
        const int* ei = eidx + (size_t)t * 128; const float* eg = egate + (size_t)t * 128;
#pragma unroll 2
        for (int k = 0; k < 128; ++k) {
            const int e = __builtin_amdgcn_readfirstlane(ei[k]); const float gk = __uint_as_float(__builtin_amdgcn_readfirstlane(__float_as_uint(eg[k])));
            const bf16* ur = pu + (size_t)e * 2048 + 8 * F.lane; const bf16* vr = pv + (size_t)e * 2048 + 8 * F.lane;
            v4u uu[4], vv[4];
#pragma unroll
            for (int j = 0; j < 4; ++j) { uu[j] = *(const v4u*)(ur + 512 * j); vv[j] = *(const v4u*)(vr + 512 * j); }
            float d = 0.f;
#pragma unroll
            for (int j = 0; j < 4; ++j) {
                const unsigned uw[4] = {uu[j].x, uu[j].y, uu[j].z, uu[j].w}, xw[4] = {xh[j].x, xh[j].y, xh[j].z, xh[j].w};
#pragma unroll
                for (int q = 0; q < 4; ++q) d += __uint_as_float(uw[q] << 16) * __uint_as_float(xw[q] << 16) + __uint_as_float(uw[q] & 0xffff0000u) * __uint_as_float(xw[q] & 0xffff0000u);
            }
            d = wave_sum(d);
            const float cf = gk * gelu_tanh(d);
#pragma unroll
            for (int j = 0; j < 4; ++j) {
                const unsigned w[4] = {vv[j].x, vv[j].y, vv[j].z, vv[j].w};
#pragma unroll
                for (int q = 0; q < 4; ++q) { const f32x2 vf = (f32x2){__uint_as_float(w[q] << 16), __uint_as_float(w[q] & 0xffff0000u)}; acc[j][q] += vf * cf; }
            }
        }
        const int b = t / S; const float* g2 = gate2 + (size_t)b * 12288;
        f32x4 o[4][2]; float ss = 0.f;
#pragma unroll
        for (int j = 0; j < 4; ++j)
#pragma unroll
            for (int hf = 0; hf < 2; ++hf) { const int c = 512 * j + 8 * F.lane + 4 * hf;
                const f32x4 xv = *(const f32x4*)(x1 + (size_t)t * D + c), gv = *(const f32x4*)(g2 + c);
                const f32x4 av = (f32x4){acc[j][2 * hf].x, acc[j][2 * hf].y, acc[j][2 * hf + 1].x, acc[j][2 * hf + 1].y};
#ifdef EXP_NO_PEER
                o[j][hf] = xv;
#elif defined(EXP_NEG_PEER)
                o[j][hf] = xv - gv * av;
#else
                o[j][hf] = xv + gv * av;
#endif
                ss += o[j][hf].x * o[j][hf].x + o[j][hf].y * o[j][hf].y + o[j][hf].z * o[j][hf].z + o[j][hf].w * o[j][hf].w; }
        if (LAST) { const float r = rsqrtf(wave_sum(ss) * (1.0f / D) + EPS); const float* fn = (const float*)a->in[I_FNORM];
#pragma unroll
            for (int j = 0; j < 4; ++j)
#pragma unroll
                for (int hf = 0; hf < 2; ++hf) { const int c = 512 * j + 8 * F.lane + 4 * hf; *(f32x4*)(xo + (size_t)t * D + c) = (o[j][hf] * r) * *(const f32x4*)(fn + c); } }
        else {
#pragma unroll
            for (int j = 0; j < 4; ++j)
#pragma unroll
                for (int hf = 0; hf < 2; ++hf) { const int c = 512 * j + 8 * F.lane + 4 * hf; *(f32x4*)(xo + (size_t)t * D + c) = o[j][hf]; } }
    }
}

#ifdef SKIP0
#define SK0(...)
#else
#define SK0(...) __VA_ARGS__
#endif
#ifdef SKIP1
#define SK1(...)
#else
#define SK1(...) __VA_ARGS__
#endif
#ifdef SKIP2
#define SK2(...)
#else
#define SK2(...) __VA_ARGS__
#endif
#ifdef SKIP3
#define SK3(...)
#else
#define SK3(...) __VA_ARGS__
#endif
#ifdef SKIP4
#define SK4(...)
#else
#define SK4(...) __VA_ARGS__
#endif
#ifdef SKIP5
#define SK5(...)
#else
#define SK5(...) __VA_ARGS__
#endif
#ifdef SKIP6
#define SK6(...)
#else
#define SK6(...) __VA_ARGS__
#endif

constexpr int NKIND = 12;
#define FRESH() ({ KA _p = (KA)__builtin_amdgcn_kernarg_segment_ptr(); asm volatile("" : "+s"(_p)); _p; })
template <int KIND>
__device__ __forceinline__ void run_phase(Frame& F, unsigned char* ws, const int l) {
    float* mod = (float*)(ws + WS_MOD);
    bf16* Hb = (bf16*)(ws + WS_H); bf16* proj = (bf16*)(ws + WS_PROJ); bf16* omix = (bf16*)(ws + WS_OMIX); bf16* pq = (bf16*)(ws + WS_PQ);
    float* XA = (float*)(ws + WS_XA); float* XB = (float*)(ws + WS_XB);
    const float* mod_l = mod + (size_t)l * 4 * 12288;
    if constexpr (KIND == 0) { SK0(p0_prologue(FRESH(), F);) }
    if constexpr (KIND == 1) { if (l == 0) norm_phase<true>(F, ws, (const float*)FRESH()->in[I_X], (const float*)FRESH()->in[I_NMIX], 0, 0, 2048, Hb); else norm_phase<false>(F, ws, XB, (const float*)FRESH()->in[I_NMIX] + l * D, l, 0, 2048, Hb); }
    if constexpr (KIND == 2) {
        pg8::Gemm g{Hb, (const bf16*)(ws + WS_WINT) + (size_t)l * NPROJ * D, T, NPROJ, D}; pg8::StaticOrder So; So.init(T, NPROJ, F.G, (int)blockIdx.x);
        pg8::EpiStoreBf16 E{proj, NPROJ};
        pg8::gemm_phase<pg8::EpiStoreBf16, pg8::StaticOrder, PG8_ALIGN, PG8_SP2>(F.lds, g, So, E);
    }
    if constexpr (KIND == 3) { SK1(cmp1_naive(FRESH(), F, l);) SK2(hgrn_naive(FRESH(), F, l);) }
    if constexpr (KIND == 4) { SK1(cmp2_naive(FRESH(), F, l);) }
    if constexpr (KIND == 5) { SK3(catt_naive(FRESH(), F);) }
    if constexpr (KIND == 6) { SK4(satt_naive(FRESH(), F);) SK2(hgrn_norm_naive(FRESH(), F, l);) }
    if constexpr (KIND == 7) {
        pg8::Gemm g{omix, (const bf16*)(ws + WS_WOUTT) + (size_t)l * D * D, T, D, D}; pg8::StaticOrder So; So.init(T, D, F.G, (int)blockIdx.x);
        pg8::EpiResGate E{(l == 0) ? (const float*)FRESH()->in[I_X] : XB, XA, D, mod_l + 2 * 2048, 12288, S};
        pg8::gemm_phase<pg8::EpiResGate, pg8::StaticOrder, PG8_ALIGN, PG8_SP2>(F.lds, g, So, E);
    }
    if constexpr (KIND == 8) norm_phase<false>(F, ws, XA, (const float*)FRESH()->in[I_NFFN] + l * D, l, 3 * 2048, 4 * 2048, Hb);
    if constexpr (KIND == 9) {
        pg8::Gemm g{Hb, (const bf16*)(ws + WS_WQT) + (size_t)l * D * D, T, D, D}; pg8::StaticOrder So; So.init(T, D, F.G, (int)blockIdx.x);
        pg8::EpiStoreBf16 E{pq, D};
        pg8::gemm_phase<pg8::EpiStoreBf16, pg8::StaticOrder, PG8_ALIGN, PG8_SP2>(F.lds, g, So, E);
    }
    if constexpr (KIND == 10) { SK5(peer_topk(FRESH(), F, l);) }
    if constexpr (KIND == 11) {
        SK6(if (l == DEPTH - 1) peer_gather<true>(FRESH(), F, l, XA, FRESH()->out, mod_l + 5 * 2048);
        else peer_gather<false>(FRESH(), F, l, XA, XB, mod_l + 5 * 2048);)
    }
}
__device__ __forceinline__ void frame_init(Frame& F, unsigned char* lds_raw) {
    F.lds = (LAS unsigned char*)lds_raw;
    { int t_ = threadIdx.x; asm volatile("" : "+v"(t_)); F.tid = t_; } F.lane = F.tid & 63; F.wave = __builtin_amdgcn_readfirstlane(F.tid >> 6);
    F.G = gridDim.x; { const int bx = blockIdx.x; F.vb = (F.G % 8 == 0) ? (bx % 8) * (F.G / 8) + bx / 8 : bx; }
}
#if !MK_ONE_LAUNCH
template <int KIND>
__global__ void __launch_bounds__(512, 2) k_phase(Args a) {
    extern __shared__ __attribute__((aligned(16))) unsigned char lds_raw[];
    Frame F; frame_init(F, lds_raw);
    run_phase<KIND>(F, a.ws, a.layer);
}
#else
extern __shared__ __attribute__((aligned(16))) unsigned char lds_dyn[];
__device__ __noinline__ void grid_sync(unsigned* barw, unsigned x) {
    XcdBarrier b; b.bar = barw; b.x = x; b.st = (volatile LAS unsigned*)((LAS unsigned char*)lds_dyn + MISC_OFF) + 8;
    xcd_barrier(b);
}
template <int KIND>
__device__ __forceinline__ void phase_fn(unsigned char* ws, int l) {
    Frame F; frame_init(F, lds_dyn);
    run_phase<KIND>(F, ws, l);
}
__global__ void __launch_bounds__(512, 2) trunk_fwd(Args a) {
    LAS unsigned char* lds = (LAS unsigned char*)lds_dyn;
    volatile LAS unsigned* MISC = (volatile LAS unsigned*)(lds + MISC_OFF);
    if (threadIdx.x < 32) MISC[threadIdx.x] = 0u;
    __syncthreads();
    unsigned char* ws = a.ws;
    XcdBarrier bar = xcd_barrier_post((unsigned*)(ws + WS_CTL) + CW_BAR, MISC + 8);
    phase_fn<0>(ws, 0); grid_sync(bar.bar, bar.x);
#pragma unroll
    for (int l = 0; l < DEPTH; ++l) {
        phase_fn<1>(ws, l); grid_sync(bar.bar, bar.x);
        phase_fn<2>(ws, l); grid_sync(bar.bar, bar.x);
        phase_fn<3>(ws, l); grid_sync(bar.bar, bar.x);
        phase_fn<4>(ws, l); grid_sync(bar.bar, bar.x);
        phase_fn<5>(ws, l); grid_sync(bar.bar, bar.x);
        phase_fn<6>(ws, l); grid_sync(bar.bar, bar.x);
        phase_fn<7>(ws, l); grid_sync(bar.bar, bar.x);
        phase_fn<8>(ws, l); grid_sync(bar.bar, bar.x);
        phase_fn<9>(ws, l); grid_sync(bar.bar, bar.x);
        phase_fn<10>(ws, l); grid_sync(bar.bar, bar.x);
        phase_fn<11>(ws, l); if (l + 1 < DEPTH) grid_sync(bar.bar, bar.x);
    }
}
#endif

template <class KF> static bool prep_kernel(KF kf) {
    if (hipFuncSetAttribute((const void*)kf, hipFuncAttributeMaxDynamicSharedMemorySize, LDS_BYTES) != hipSuccess) { fprintf(stderr, "kernel_launch: hipFuncSetAttribute failed\n"); return false; }
    return true;
}
extern "C" void kernel_launch(void* const* d_in, const int* in_sizes, int n_in, void* d_out, int out_size, void* d_ws, size_t ws_size, hipStream_t stream) {
    static int grid = 0;
    if (grid == 0) {
        if (n_in != 26 || out_size != T * D || ws_size < WS_END) { fprintf(stderr, "kernel_launch: unexpected problem (n_in %d, out %d, ws %zu, need %zu)\n", n_in, out_size, ws_size, (size_t)WS_END); grid = -1; return; }
        int dev = 0, cus = 0;
        if (hipGetDevice(&dev) != hipSuccess || hipDeviceGetAttribute(&cus, hipDeviceAttributeMultiprocessorCount, dev) != hipSuccess) { grid = -1; return; }
        bool ok = true;
#if MK_ONE_LAUNCH
        ok = prep_kernel(trunk_fwd);
        int per_cu = 0;
        if (hipOccupancyMaxActiveBlocksPerMultiprocessor(&per_cu, (const void*)trunk_fwd, 512, LDS_BYTES) != hipSuccess || per_cu < 1) { fprintf(stderr, "kernel_launch: occupancy query says %d\n", per_cu); }
#else
        ok = prep_kernel(k_phase<0>) && prep_kernel(k_phase<1>) && prep_kernel(k_phase<2>) && prep_kernel(k_phase<3>) && prep_kernel(k_phase<4>) && prep_kernel(k_phase<5>) && prep_kernel(k_phase<6>)
          && prep_kernel(k_phase<7>) && prep_kernel(k_phase<8>) && prep_kernel(k_phase<9>) && prep_kernel(k_phase<10>) && prep_kernel(k_phase<11>);
#endif
        (void)hipGetLastError();
        if (!ok) { grid = -1; return; }
        grid = cus;
    }
    if (grid < 0) return;
    (void)hipMemsetAsync((char*)d_ws + WS_CTL, 0, CTL_ZERO_BYTES, stream);
    Args a{};
    for (int i = 0; i < 26; ++i) a.in[i] = d_in[i];
    a.out = (float*)d_out; a.ws = (unsigned char*)d_ws; a.layer = 0; a.pad = 0;
#if MK_ONE_LAUNCH
    hipLaunchKernelGGL(trunk_fwd, dim3(grid), dim3(512), LDS_BYTES, stream, a);
#else
    hipLaunchKernelGGL(k_phase<0>, dim3(grid), dim3(512), LDS_BYTES, stream, a);
    for (int l = 0; l < DEPTH; ++l) { a.layer = l;
        hipLaunchKernelGGL(k_phase<1>, dim3(grid), dim3(512), LDS_BYTES, stream, a);
        hipLaunchKernelGGL(k_phase<2>, dim3(grid), dim3(512), LDS_BYTES, stream, a);
        hipLaunchKernelGGL(k_phase<3>, dim3(grid), dim3(512), LDS_BYTES, stream, a);
        hipLaunchKernelGGL(k_phase<4>, dim3(grid), dim3(512), LDS_BYTES, stream, a);
        hipLaunchKernelGGL(k_phase<5>, dim3(grid), dim3(512), LDS_BYTES, stream, a);
        hipLaunchKernelGGL(k_phase<6>, dim3(grid), dim3(512), LDS_BYTES, stream, a);
        hipLaunchKernelGGL(k_phase<7>, dim3(grid), dim3(512), LDS_BYTES, stream, a);
        hipLaunchKernelGGL(k_phase<8>, dim3(grid), dim3(512), LDS_BYTES, stream, a);
        hipLaunchKernelGGL(k_phase<9>, dim3(grid), dim3(512), LDS_BYTES, stream, a);
        hipLaunchKernelGGL(k_phase<10>, dim3(grid), dim3(512), LDS_BYTES, stream, a);
        hipLaunchKernelGGL(k_phase<11>, dim3(grid), dim3(512), LDS_BYTES, stream, a);
    }
#endif
}
```

```cpp
#include <hip/hip_runtime.h>
#include <cstdio>
#include <cstdint>
#ifndef MK_ONE_LAUNCH
#define MK_ONE_LAUNCH 1
#endif
namespace pg8 {
#define PG8_LAS __attribute__((address_space(3)))
typedef unsigned short bf16_t;
typedef short bf16x8 __attribute__((ext_vector_type(8)));
typedef float f32x4 __attribute__((ext_vector_type(4)));
typedef unsigned u32x4 __attribute__((ext_vector_type(4)));
constexpr int BM = 256, BK = 64, HALF = 128, HTB = HALF * BK * 2  , STAGE_BYTES = 8 * HTB, NXCD = 8, WGM = 8;

__host__ __device__ __forceinline__ int lds_byte(int r, int c) { const int st = (r >> 4) * 2 + (c >> 5), rr = r & 15, cc = c & 31, ob = rr * 64 + cc * 2; return st * 1024 + (ob ^ (((ob >> 9) & 1) << 5)); }
__host__ __device__ __forceinline__ void stage_rc(int b, int& R, int& C) { const int st = b / 1024, sb = b % 1024, swz = sb ^ (((sb >> 9) & 1) << 5); R = (st >> 1) * 16 + swz / 64; C = (st & 1) * 32 + (swz % 64) / 2; }
__host__ __device__ __forceinline__ int perm32(int rho) { const int n = rho >> 4, i = rho & 15; return 8 * (i >> 2) + 4 * n + (i & 3); }

struct Unit { int pm, pn; };
struct Gemm { const bf16_t* A; const bf16_t* Bt; int M, N, K; };

struct StaticOrder {
    int nM, nN, nwg, G, c;
    __host__ __device__ void init(int M, int N, int G_, int c_) { nM = M / BM; nN = N / BM; nwg = nM * nN; G = G_; c = c_; }
    __host__ __device__ bool next(int i, Unit& u) const {
        const long L = (long)i * G + c; if (L >= nwg) return false;
        int wgid = (int)L; { const int q = nwg / NXCD, r = nwg % NXCD, xcd = wgid % NXCD, off = wgid / NXCD; wgid = (xcd < r ? xcd * (q + 1) : r * (q + 1) + (xcd - r) * q) + off; }
        const int nig = WGM * nN, gid = wgid / nig, fm = gid * WGM, gsz = (nM - fm) < WGM ? (nM - fm) : WGM;
        u.pm = fm + ((wgid % nig) % gsz); u.pn = (wgid % nig) / gsz; return true;
    }
    __device__ __forceinline__ void a_ready(const Unit&) const {}
    __device__ __forceinline__ void done(const Unit&) const {}
};

__device__ __forceinline__ unsigned cvt_pk_bf16(float lo, float hi) { unsigned r; asm volatile("v_cvt_pk_bf16_f32 %0, %1, %2" : "=v"(r) : "v"(lo), "v"(hi)); return r; }
typedef float f32x2 __attribute__((ext_vector_type(2)));
struct EpiStoreBf16 {
    static constexpr bool PERM = true, AFTER_DRAIN = false;
    bf16_t* O; int ldc;
    __device__ __forceinline__ void operator()(const f32x4 (&acc)[2][2][4][2], const Unit& u, int wr, int wc, int fr, int fq) const {
        const int row0 = u.pm * BM + wr * 64 + fr, col0 = u.pn * BM + wc * 32 + 8 * fq;
#pragma unroll
        for (int ai = 0; ai < 2; ++ai)
#pragma unroll
            for (int m = 0; m < 4; ++m) { bf16_t* rowp = O + (size_t)(row0 + ai * HALF + m * 16) * ldc + col0;
#pragma unroll
                for (int bj = 0; bj < 2; ++bj) { const f32x4 v0 = acc[ai][bj][m][0], v1 = acc[ai][bj][m][1];
                    u32x4 w; w.x = cvt_pk_bf16(v0[0], v0[1]); w.y = cvt_pk_bf16(v0[2], v0[3]); w.z = cvt_pk_bf16(v1[0], v1[1]); w.w = cvt_pk_bf16(v1[2], v1[3]);
                    *(u32x4*)(rowp + bj * HALF) = w; } }
    }
};
struct EpiResGate {
    static constexpr bool PERM = false, AFTER_DRAIN = false;
    const float* base; float* out; int ldc; const float* gate; int gate_stride; int rows_per_b;
    __device__ __forceinline__ void operator()(const f32x4 (&acc)[2][2][4][2], const Unit& u, int wr, int wc, int fr, int fq) const {
        const int row0 = u.pm * BM + wr * 64 + fr, col0 = u.pn * BM + wc * 32 + 4 * fq;
        const float* gp = gate + (size_t)((u.pm * BM) / rows_per_b) * gate_stride + col0;
        f32x4 gv[2][2];
#pragma unroll
        for (int bj = 0; bj < 2; ++bj)
#pragma unroll
            for (int n = 0; n < 2; ++n) gv[bj][n] = *(const f32x4*)(gp + bj * HALF + n * 16);
#pragma unroll
        for (int ai = 0; ai < 2; ++ai)
#pragma unroll
            for (int m = 0; m < 4; ++m) { const size_t off = (size_t)(row0 + ai * HALF + m * 16) * ldc + col0;
#pragma unroll
                for (int bj = 0; bj < 2; ++bj)
#pragma unroll
                    for (int n = 0; n < 2; ++n) { const f32x4 x = *(const f32x4*)(base + off + bj * HALF + n * 16);

#ifdef EXP_NO_MIX
                        *(f32x4*)(out + off + bj * HALF + n * 16) = x; } }
#else
                        *(f32x4*)(out + off + bj * HALF + n * 16) = x + gv[bj][n] * acc[ai][bj][m][n]; } }
#endif
    }
};

template <class Epi, class Sched, bool ALIGN_EPI = false, bool SP2 = false>
__device__ __forceinline__ void gemm_phase(PG8_LAS unsigned char* lds, const Gemm g, const Sched& S, const Epi& E) {
    int tid_l = threadIdx.x; asm volatile("" : "+v"(tid_l));
    const int tid = tid_l, wid = __builtin_amdgcn_readfirstlane(tid >> 6), lane = tid & 63, wr = wid >> 2, wc = wid & 3, fr = lane & 15, fq = lane >> 4;
    const int K = g.K, nt = K / BK;
    unsigned voffA[2], voffB[2];
#pragma unroll
    for (int i = 0; i < 2; ++i) { int R, C; stage_rc(tid * 16 + i * 8192, R, C); const int Rb = Epi::PERM ? ((R & ~31) + perm32(R & 31)) : R;
        voffA[i] = (unsigned)(R * K + C) * 2u; voffB[i] = (unsigned)(Rb * K + C) * 2u; }
    const size_t kstep = (size_t)(BK * 2);
    const size_t hstep = (size_t)HALF * K * 2;
    const size_t tstep = 2 * hstep;
    const unsigned ldsw = (unsigned)wid * 1024u;
    const int aoff = lds_byte(wr * 64 + fr, fq * 8), boff = lds_byte(wc * 32 + fr, fq * 8);
#define PG8_SA(b, h) (((b) * 2 + (h)) * HTB)
#define PG8_SB(b, h) ((4 + (b) * 2 + (h)) * HTB)
#define PG8_STAGE(bufoff, gbase, voff) do { _Pragma("unroll") for (int _i = 0; _i < 2; ++_i) \
        __builtin_amdgcn_global_load_lds((const unsigned*)((const char*)(gbase) + (voff)[_i]), (PG8_LAS unsigned*)(lds + (bufoff) + ldsw + _i * 8192), 16, 0, 0); } while (0)
#define PG8_LDA(dst, b, h) do { _Pragma("unroll") for (int m = 0; m < 4; ++m) _Pragma("unroll") for (int k = 0; k < 2; ++k) dst[m][k] = *(const PG8_LAS bf16x8*)(lds + PG8_SA(b, h) + aoff + m * 2048 + k * 1024); } while (0)
#define PG8_LDB(dst, b, h) do { _Pragma("unroll") for (int n = 0; n < 2; ++n) _Pragma("unroll") for (int k = 0; k < 2; ++k) dst[n][k] = *(const PG8_LAS bf16x8*)(lds + PG8_SB(b, h) + boff + n * 2048 + k * 1024); } while (0)
#define PG8_MMA(ai, bj, At, Bt) do { __builtin_amdgcn_s_setprio(1); _Pragma("unroll") for (int m = 0; m < 4; ++m) _Pragma("unroll") for (int n = 0; n < 2; ++n) _Pragma("unroll") for (int k = 0; k < 2; ++k) \
        acc[ai][bj][m][n] = __builtin_amdgcn_mfma_f32_16x16x32_bf16(Bt[n][k], At[m][k], acc[ai][bj][m][n], 0, 0, 0); __builtin_amdgcn_s_setprio(0); } while (0)
#define PG8_WAIT_V(n) asm volatile("s_waitcnt vmcnt(" #n ")" ::: "memory")
#define PG8_WAIT_L(n) asm volatile("s_waitcnt lgkmcnt(" #n ")" ::: "memory")
#define PG8_BAR __builtin_amdgcn_s_barrier()
#define PG8_SCHED __builtin_amdgcn_sched_barrier(0)
    Unit cur, nxt; int ui = 0;
    if (!S.next(0, cur)) return;
    f32x4 acc[2][2][4][2];
#pragma unroll
    for (int a = 0; a < 2; ++a)
#pragma unroll
        for (int b = 0; b < 2; ++b)
#pragma unroll
            for (int m = 0; m < 4; ++m)
#pragma unroll
                for (int n = 0; n < 2; ++n) acc[a][b][m][n] = (f32x4){0.f, 0.f, 0.f, 0.f};
    bf16x8 At[4][2], B0[2][2], B1[2][2];
    const char* cA = (const char*)g.A + (size_t)cur.pm * tstep; const char* cB = (const char*)g.Bt + (size_t)cur.pn * tstep;
    S.a_ready(cur);
    if constexpr (SP2) {
        PG8_STAGE(PG8_SB(0, 0), cB, voffB); PG8_STAGE(PG8_SB(0, 1), cB + hstep, voffB); PG8_STAGE(PG8_SA(0, 0), cA, voffA); PG8_STAGE(PG8_SA(0, 1), cA + hstep, voffA);
        if (wr == 1) PG8_BAR;
        PG8_WAIT_V(2); PG8_BAR;
        PG8_STAGE(PG8_SB(1, 0), cB + kstep, voffB); PG8_STAGE(PG8_SA(1, 0), cA + kstep, voffA); PG8_STAGE(PG8_SB(1, 1), cB + hstep + kstep, voffB);
        PG8_WAIT_V(6); PG8_BAR;
    } else {
        PG8_STAGE(PG8_SB(0, 0), cB, voffB); PG8_STAGE(PG8_SA(0, 0), cA, voffA); PG8_STAGE(PG8_SB(0, 1), cB + hstep, voffB); PG8_STAGE(PG8_SA(0, 1), cA + hstep, voffA);
        if (wr == 1) PG8_BAR;
        PG8_WAIT_V(4); PG8_BAR;
        PG8_STAGE(PG8_SB(1, 0), cB + kstep, voffB); PG8_STAGE(PG8_SA(1, 0), cA + kstep, voffA); PG8_STAGE(PG8_SB(1, 1), cB + hstep + kstep, voffB);
        PG8_WAIT_V(6); PG8_BAR;
    }
    for (;;) {
        const bool has_next = S.next(ui + 1, nxt);
        const char* nA = has_next ? (const char*)g.A + (size_t)nxt.pm * tstep : cA; const char* nB = has_next ? (const char*)g.Bt + (size_t)nxt.pn * tstep : cB;
        for (int t = 0; t < nt; t += 2) {
            const bool last = (t == nt - 2);
            const char* a1 = cA + (size_t)(t + 1) * kstep;
            const char* a2 = last ? nA : cA + (size_t)(t + 2) * kstep; const char* b2 = last ? nB : cB + (size_t)(t + 2) * kstep;
            const char* a3 = a2 + kstep; const char* b3 = b2 + kstep;
            if (last && has_next) S.a_ready(nxt);
            if constexpr (SP2) {
            PG8_LDB(B0, 0, 0); PG8_LDB(B1, 0, 1); PG8_SCHED; PG8_LDA(At, 0, 0); PG8_STAGE(PG8_SA(1, 1), a1 + hstep, voffA);
            PG8_WAIT_V(8); PG8_WAIT_L(0); PG8_BAR; PG8_MMA(0, 0, At, B0); PG8_MMA(0, 1, At, B1); PG8_BAR; PG8_SCHED;
            PG8_LDA(At, 0, 1); PG8_STAGE(PG8_SB(0, 0), b2, voffB); PG8_STAGE(PG8_SB(0, 1), b2 + hstep, voffB); PG8_STAGE(PG8_SA(0, 0), a2, voffA);
            PG8_WAIT_V(8); PG8_WAIT_L(0); PG8_BAR; PG8_MMA(1, 0, At, B0); PG8_MMA(1, 1, At, B1); PG8_BAR; PG8_SCHED;
            PG8_LDB(B0, 1, 0); PG8_LDB(B1, 1, 1); PG8_SCHED; PG8_LDA(At, 1, 0); PG8_STAGE(PG8_SA(0, 1), a2 + hstep, voffA);
            PG8_WAIT_V(8); PG8_WAIT_L(0); PG8_BAR; PG8_MMA(0, 0, At, B0); PG8_MMA(0, 1, At, B1); PG8_BAR; PG8_SCHED;
            PG8_LDA(At, 1, 1); PG8_STAGE(PG8_SB(1, 0), b3, voffB); PG8_STAGE(PG8_SB(1, 1), b3 + hstep, voffB); PG8_STAGE(PG8_SA(1, 0), a3, voffA);
            PG8_WAIT_V(8); PG8_WAIT_L(0); PG8_BAR; PG8_MMA(1, 0, At, B0); PG8_MMA(1, 1, At, B1); PG8_BAR; PG8_SCHED;
            } else {
            PG8_LDB(B0, 0, 0); PG8_SCHED; PG8_LDA(At, 0, 0); PG8_STAGE(PG8_SA(1, 1), a1 + hstep, voffA);
            PG8_WAIT_L(8); PG8_BAR; PG8_WAIT_L(0); PG8_MMA(0, 0, At, B0); PG8_BAR; PG8_SCHED;
            PG8_LDB(B1, 0, 1); PG8_STAGE(PG8_SB(0, 0), b2, voffB);
            PG8_BAR; PG8_WAIT_L(0); PG8_MMA(0, 1, At, B1); PG8_BAR;
            PG8_LDA(At, 0, 1); PG8_STAGE(PG8_SA(0, 0), a2, voffA);
            PG8_BAR; PG8_WAIT_L(0); PG8_MMA(1, 0, At, B0); PG8_BAR; PG8_SCHED;
            PG8_STAGE(PG8_SB(0, 1), b2 + hstep, voffB);
            PG8_WAIT_V(6); PG8_BAR; PG8_MMA(1, 1, At, B1); PG8_BAR;
            PG8_LDB(B0, 1, 0); PG8_SCHED; PG8_LDA(At, 1, 0); PG8_STAGE(PG8_SA(0, 1), a2 + hstep, voffA);
            PG8_WAIT_L(8); PG8_BAR; PG8_WAIT_L(0); PG8_MMA(0, 0, At, B0); PG8_BAR; PG8_SCHED;
            PG8_LDB(B1, 1, 1); PG8_STAGE(PG8_SB(1, 0), b3, voffB);
            PG8_BAR; PG8_WAIT_L(0); PG8_MMA(0, 1, At, B1); PG8_BAR;
            PG8_LDA(At, 1, 1); PG8_STAGE(PG8_SA(1, 0), a3, voffA);
            PG8_BAR; PG8_WAIT_L(0); PG8_MMA(1, 0, At, B0); PG8_BAR; PG8_SCHED;
            PG8_STAGE(PG8_SB(1, 1), b3 + hstep, voffB);
            PG8_WAIT_V(6); PG8_BAR; PG8_MMA(1, 1, At, B1); PG8_BAR;
            }
        }
        if constexpr (ALIGN_EPI) { if (wr == 0) PG8_BAR; }
        if constexpr (!Epi::AFTER_DRAIN) { E(acc, cur, wr, wc, fr, fq); S.done(cur); }
        if (!has_next) break;
#pragma unroll
        for (int a = 0; a < 2; ++a)
#pragma unroll
            for (int b = 0; b < 2; ++b)
#pragma unroll
                for (int m = 0; m < 4; ++m)
#pragma unroll
                    for (int n = 0; n < 2; ++n) acc[a][b][m][n] = (f32x4){0.f, 0.f, 0.f, 0.f};
        cur = nxt; cA = nA; cB = nB; ++ui;
        if constexpr (ALIGN_EPI) { if (wr == 1) PG8_BAR; }
    }
    PG8_WAIT_V(0);
    if constexpr (!ALIGN_EPI) { if (wr == 0) PG8_BAR; }
    PG8_BAR;
    if constexpr (Epi::AFTER_DRAIN) { E.fused(acc, cur, wr, wc, fr, fq, lds, wid, lane); S.done(cur); }
#undef PG8_SA
#undef PG8_SB
#undef PG8_STAGE
#undef PG8_LDA
#undef PG8_LDB
#undef PG8_MMA
#undef PG8_WAIT_V
#undef PG8_WAIT_L
#undef PG8_BAR
#undef PG8_SCHED
}
}

#ifndef PG8_SP2
#define PG8_SP2 true
#endif
#ifndef PG8_ALIGN
#define PG8_ALIGN true
#endif
#define GAS __attribute__((address_space(1)))
#define LAS __attribute__((address_space(3)))
typedef unsigned short bf16;
typedef unsigned v4u __attribute__((ext_vector_type(4)));
typedef unsigned v2u __attribute__((ext_vector_type(2)));
typedef float f32x4 __attribute__((ext_vector_type(4)));
typedef float f32x2 __attribute__((ext_vector_type(2)));
typedef short bf16x8 __attribute__((ext_vector_type(8)));
typedef __bf16 bf16x2_t __attribute__((ext_vector_type(2)));
typedef GAS unsigned gu32;

constexpr int NB = 4, S = 2048, D = 2048, T = NB * S, DEPTH = 2;
constexpr int INW = 6680, NPROJ = 6912;
constexpr int C_Q = 0, C_KC = 1024, C_VC = 1280, C_KS = 1536, C_VS = 1792, C_KW = 2048, C_VW = 2304, C_HQ = 2560, C_HF = 3584, C_HI = 4608, C_HG = 5632, C_GL = 6656;
constexpr int NCMP = 127;
constexpr float EPS = 1e-6f;
constexpr float ATT_SCALE = 0.08838834764831845f;
__host__ __device__ __forceinline__ int winmap(int n) { return n < 2560 ? n : (n < 2584 ? C_GL + (n - 2560) : n - 24); }

constexpr size_t MiB = 1u << 20;
constexpr size_t WS_CTL = 0, CTL_ZERO_BYTES = 2 * MiB;
constexpr size_t WS_MOD = 256 * 1024;
constexpr size_t WS_B1P = 1 * MiB;
constexpr size_t WS_WINT = 2 * MiB, WS_WOUTT = 56 * MiB, WS_WQT = 72 * MiB, WS_W1T = 88 * MiB, WS_PU = 96 * MiB, WS_PV = 224 * MiB;
constexpr size_t WS_H = 352 * MiB, WS_PROJ = 384 * MiB, WS_OMIX = 492 * MiB, WS_OACC = 524 * MiB, WS_XA = 556 * MiB, WS_XB = 620 * MiB;
constexpr size_t WS_PQ = 684 * MiB, WS_EIDX = 716 * MiB, WS_EGATE = 720 * MiB, WS_MISC = 724 * MiB, WS_HRAW = 732 * MiB, WS_PARTS = 764 * MiB, WS_UT = 772 * MiB, WS_ST = 836 * MiB, WS_DEC = 868 * MiB, WS_KSR = 870 * MiB, WS_KWR = 874 * MiB, WS_VST = 878 * MiB, WS_VWT = 882 * MiB, WS_KCB = 886 * MiB, WS_VCT = 887 * MiB, WS_W2T = 887 * MiB + 512 * 1024, WS_PKB = 888 * MiB, WS_END = 889 * MiB;
constexpr size_t MS_KC = 0, MS_ROPEC = 1 * MiB, MS_ROPES = 1 * MiB + 512 * 1024, MS_SEL = 2 * MiB, MS_HID = 4 * MiB;
constexpr int CW_BAR = 4096;

constexpr int LDS_BYTES = 147456;
constexpr int MISC_OFF = 131072 + 320;

#define RLX_AGENT __ATOMIC_RELAXED, __HIP_MEMORY_SCOPE_AGENT
__device__ __forceinline__ float bf2f(bf16 b) { return __uint_as_float(((unsigned)b) << 16); }
__device__ __forceinline__ unsigned f2bf(float f) { unsigned u = __float_as_uint(f); return (u + 0x7fffu + ((u >> 16) & 1u)) >> 16; }
__device__ __forceinline__ unsigned pk2(float lo, float hi) { return f2bf(lo) | (f2bf(hi) << 16); }
__device__ __forceinline__ float wave_sum(float v) {
#pragma unroll
    for (int o = 1; o < 64; o <<= 1) v += __shfl_xor(v, o);
    return v;
}
__device__ __forceinline__ float wave_max(float v) {
#pragma unroll
    for (int o = 1; o < 64; o <<= 1) v = fmaxf(v, __shfl_xor(v, o));
    return v;
}
__device__ __forceinline__ float sigmoidf_(float x) { return 1.0f / (1.0f + __expf(-x)); }
__device__ __forceinline__ float siluf_(float x) { return x / (1.0f + __expf(-x)); }
__device__ __forceinline__ float gelu_tanh(float x) { const float u = 0.7978845608028654f * (x + 0.044715f * x * x * x); const float e = __expf(2.0f * u); return 0.5f * x * (1.0f + (1.0f - 2.0f / (e + 1.0f))); }
#define XB_TMO      128
#define XB_XCNT(j)  (256  + 64 * (j))
#define XB_XSUB(j)  (1280 + 64 * (j))
#define XB_XGEN(j)  (2304 + 64 * (j))
#define XB_TOP      3328
#define XB_TOPGEN   3392
#define XCD_BAR_WORDS 3456
#define XB_SPIN_CAP (1u << 18)

__device__ __forceinline__ unsigned xb_ld(unsigned* p)              { return __hip_atomic_load(p, __ATOMIC_RELAXED, __HIP_MEMORY_SCOPE_AGENT); }
__device__ __forceinline__ unsigned xb_add(unsigned* p, unsigned v) { return __hip_atomic_fetch_add(p, v, __ATOMIC_RELAXED, __HIP_MEMORY_SCOPE_AGENT); }
__device__ __forceinline__ unsigned xb_xcc_id() { return (unsigned)__builtin_amdgcn_s_getreg((3 << 11) | 20) & 0xFu; }
#define XB_SPIN(cond, bar) do { unsigned _sp = 0; while (cond) { __builtin_amdgcn_s_sleep(1); \
    if ((++_sp & 255u) == 0u) { if (xb_ld(&(bar)[XB_TMO])) break; if (_sp > XB_SPIN_CAP) { atomicAdd(&(bar)[XB_TMO], 1u); break; } } } } while (0)

struct XcdBarrier {
    unsigned* bar; unsigned x;
    volatile LAS unsigned* st;
};

__device__ __forceinline__ XcdBarrier xcd_barrier_post(unsigned* bar, volatile LAS unsigned* st) {
    XcdBarrier b; b.bar = bar; b.x = xb_xcc_id(); b.st = st;
    if (threadIdx.x == 0) (void)xb_add(&bar[XB_XCNT(b.x)], 1u);
    return b;
}
__device__ __forceinline__ void xcd_barrier_complete(unsigned* bar, unsigned x, unsigned& nloc, unsigned& nx) {
    const unsigned G = gridDim.x * gridDim.y * gridDim.z;
    unsigned sum, cnt, mine, sp = 0u;
    for (;;) {
        sum = 0u; cnt = 0u; mine = 0u;
#pragma unroll
        for (unsigned j = 0; j < 16; ++j) { const unsigned c = xb_ld(&bar[XB_XCNT(j)]); sum += c; cnt += (c > 0u) ? 1u : 0u; mine = (j == x) ? c : mine; }
        if (sum == G) break;
        __builtin_amdgcn_s_sleep(1);
        if ((++sp & 255u) == 0u) { if (xb_ld(&bar[XB_TMO])) break; if (sp > XB_SPIN_CAP) { atomicAdd(&bar[XB_TMO], 1u); break; } }
    }
    nloc = mine > 0u ? mine : 1u; nx = cnt > 0u ? cnt : 1u;
}

__device__ __forceinline__ void xcd_barrier(const XcdBarrier& b) {
    asm volatile("s_waitcnt vmcnt(0)" ::: "memory");
    __syncthreads();
    if (threadIdx.x == 0) {
        unsigned* bar = b.bar;
        __builtin_amdgcn_s_waitcnt(0);
        unsigned nloc = b.st[0], nx = b.st[1];
        if (nloc == 0u) { xcd_barrier_complete(bar, b.x, nloc, nx); b.st[0] = nloc; b.st[1] = nx; }
        const unsigned old = xb_add(&bar[XB_XSUB(b.x)], 1u);
        const unsigned gen = old / nloc;
        if (old + 1u == (gen + 1u) * nloc) {
            __builtin_amdgcn_fence(__ATOMIC_RELEASE, "agent");
            asm volatile("s_waitcnt vmcnt(0)" ::: "memory");
            const unsigned og = xb_add(&bar[XB_TOP], 1u);
            const unsigned tg = og / nx;
            if (og + 1u == (tg + 1u) * nx) xb_add(&bar[XB_TOPGEN], 1u);
            else XB_SPIN(xb_ld(&bar[XB_TOPGEN]) == tg, bar);
            __builtin_amdgcn_fence(__ATOMIC_ACQUIRE, "agent");
            xb_add(&bar[XB_XGEN(b.x)], 1u);
            asm volatile("s_waitcnt vmcnt(0)" ::: "memory");
        } else {
            XB_SPIN(xb_ld(&bar[XB_XGEN(b.x)]) == gen, bar);
            __builtin_amdgcn_fence(__ATOMIC_ACQUIRE, "agent");
            asm volatile("s_waitcnt vmcnt(0)" ::: "memory");
        }
    }
    __syncthreads();
}

struct Args { const void* in[26]; float* out; unsigned char* ws; int layer, pad; };
typedef const __attribute__((address_space(4))) Args* KA;
__device__ __forceinline__ int perm16(int n) { const int k = n & 15; return (n & ~15) | (k < 4 ? k : (k < 8 ? k + 4 : (k < 12 ? k - 4 : k))); }
struct Frame {
    LAS unsigned char* lds;
    int tid, lane, wave, vb, G;
};
enum { I_X = 0, I_C, I_POS, I_NMIX, I_NFFN, I_WADA, I_BADA, I_WIN, I_WOUT, I_CKPOS, I_CKW1, I_CKB1, I_CKW2, I_CKB2, I_CVPOS, I_CVW1, I_CVB1, I_CVW2, I_CVB2, I_HNORM, I_HLB, I_PWQ, I_PKEYS, I_PU, I_PV, I_FNORM };

template <bool MAPPED>
__device__ __forceinline__ void p0_transpose_item(const float* W, int K, int N, bf16* WT, LAS float* scr, int item, int lane) {
    const int nblk = (N + 31) / 32, kb = item / nblk, nb = item % nblk, k0 = 64 * kb, n0 = 32 * nb;
    const int ncol = n0 + (lane & 31);
#pragma unroll 8
    for (int i = 0; i < 32; ++i) { const int kk = 2 * i + (lane >> 5); scr[kk * 33 + (lane & 31)] = (ncol < N) ? W[(size_t)(k0 + kk) * N + ncol] : 0.f; }
    asm volatile("s_waitcnt lgkmcnt(0)" ::: "memory");
    const int c = lane & 7;
#pragma unroll
    for (int j = 0; j < 4; ++j) { const int n = (lane >> 3) + 8 * j; const LAS float* s = scr + (8 * c) * 33 + n;
        v4u o; o.x = pk2(s[0 * 33], s[1 * 33]); o.y = pk2(s[2 * 33], s[3 * 33]); o.z = pk2(s[4 * 33], s[5 * 33]); o.w = pk2(s[6 * 33], s[7 * 33]);
        if (n0 + n < N) { const int row = MAPPED ? winmap(n0 + n) : (n0 + n); *(v4u*)(WT + (size_t)row * K + k0 + 8 * c) = o; } }
    asm volatile("s_waitcnt lgkmcnt(0)" ::: "memory");
}

__device__ __forceinline__ void p0_prologue(KA a, Frame& F) {
    unsigned char* ws = a->ws;
    LAS float* scr = (LAS float*)(F.lds + F.wave * 16384);
    const int gw = F.vb * 8 + F.wave, NGW = F.G * 8;
    const long gt = (long)F.vb * 512 + F.tid, GT = (long)F.G * 512;
    {
        constexpr int I_IN = (D / 64) * ((INW + 31) / 32);
        constexpr int I_SQ = (D / 64) * (D / 32);
        constexpr int I_W1 = (4096 / 64) * (256 / 32);
        constexpr int I_W2 = (256 / 64) * (128 / 32);
        constexpr int NITEMS = 2 * I_IN + 4 * I_SQ + 4 * I_W1 + 4 * I_W2;
        for (int it = gw; it < NITEMS; it += NGW) {
            int r = it;
            if (r < 2 * I_IN) { const int l = r / I_IN; p0_transpose_item<true>((const float*)a->in[I_WIN] + (size_t)l * D * INW, D, INW, (bf16*)(ws + WS_WINT) + (size_t)l * NPROJ * D, scr, r % I_IN, F.lane); continue; }
            r -= 2 * I_IN;
            if (r < 2 * I_SQ) { const int l = r / I_SQ; p0_transpose_item<false>((const float*)a->in[I_WOUT] + (size_t)l * D * D, D, D, (bf16*)(ws + WS_WOUTT) + (size_t)l * D * D, scr, r % I_SQ, F.lane); continue; }
            r -= 2 * I_SQ;
            if (r < 2 * I_SQ) { const int l = r / I_SQ; p0_transpose_item<false>((const float*)a->in[I_PWQ] + (size_t)l * D * D, D, D, (bf16*)(ws + WS_WQT) + (size_t)l * D * D, scr, r % I_SQ, F.lane); continue; }
            r -= 2 * I_SQ;
            if (r < 4 * I_W1) { const int lk = r / I_W1, l = lk >> 1, kv = lk & 1;
              p0_transpose_item<false>((const float*)a->in[kv ? I_CVW1 : I_CKW1] + (size_t)l * 4096 * 256, 4096, 256, (bf16*)(ws + WS_W1T) + (size_t)lk * 256 * 4096, scr, r % I_W1, F.lane); continue; }
            r -= 4 * I_W1;
            { const int lk = r / I_W2, l = lk >> 1, kv = lk & 1;
              p0_transpose_item<false>((const float*)a->in[kv ? I_CVW2 : I_CKW2] + (size_t)l * 256 * 128, 256, 128, (bf16*)(ws + WS_W2T) + (size_t)lk * 128 * 256, scr, r % I_W2, F.lane); }
        }
    }
    {
        constexpr int CH = (NPROJ - INW) * D / 8;
        for (long i = gt; i < 2L * CH; i += GT) { const int l = (int)(i / CH); const long c = i % CH;
            *(v4u*)((bf16*)(ws + WS_WINT) + (size_t)l * NPROJ * D + (size_t)INW * D + c * 8) = (v4u){0u, 0u, 0u, 0u}; }
    }
    {
        constexpr long NCH = 2L * 16384 * 2048 / 8;
        const f32x4* su = (const f32x4*)a->in[I_PU]; const f32x4* sv = (const f32x4*)a->in[I_PV];
        v4u* du = (v4u*)(ws + WS_PU); v4u* dv = (v4u*)(ws + WS_PV);
        for (long i = gt; i < NCH; i += GT) {
            const f32x4 a0 = su[2 * i], a1 = su[2 * i + 1], b0 = sv[2 * i], b1 = sv[2 * i + 1];
            du[i] = (v4u){pk2(a0.x, a0.y), pk2(a0.z, a0.w), pk2(a1.x, a1.y), pk2(a1.z, a1.w)};
            dv[i] = (v4u){pk2(b0.x, b0.y), pk2(b0.z, b0.w), pk2(b1.x, b1.y), pk2(b1.z, b1.w)};
        }
    }
    {
        const f32x4* sk = (const f32x4*)a->in[I_PKEYS]; v2u* dk = (v2u*)(ws + WS_PKB);
        for (long i = gt; i < 2L * 8 * 2 * 128 * 128 / 4; i += GT) { const f32x4 v = sk[i]; dk[i] = (v2u){pk2(v.x, v.y), pk2(v.z, v.w)}; }
    }
    {
        const int* pos = (const int*)a->in[I_POS]; float* rc = (float*)(ws + WS_MISC + MS_ROPEC); float* rs = (float*)(ws + WS_MISC + MS_ROPES);
        for (long i = gt; i < (long)T * 16; i += GT) { const int m = (int)(i >> 4), j = (int)(i & 15);
            const float inv = powf(500000.0f, -(float)(2 * j) / 32.0f); const float ang = (float)pos[m] * inv;
            rc[i] = cosf(ang); rs[i] = sinf(ang); }
    }
    {
        LAS float* cs = (LAS float*)(F.lds + 131072 - 4096);
        const float* cin = (const float*)a->in[I_C]; float* parts = (float*)(ws + WS_PARTS);
        for (int it = F.vb; it < 2 * 16 * 6; it += F.G) {
            const int l = it / 96, kc = (it % 96) / 6, cb = it % 6;
            __syncthreads();
            { const int b = F.tid >> 7, k = F.tid & 127; cs[F.tid] = siluf_(cin[b * D + kc * 128 + k]); }
            __syncthreads();
            const int col = cb * 2048 + F.tid * 4;
            const float* w = (const float*)a->in[I_WADA] + ((size_t)l * D + kc * 128) * 12288 + col;
            f32x4 acc[4];
#pragma unroll
            for (int b = 0; b < 4; ++b) acc[b] = (f32x4){0.f, 0.f, 0.f, 0.f};
            if (kc == 0) { const f32x4 bv = *(const f32x4*)((const float*)a->in[I_BADA] + (size_t)l * 12288 + col);
#pragma unroll
                for (int b = 0; b < 4; ++b) acc[b] = bv; }
#pragma unroll 8
            for (int k = 0; k < 128; ++k) { const f32x4 wv = *(const f32x4*)(w + (size_t)k * 12288);
#pragma unroll
                for (int b = 0; b < 4; ++b) acc[b] += wv * cs[b * 128 + k]; }
#pragma unroll
            for (int b = 0; b < 4; ++b) *(f32x4*)(parts + (((size_t)kc * 2 + l) * 4 + b) * 12288 + col) = acc[b];
        }
        __syncthreads();
    }
    {
        float* b1p = (float*)(ws + WS_B1P);
        for (int it = F.vb; it < 64; it += F.G) {
            const int lk = it >> 4, l = lk >> 1, kv = lk & 1, kc = it & 15;
            if (F.tid < 256) {
                const int c = F.tid;
                const float* w1 = (const float*)a->in[kv ? I_CVW1 : I_CKW1] + (size_t)l * 4096 * 256;
                const float* pe = (const float*)a->in[kv ? I_CVPOS : I_CKPOS] + (size_t)l * 4096;
                float acc = (kc == 0) ? ((const float*)a->in[kv ? I_CVB1 : I_CKB1])[l * 256 + c] : 0.f;
                const int k0 = kc * 256;
#pragma unroll 8
                for (int k = 0; k < 256; ++k) acc += pe[k0 + k] * w1[(size_t)(k0 + k) * 256 + c];
                b1p[(kc * 4 + lk) * 256 + c] = acc;
            }
        }
    }
}

template <bool PART>
__device__ __forceinline__ void norm_phase(Frame& F, unsigned char* ws, const float* x, const float* gain, int l, int sh_off, int sc_off, bf16* out) {
    LAS float* shs = (LAS float*)F.lds; LAS float* scs = shs + 2048;
    const float* parts = (const float*)(ws + WS_PARTS); float* mod = (float*)(ws + WS_MOD);
    if (PART) {
        const long gt = (long)F.vb * 512 + F.tid, GT = (long)F.G * 512;
        for (long i = gt; i < 2L * 4 * 12288; i += GT) { float sacc = 0.f; const float* pp = parts + i;
#pragma unroll 1
            for (int kc = 0; kc < 16; ++kc) { sacc += *pp; pp += 2 * 4 * 12288; }
            mod[i] = sacc; }
    }
    for (int rb = F.vb; rb < T / 32; rb += F.G) {
        const int m0 = rb * 32, b = m0 / S;
        __syncthreads();
        for (int c = F.tid; c < 2048; c += 512) {
            float s0 = 0.f, s1 = 0.f;
            if (PART) { const float* pp = parts + ((size_t)l * 4 + b) * 12288 + c;
#pragma unroll 1
                for (int kc = 0; kc < 16; ++kc) { s0 += pp[sh_off]; s1 += pp[sc_off]; pp += 2 * 4 * 12288; }
            } else { const float* mp = mod + ((size_t)l * 4 + b) * 12288; s0 = mp[sh_off + c]; s1 = mp[sc_off + c]; }
            shs[c] = s0; scs[c] = s1 + 1.0f;
        }
        __syncthreads();
        for (int r = 0; r < 4; ++r) {
            const int m = m0 + F.wave * 4 + r;
            const float* xr = x + (size_t)m * D;
            f32x4 v[8]; float ss = 0.f;
#pragma unroll
            for (int j = 0; j < 8; ++j) { v[j] = *(const f32x4*)(xr + F.lane * 4 + 256 * j); ss += v[j].x * v[j].x + v[j].y * v[j].y + v[j].z * v[j].z + v[j].w * v[j].w; }
            const float rr = rsqrtf(wave_sum(ss) * (1.0f / D) + EPS);
#pragma unroll
            for (int j = 0; j < 8; ++j) { const int c = F.lane * 4 + 256 * j;
                const f32x4 g = *(const f32x4*)(gain + c), s1 = *(const LAS f32x4*)(scs + c), s0 = *(const LAS f32x4*)(shs + c);
                const f32x4 y = (v[j] * rr) * g * s1 + s0;
                *(v2u*)(out + (size_t)m * D + c) = (v2u){pk2(y.x, y.y), pk2(y.z, y.w)}; }
        }
    }
    __syncthreads();
}

__device__ __forceinline__ void cmp1_naive(KA a, Frame& F, int l) {
    const bf16* proj = (const bf16*)(a->ws + WS_PROJ); float* hid = (float*)(a->ws + WS_MISC + MS_HID);
    const long gt = (long)F.vb * 512 + F.tid, GT = (long)F.G * 512;
    constexpr int ROWS = NB * NCMP * 2;
    for (long i = gt; i < 2L * ROWS * 256; i += GT) {
        const int c = (int)(i & 255); const int row = (int)((i >> 8) % ROWS), kv = (int)((i >> 8) / ROWS);
        const int g = row & 1, n = (row >> 1) % NCMP, b = (row >> 1) / NCMP;
        const float* w1 = (const float*)a->in[kv ? I_CVW1 : I_CKW1] + (size_t)l * 4096 * 256 + c;
        const float* pe = (const float*)a->in[kv ? I_CVPOS : I_CKPOS] + (size_t)l * 4096;
        const bf16* ap = proj + (size_t)(b * S + 16 * n) * NPROJ + (kv ? C_VC : C_KC) + g * 128;
        float acc = ((const float*)a->in[kv ? I_CVB1 : I_CKB1])[l * 256 + c];
        for (int tl = 0; tl < 32; ++tl) {
#pragma unroll 8
            for (int d = 0; d < 128; ++d) acc += (bf2f(ap[(size_t)tl * NPROJ + d]) + pe[tl * 128 + d]) * w1[(size_t)(tl * 128 + d) * 256];
        }
        hid[i] = gelu_tanh(acc);
    }
}
__device__ __forceinline__ void cmp2_naive(KA a, Frame& F, int l) {
    const float* hid = (const float*)(a->ws + WS_MISC + MS_HID); float* kc = (float*)(a->ws + WS_MISC + MS_KC);
    const long gt = (long)F.vb * 512 + F.tid, GT = (long)F.G * 512;
    constexpr int ROWS = NB * NCMP * 2;
    for (long i = gt; i < 2L * ROWS * 128; i += GT) {
        const int j = (int)(i & 127); const int row = (int)((i >> 7) % ROWS), kv = (int)((i >> 7) / ROWS);
        const float* w2 = (const float*)a->in[kv ? I_CVW2 : I_CKW2] + (size_t)l * 256 * 128 + j;
        const float* hr = hid + ((size_t)kv * ROWS + row) * 256;
        float acc = ((const float*)a->in[kv ? I_CVB2 : I_CKB2])[l * 128 + j];
#pragma unroll 8
        for (int c = 0; c < 256; ++c) acc += hr[c] * w2[(size_t)c * 128];
        const int g = row & 1, n = (row >> 1) % NCMP, b = (row >> 1) / NCMP;
        kc[((((size_t)kv * NB + b) * 128 + n) * 2 + g) * 128 + j] = acc;
        if (kv == 0) ((bf16*)(a->ws + WS_KCB))[((size_t)(b * 2 + g) * 128 + n) * 128 + j] = (bf16)f2bf(acc);
        else ((bf16*)(a->ws + WS_VCT))[((size_t)(b * 2 + g) * 128 + j) * 128 + perm16(n)] = (bf16)f2bf(acc);
    }
    for (long i = gt; i < 2L * NB * 2 * 128; i += GT) {
        const int j = (int)(i & 127), bg = (int)((i >> 7) & 7), kv = (int)(i >> 10);
        if (kv == 0) ((bf16*)(a->ws + WS_KCB))[((size_t)bg * 128 + 127) * 128 + j] = 0;
        else ((bf16*)(a->ws + WS_VCT))[((size_t)bg * 128 + j) * 128 + perm16(127)] = 0;
    }
}

__device__ __forceinline__ void hgrn_naive(KA a, Frame& F, int l) {
    if (F.wave != 0 || F.vb >= 128) return;
    const bf16* proj = (const bf16*)(a->ws + WS_PROJ); float* hraw = (float*)(a->ws + WS_HRAW);
    LAS float* fs = (LAS float*)(F.lds + 65536); LAS float* ks = fs + 128; LAS float* qs = fs + 256;
    const int item = F.vb, eq = item & 3, h = (item >> 2) & 7, b = item >> 5;
    const int e = eq * 32 + (F.lane & 31), dh = F.lane >> 5;
    const float* lbp = (const float*)a->in[I_HLB];
    float lb0, lb1;
    { const float a0 = lbp[h * 128 + F.lane], a1 = lbp[1024 + h * 128 + F.lane]; lb0 = (l == 0) ? 0.f : 1.0f / (1.0f + __expf(a0 - a1));
      const float c0 = lbp[h * 128 + 64 + F.lane], c1 = lbp[1024 + h * 128 + 64 + F.lane]; lb1 = (l == 0) ? 0.f : 1.0f / (1.0f + __expf(c0 - c1)); }
    float st[64];
#pragma unroll
    for (int d = 0; d < 64; ++d) st[d] = 0.f;
    for (int t = 0; t < S; ++t) {
        const bf16* pr = proj + (size_t)(b * S + t) * NPROJ;
        const float f0 = lb0 + (1.0f - lb0) * sigmoidf_(bf2f(pr[C_HF + h * 128 + F.lane])), f1 = lb1 + (1.0f - lb1) * sigmoidf_(bf2f(pr[C_HF + h * 128 + 64 + F.lane]));
        fs[F.lane] = f0; fs[64 + F.lane] = f1; ks[F.lane] = 1.0f - f0; ks[64 + F.lane] = 1.0f - f1;
        qs[F.lane] = siluf_(bf2f(pr[C_HQ + h * 128 + F.lane])); qs[64 + F.lane] = siluf_(bf2f(pr[C_HQ + h * 128 + 64 + F.lane]));
        const float v = bf2f(pr[C_HI + h * 128 + e]);
        asm volatile("s_waitcnt lgkmcnt(0)" ::: "memory");
        float o = 0.f;
#pragma unroll
        for (int d = 0; d < 64; ++d) { st[d] = fs[dh * 64 + d] * st[d] + ks[dh * 64 + d] * v; o += st[d] * qs[dh * 64 + d]; }
        o += __shfl_xor(o, 32);
        if (dh == 0) hraw[(size_t)(b * S + t) * 1024 + h * 128 + e] = o;
        asm volatile("s_waitcnt lgkmcnt(0)" ::: "memory");
    }
}
__device__ __forceinline__ void hgrn_norm_naive(KA a, Frame& F, int l) {
    const bf16* proj = (const bf16*)(a->ws + WS_PROJ); const float* hraw = (const float*)(a->ws + WS_HRAW); bf16* omix = (bf16*)(a->ws + WS_OMIX);
    const float* gn = (const float*)a->in[I_HNORM] + l * 1024;
    const int gw = F.vb * 8 + F.wave, NGW = F.G * 8;
    for (int i = gw; i < T * 8; i += NGW) { const int m = i >> 3, h = i & 7;
        const float o0 = hraw[(size_t)m * 1024 + h * 128 + F.lane], o1 = hraw[(size_t)m * 1024 + h * 128 + 64 + F.lane];
        const float r = rsqrtf(wave_sum(o0 * o0 + o1 * o1) * (1.0f / 128.0f) + EPS);
        const bf16* pr = proj + (size_t)m * NPROJ + C_HG + h * 128;
#ifdef EXP_NO_HGRN
        omix[(size_t)m * D + 1024 + h * 128 + F.lane] = 0; omix[(size_t)m * D + 1024 + h * 128 + 64 + F.lane] = 0; continue;
#endif
        omix[(size_t)m * D + 1024 + h * 128 + F.lane] = (bf16)f2bf(o0 * r * gn[h * 128 + F.lane] * sigmoidf_(bf2f(pr[F.lane])));
        omix[(size_t)m * D + 1024 + h * 128 + 64 + F.lane] = (bf16)f2bf(o1 * r * gn[h * 128 + 64 + F.lane] * sigmoidf_(bf2f(pr[64 + F.lane])));
    }
}

__device__ __forceinline__ void catt_naive(KA a, Frame& F) {
    const bf16* proj = (const bf16*)(a->ws + WS_PROJ); const float* kc = (const float*)(a->ws + WS_MISC + MS_KC); const float* vc = kc + (size_t)NB * 128 * 2 * 128;
    float* oacc = (float*)(a->ws + WS_OACC); unsigned* sel = (unsigned*)(a->ws + WS_MISC + MS_SEL);
    LAS float* qs = (LAS float*)(F.lds + F.wave * 2048); LAS float* ps = qs + 128;
    const int gw = F.vb * 8 + F.wave, NGW = F.G * 8;
    for (int i = gw; i < NB * 2 * S; i += NGW) {
        const int s = i % S, g = (i / S) & 1, b = i / (2 * S), m = b * S + s;
        const int nv = s >= 31 ? (s - 31) / 16 + 1 : 0;
        const bf16* pr = proj + (size_t)m * NPROJ;
        float imp = 0.f;
        for (int hh = 0; hh < 4; ++hh) {
            const int head = g * 4 + hh;
            qs[F.lane] = bf2f(pr[C_Q + head * 128 + F.lane]); qs[64 + F.lane] = bf2f(pr[C_Q + head * 128 + 64 + F.lane]);
            asm volatile("s_waitcnt lgkmcnt(0)" ::: "memory");
            float sc[2];
#pragma unroll
            for (int u = 0; u < 2; ++u) { const int n = F.lane + 64 * u; float acc = 0.f;
                if (n < nv) { const float* kr = kc + (((size_t)b * 128 + n) * 2 + g) * 128;
#pragma unroll 8
                    for (int d = 0; d < 128; ++d) acc += qs[d] * kr[d]; }
                sc[u] = (n < nv) ? acc * ATT_SCALE : -__builtin_inff(); }
            float mx = wave_max(fmaxf(sc[0], sc[1])); if (!(mx > -1e30f)) mx = 0.f;
            const float e0 = (F.lane < nv) ? __expf(sc[0] - mx) : 0.f, e1 = (F.lane + 64 < nv) ? __expf(sc[1] - mx) : 0.f;
            const float den = fmaxf(wave_sum(e0 + e1), 1e-30f);
            ps[F.lane] = e0 / den; ps[64 + F.lane] = e1 / den;
            asm volatile("s_waitcnt lgkmcnt(0)" ::: "memory");
            float o0 = 0.f, o1 = 0.f;
            for (int n = 0; n < nv; ++n) { const float p = ps[n]; const float* vr = vc + (((size_t)b * 128 + n) * 2 + g) * 128; o0 += p * vr[F.lane]; o1 += p * vr[64 + F.lane]; }
            const float g0 = sigmoidf_(bf2f(pr[C_GL + head * 3 + 0]));
            oacc[(size_t)m * 1024 + head * 128 + F.lane] = g0 * o0; oacc[(size_t)m * 1024 + head * 128 + 64 + F.lane] = g0 * o1;
            if (F.lane < 32) { const int j = F.lane; float v = ps[4 * j] + ps[4 * j + 1] + ps[4 * j + 2] + 0.5f * (4 * j + 3 < NCMP ? ps[4 * j + 3] : 0.f); if (j > 0) v += 0.5f * ps[4 * j - 1]; imp += v; }
            asm volatile("s_waitcnt lgkmcnt(0)" ::: "memory");
        }
        const int qb = s >> 6, j = F.lane & 31;
        const bool forced = (j == 0) || (j == qb) || (j + 1 == qb);
        const float score = forced ? __builtin_inff() : (j <= qb ? imp : -__builtin_inff());
        int rank = 0;
#pragma unroll
        for (int k = 0; k < 32; ++k) { const float o = __shfl(score, k); rank += (o > score || (o == score && k < j)) ? 1 : 0; }
        const unsigned long long bal = __ballot(F.lane < 32 && rank < 16 && j <= qb);
        if (F.lane == 0) sel[i] = (unsigned)bal;
    }
}

__device__ __forceinline__ float dot_rope(const LAS float* qs, const bf16* kr, const float* cr, const float* sr) {
    float acc = 0.f;
#pragma unroll
    for (int d = 0; d < 16; ++d) { const float k1 = bf2f(kr[d]), k2 = bf2f(kr[d + 16]), c = cr[d], sn = sr[d];
        acc += qs[d] * (k1 * c - k2 * sn) + qs[d + 16] * (k2 * c + k1 * sn); }
#pragma unroll 8
    for (int d = 32; d < 128; ++d) acc += qs[d] * bf2f(kr[d]);
    return acc;
}
__device__ __forceinline__ void satt_naive(KA a, Frame& F) {
    const bf16* proj = (const bf16*)(a->ws + WS_PROJ); const float* oacc = (const float*)(a->ws + WS_OACC); bf16* omix = (bf16*)(a->ws + WS_OMIX);
    const unsigned* sel = (const unsigned*)(a->ws + WS_MISC + MS_SEL);
    const float* rc = (const float*)(a->ws + WS_MISC + MS_ROPEC); const float* rs = (const float*)(a->ws + WS_MISC + MS_ROPES);
    LAS float* qs = (LAS float*)(F.lds + F.wave * 8192); LAS float* ps = qs + 128;
    const int gw = F.vb * 8 + F.wave, NGW = F.G * 8;
    for (int i = gw; i < NB * 8 * S; i += NGW) {
        const int s = i % S, head = (i / S) & 7, b = i / (8 * S), m = b * S + s, g = head >> 2;
        const bf16* pr = proj + (size_t)m * NPROJ;
        { const float q0 = bf2f(pr[C_Q + head * 128 + F.lane]), q1 = bf2f(pr[C_Q + head * 128 + 64 + F.lane]);
          float qo = q0; const float other = __shfl_xor(q0, 16);
          if (F.lane < 32) { const int dd = F.lane & 15; const float c = rc[m * 16 + dd], sn = rs[m * 16 + dd];
              qo = (F.lane < 16) ? q0 * c - other * sn : q0 * c + other * sn; }
          qs[F.lane] = qo; qs[64 + F.lane] = q1; }
        asm volatile("s_waitcnt lgkmcnt(0)" ::: "memory");
        float res0 = oacc[(size_t)m * 1024 + head * 128 + F.lane], res1 = oacc[(size_t)m * 1024 + head * 128 + 64 + F.lane];
        const float g1 = sigmoidf_(bf2f(pr[C_GL + head * 3 + 1])), g2 = sigmoidf_(bf2f(pr[C_GL + head * 3 + 2]));
        {
            const unsigned mask = sel[(b * 2 + g) * S + s];
            unsigned mm = mask; float mx = -__builtin_inff();
#pragma nounroll
            for (int u = 0; u < 16; ++u) { float v = -__builtin_inff();
                if (mm) { const int j = __builtin_ctz(mm); mm &= mm - 1; const int key = 64 * j + F.lane;
                    if (key <= s) { const int mk = b * S + key; v = dot_rope(qs, proj + (size_t)mk * NPROJ + C_KS + g * 128, rc + mk * 16, rs + mk * 16) * ATT_SCALE; } }
                ps[u * 64 + F.lane] = v; mx = fmaxf(mx, v); }
            mx = wave_max(mx);
            float sum = 0.f;
#pragma nounroll
            for (int u = 0; u < 16; ++u) { const float e = __expf(ps[u * 64 + F.lane] - mx); ps[u * 64 + F.lane] = e; sum += e; }
            sum = wave_sum(sum);
            asm volatile("s_waitcnt lgkmcnt(0)" ::: "memory");
            float o0 = 0.f, o1 = 0.f; mm = mask;
            for (int u = 0; u < 16 && mm; ++u) { const int j = __builtin_ctz(mm); mm &= mm - 1;
                const int kmax = min(63, s - 64 * j);
                for (int k = 0; k <= kmax; ++k) { const float p = ps[u * 64 + k]; const bf16* vr = proj + (size_t)(b * S + 64 * j + k) * NPROJ + C_VS + g * 128;
                    o0 += p * bf2f(vr[F.lane]); o1 += p * bf2f(vr[64 + F.lane]); } }
            res0 += g1 * o0 / sum; res1 += g1 * o1 / sum;
            asm volatile("s_waitcnt lgkmcnt(0)" ::: "memory");
        }
        {
            float mx = -__builtin_inff();
#pragma nounroll
            for (int u = 0; u < 8; ++u) { const int key = s - 511 + 64 * u + F.lane; float v = -__builtin_inff();
                if (key >= 0) { const int mk = b * S + key; v = dot_rope(qs, proj + (size_t)mk * NPROJ + C_KW + g * 128, rc + mk * 16, rs + mk * 16) * ATT_SCALE; }
                ps[u * 64 + F.lane] = v; mx = fmaxf(mx, v); }
            mx = wave_max(mx);
            float sum = 0.f;
#pragma nounroll
            for (int u = 0; u < 8; ++u) { const float e = __expf(ps[u * 64 + F.lane] - mx); ps[u * 64 + F.lane] = e; sum += e; }
            sum = wave_sum(sum);
            asm volatile("s_waitcnt lgkmcnt(0)" ::: "memory");
            float o0 = 0.f, o1 = 0.f;
            const int k0 = max(0, 511 - s);
            for (int k = k0; k < 512; ++k) { const float p = ps[k]; const bf16* vr = proj + (size_t)(b * S + s - 511 + k) * NPROJ + C_VW + g * 128;
                o0 += p * bf2f(vr[F.lane]); o1 += p * bf2f(vr[64 + F.lane]); }
            res0 += g2 * o0 / sum; res1 += g2 * o1 / sum;
            asm volatile("s_waitcnt lgkmcnt(0)" ::: "memory");
        }
#ifdef EXP_NO_NSA
        res0 = 0.f; res1 = 0.f;
#endif
        omix[(size_t)m * D + head * 128 + F.lane] = (bf16)f2bf(res0); omix[(size_t)m * D + head * 128 + 64 + F.lane] = (bf16)f2bf(res1);
    }
}

__device__ __forceinline__ void wave_argmax(float& v, int& i) {
#pragma unroll
    for (int o = 1; o < 64; o <<= 1) { const float ov = __shfl_xor(v, o); const int oi = __shfl_xor(i, o); if (ov > v || (ov == v && oi < i)) { v = ov; i = oi; } }
}
__device__ __forceinline__ void peer_topk(KA a, Frame& F, int l) {
    const bf16* pq = (const bf16*)(a->ws + WS_PQ); int* eidx = (int*)(a->ws + WS_EIDX); float* egate = (float*)(a->ws + WS_EGATE);
    const float* keys = (const float*)a->in[I_PKEYS] + (size_t)l * 8 * 2 * 128 * 128;
    LAS float* qs = (LAS float*)(F.lds + F.wave * 1024);
    const int gw = F.vb * 8 + F.wave, NGW = F.G * 8;
    const float NEG = -__builtin_inff();
    for (int i = gw; i < T * 8; i += NGW) {
        const int t = i >> 3, h = i & 7;
        const bf16* qr = pq + (size_t)t * D + h * 256;
#pragma unroll
        for (int u = 0; u < 4; ++u) qs[u * 64 + F.lane] = bf2f(qr[u * 64 + F.lane]);
        asm volatile("s_waitcnt lgkmcnt(0)" ::: "memory");
        float sv[2]; int si[2];
#pragma unroll
        for (int p = 0; p < 2; ++p) {
            const float* kp = keys + ((size_t)(h * 2 + p) * 128) * 128;
            float c0 = 0.f, c1 = 0.f;
#pragma unroll 4
            for (int d = 0; d < 128; ++d) { const float q = qs[p * 128 + d]; c0 += q * kp[(size_t)F.lane * 128 + d]; c1 += q * kp[(size_t)(F.lane + 64) * 128 + d]; }
            float tv = NEG; int ti = 0;
#pragma nounroll
            for (int r = 0; r < 16; ++r) {
                float bv; int bi; if (c1 > c0) { bv = c1; bi = F.lane + 64; } else { bv = c0; bi = F.lane; }
                wave_argmax(bv, bi);
                if (bi == F.lane) c0 = NEG; if (bi == F.lane + 64) c1 = NEG;
                if (F.lane == r) { tv = bv; ti = bi; }
            }
            sv[p] = tv; si[p] = ti;
        }
        float cv[4]; const int bsel = F.lane & 15; const float s2 = __shfl(sv[1], bsel);
#pragma unroll
        for (int r = 0; r < 4; ++r) cv[r] = __shfl(sv[0], (F.lane >> 4) + 4 * r) + s2;
        float tv = NEG; int tp = 0;
#pragma nounroll
        for (int r = 0; r < 16; ++r) {
            float bv = cv[0]; int bi = F.lane;
#pragma unroll
            for (int u = 1; u < 4; ++u) if (cv[u] > bv) { bv = cv[u]; bi = F.lane + 64 * u; }
            wave_argmax(bv, bi);
#pragma unroll
            for (int u = 0; u < 4; ++u) if (bi == F.lane + 64 * u) cv[u] = NEG;
            if (F.lane == r) { tv = bv; tp = bi; }
        }
        const int ia = __shfl(si[0], (tp >> 4) & 15), ib = __shfl(si[1], tp & 15);
        const float top = __shfl(tv, 0);
        float e = (F.lane < 16) ? __expf(tv - top) : 0.f;
        float sum = e;
#pragma unroll
        for (int o = 1; o < 16; o <<= 1) sum += __shfl_xor(sum, o);
        if (F.lane < 16) { eidx[(size_t)t * 128 + h * 16 + F.lane] = ia * 128 + ib; egate[(size_t)t * 128 + h * 16 + F.lane] = e / sum; }
    }
}

template <bool LAST>
__device__ __forceinline__ void peer_gather(KA a, Frame& F, int l, const float* x1, float* xo, const float* gate2  ) {
    const bf16* hb = (const bf16*)(a->ws + WS_H); const int* eidx = (const int*)(a->ws + WS_EIDX); const float* egate = (const float*)(a->ws + WS_EGATE);
    const bf16* pu = (const bf16*)(a->ws + WS_PU) + (size_t)l * 16384 * 2048; const bf16* pv = (const bf16*)(a->ws + WS_PV) + (size_t)l * 16384 * 2048;
    const int gw = F.vb * 8 + F.wave, NGW = F.G * 8;
    for (int t = gw; t < T; t += NGW) {
        v4u xh[4];
#pragma unroll
        for (int j = 0; j < 4; ++j) xh[j] = *(const v4u*)(hb + (size_t)t * D + 512 * j + 8 * F.lane);
        f32x2 acc[4][4];
#pragma unroll
        for (int j = 0; j < 4; ++j)
#pragma unroll
            for (int q = 0; q < 4; ++q) acc[j][q] = (f32x2){0.f, 0.f};
        const int* ei = eidx + (size_t)t * 128; const float* eg = egate + (size_t)t * 128;
#pragma unroll 2
        for (int k = 0; k < 128; ++k) {
            const int e = __builtin_amdgcn_readfirstlane(ei[k]); const float gk = __uint_as_float(__builtin_amdgcn_readfirstlane(__float_as_uint(eg[k])));
            const bf16* ur = pu + (size_t)e * 2048 + 8 * F.lane; const bf16* vr = pv + (size_t)e * 2048 + 8 * F.lane;
            v4u uu[4], vv[4];
#pragma unroll
            for (int j = 0; j < 4; ++j) { uu[j] = *(const v4u*)(ur + 512 * j); vv[j] = *(const v4u*)(vr + 512 * j); }
            float d = 0.f;
#pragma unroll
            for (int j = 0; j < 4; ++j) {
                const unsigned uw[4] = {uu[j].x, uu[j].y, uu[j].z, uu[j].w}, xw[4] = {xh[j].x, xh[j].y, xh[j].z, xh[j].w};
#pragma unroll
                for (int q = 0; q < 4; ++q) d += __uint_as_float(uw[q] << 16) * __uint_as_float(xw[q] << 16) + __uint_as_float(uw[q] & 0xffff0000u) * __uint_as_float(xw[q] & 0xffff0000u);
            }
            d = wave_sum(d);
            const float cf = gk * gelu_tanh(d);
#pragma unroll
            for (int j = 0; j < 4; ++j) {
                const unsigned w[4] = {vv[j].x, vv[j].y, vv[j].z, vv[j].w};
#pragma unroll
                for (int q = 0; q < 4; ++q) { const f32x2 vf = (f32x2){__uint_as_float(w[q] << 16), __uint_as_float(w[q] & 0xffff0000u)}; acc[j][q] += vf * cf; }
            }
        }
        const int b = t / S; const float* g2 = gate2 + (size_t)b * 12288;
        f32x4 o[4][2]; float ss = 0.f;
#pragma unroll
        for (int j = 0; j < 4; ++j)
#pragma unroll
            for (int hf = 0; hf < 2; ++hf) { const int c = 512 * j + 8 * F.lane + 4 * hf;
                const f32x4 xv = *(const f32x4*)(x1 + (size_t)t * D + c), gv = *(const f32x4*)(g2 + c);
                const f32x4 av = (f32x4){acc[j][2 * hf].x, acc[j][2 * hf].y, acc[j][2 * hf + 1].x, acc[j][2 * hf + 1].y};
#ifdef EXP_NO_PEER
                o[j][hf] = xv;
#elif defined(EXP_NEG_PEER)
                o[j][hf] = xv - gv * av;
#else
                o[j][hf] = xv + gv * av;
#endif
                ss += o[j][hf].x * o[j][hf].x + o[j][hf].y * o[j][hf].y + o[j][hf].z * o[j][hf].z + o[j][hf].w * o[j][hf].w; }
        if (LAST) { const float r = rsqrtf(wave_sum(ss) * (1.0f / D) + EPS); const float* fn = (const float*)a->in[I_FNORM];
#pragma unroll
            for (int j = 0; j < 4; ++j)
#pragma unroll
                for (int hf = 0; hf < 2; ++hf) { const int c = 512 * j + 8 * F.lane + 4 * hf; *(f32x4*)(xo + (size_t)t * D + c) = (o[j][hf] * r) * *(const f32x4*)(fn + c); } }
        else {
#pragma unroll
            for (int j = 0; j < 4; ++j)
#pragma unroll
                for (int hf = 0; hf < 2; ++hf) { const int c = 512 * j + 8 * F.lane + 4 * hf; *(f32x4*)(xo + (size_t)t * D + c) = o[j][hf]; } }
    }
}

typedef float f32x16 __attribute__((ext_vector_type(16)));
#define MFMA32(a, b, c) __builtin_amdgcn_mfma_f32_32x32x16_bf16((a), (b), (c), 0, 0, 0)
__device__ __forceinline__ unsigned cvtpk(float lo, float hi) { f32x2 v = {lo, hi}; bf16x2_t b = __builtin_convertvector(v, bf16x2_t); return __builtin_bit_cast(unsigned, b); }
constexpr int HG_TS = 144;
constexpr int HG_DS = 272;
constexpr int HL_SEG = 0, HL_KT = 2048, HL_VT = HL_KT + 128 * HG_TS, HL_QH = HL_VT + 128 * HG_TS, HL_QT = HL_QH + 64 * HG_DS, HL_K2 = HL_QT + 64 * HG_DS, HL_RED = HL_K2 + 64 * HG_DS;
static_assert(HL_RED + 1024 <= 131072, "hgrn LDS map");

__device__ __forceinline__ void hgrn_decay(const bf16* proj, const float* lbp, int l, int m0, int h, int d, int tq, LAS unsigned char* lds, float (&A)[16], float (&kk)[16], float& Aend, float& Amid) {
    float lb = 0.f;
    if (l != 0) { const float a0 = lbp[h * 128 + d], a1 = lbp[1024 + h * 128 + d]; lb = 1.0f / (1.0f + __expf(a0 - a1)); }
    float run = 0.f;
#pragma unroll
    for (int i = 0; i < 16; ++i) { const float x = bf2f(proj[(size_t)(m0 + 16 * tq + i) * NPROJ + C_HF + h * 128 + d]);
        const float f = lb + (1.0f - lb) * sigmoidf_(x); kk[i] = 1.0f - f; run += __logf(f); A[i] = run; }
    LAS float* seg = (LAS float*)(lds + HL_SEG);
    __syncthreads();
    seg[tq * 128 + d] = run;
    __syncthreads();
    const float s0 = seg[d], s1 = seg[128 + d], s2 = seg[256 + d], s3 = seg[384 + d];
    const float off = (tq > 0 ? s0 : 0.f) + (tq > 1 ? s1 : 0.f) + (tq > 2 ? s2 : 0.f);
#pragma unroll
    for (int i = 0; i < 16; ++i) A[i] += off;
    Aend = (s0 + s1) + (s2 + s3); Amid = s0 + s1;
}

__device__ __forceinline__ void hgrn_local(KA a, Frame& F, int l) {
    const bf16* proj = (const bf16*)(a->ws + WS_PROJ); float* ut = (float*)(a->ws + WS_UT); float* dec = (float*)(a->ws + WS_DEC);
    const float* lbp = (const float*)a->in[I_HLB];
    const int d = F.tid & 127, tq = F.tid >> 7, l32 = F.lane & 31, hi = F.lane >> 5;
    const bool deal = (F.G == 256); const int nmine = deal ? (F.vb < 128 ? 2 : 6) : (NB * 8 * 32 - F.vb + F.G - 1) / F.G;
    for (int it = 0; it < nmine; ++it) {
        const int item = deal ? (F.vb < 128 ? 2 * F.vb + it : 256 + 6 * (F.vb - 128) + it) : F.vb + it * F.G;
        const int c = item & 31, h = (item >> 5) & 7, b = item >> 8, m0 = b * S + c * 64;
        float A[16], kk[16], Aend, Amid;
        hgrn_decay(proj, lbp, l, m0, h, d, tq, F.lds, A, kk, Aend, Amid);
        unsigned kw[8], vw[8];
#pragma unroll
        for (int i = 0; i < 8; ++i) {
            kw[i] = cvtpk(kk[2 * i] * __expf(Aend - A[2 * i]), kk[2 * i + 1] * __expf(Aend - A[2 * i + 1]));
            const bf16 v0 = proj[(size_t)(m0 + 16 * tq + 2 * i) * NPROJ + C_HI + h * 128 + d], v1 = proj[(size_t)(m0 + 16 * tq + 2 * i + 1) * NPROJ + C_HI + h * 128 + d];
            vw[i] = (unsigned)v0 | ((unsigned)v1 << 16); }
        *(LAS v4u*)(F.lds + HL_KT + d * HG_TS + 32 * tq) = (v4u){kw[0], kw[1], kw[2], kw[3]}; *(LAS v4u*)(F.lds + HL_KT + d * HG_TS + 32 * tq + 16) = (v4u){kw[4], kw[5], kw[6], kw[7]};
        *(LAS v4u*)(F.lds + HL_VT + d * HG_TS + 32 * tq) = (v4u){vw[0], vw[1], vw[2], vw[3]}; *(LAS v4u*)(F.lds + HL_VT + d * HG_TS + 32 * tq + 16) = (v4u){vw[4], vw[5], vw[6], vw[7]};
        if (tq == 0) dec[(size_t)item * 128 + d] = __expf(Aend);
        __syncthreads();
        const int eblk = F.wave & 3;
#pragma unroll
        for (int dd = 0; dd < 2; ++dd) { const int dblk = 2 * (F.wave >> 2) + dd;
            f32x16 acc;
#pragma unroll
            for (int r = 0; r < 16; ++r) acc[r] = 0.f;
#pragma unroll
            for (int ks = 0; ks < 4; ++ks) {
                const bf16x8 af = *(const LAS bf16x8*)(F.lds + HL_KT + (32 * dblk + l32) * HG_TS + 32 * ks + 16 * hi);
                const bf16x8 bfr = *(const LAS bf16x8*)(F.lds + HL_VT + (32 * eblk + l32) * HG_TS + 32 * ks + 16 * hi);
                acc = MFMA32(af, bfr, acc); }
            float* up = ut + ((size_t)item * 128 + 32 * eblk + l32) * 128 + 32 * dblk + 4 * hi;
#pragma unroll
            for (int q = 0; q < 4; ++q) *(f32x4*)(up + 8 * q) = (f32x4){acc[4 * q], acc[4 * q + 1], acc[4 * q + 2], acc[4 * q + 3]};
        }
    }
    __syncthreads();
}

__device__ __forceinline__ void hgrn_scan(KA a, Frame& F) {
    const float* ut = (const float*)(a->ws + WS_UT); const float* dec = (const float*)(a->ws + WS_DEC); bf16* st = (bf16*)(a->ws + WS_ST);
    const long gt = (long)F.vb * 512 + F.tid, GT = (long)F.G * 512;
    for (long g = gt; g < 32L * 128 * 32; g += GT) {
        const int dq = (int)(g & 31), e = (int)((g >> 5) & 127), bh = (int)(g >> 12);
        f32x4 sacc = (f32x4){0.f, 0.f, 0.f, 0.f};
#pragma unroll 4
        for (int c = 0; c < 32; ++c) {
            const size_t idx = (((size_t)bh * 32 + c) * 128 + e) * 128 + 4 * dq;
            *(v2u*)(st + idx) = (v2u){cvtpk(sacc.x, sacc.y), cvtpk(sacc.z, sacc.w)};
            const f32x4 u = *(const f32x4*)(ut + idx), dc = *(const f32x4*)(dec + ((size_t)bh * 32 + c) * 128 + 4 * dq);
            sacc = dc * sacc + u; }
    }
}

__device__ __forceinline__ void hgrn_out(KA a, Frame& F, int l) {
    const bf16* proj = (const bf16*)(a->ws + WS_PROJ); const bf16* st = (const bf16*)(a->ws + WS_ST); bf16* omix = (bf16*)(a->ws + WS_OMIX);
    const float* lbp = (const float*)a->in[I_HLB]; const float* gn = (const float*)a->in[I_HNORM] + l * 1024;
    const int d = F.tid & 127, tq = F.tid >> 7, l32 = F.lane & 31, hi = F.lane >> 5;
    for (int item = F.vb; item < NB * 8 * 32; item += F.G) {
        const int c = item & 31, h = (item >> 5) & 7, b = item >> 8, m0 = b * S + c * 64;
        float A[16], kk[16], Aend, Amid;
        hgrn_decay(proj, lbp, l, m0, h, d, tq, F.lds, A, kk, Aend, Amid);
        unsigned vw[8];
#pragma unroll
        for (int i = 0; i < 16; ++i) { const int t = 16 * tq + i;
            const float qv = siluf_(bf2f(proj[(size_t)(m0 + t) * NPROJ + C_HQ + h * 128 + d]));
            *(LAS bf16*)(F.lds + HL_QH + t * HG_DS + 2 * d) = (bf16)(cvtpk(qv * __expf(A[i]), 0.f) & 0xffffu);
            *(LAS bf16*)(F.lds + HL_QT + t * HG_DS + 2 * d) = (bf16)(cvtpk(qv * __expf(A[i] - Amid), 0.f) & 0xffffu);
            *(LAS bf16*)(F.lds + HL_K2 + t * HG_DS + 2 * d) = (bf16)(cvtpk(kk[i] * __expf(Amid - A[i]), 0.f) & 0xffffu); }
#pragma unroll
        for (int i = 0; i < 8; ++i) {
            const bf16 v0 = proj[(size_t)(m0 + 16 * tq + 2 * i) * NPROJ + C_HI + h * 128 + d], v1 = proj[(size_t)(m0 + 16 * tq + 2 * i + 1) * NPROJ + C_HI + h * 128 + d];
            vw[i] = (unsigned)v0 | ((unsigned)v1 << 16); }
        *(LAS v4u*)(F.lds + HL_VT + d * HG_TS + 32 * tq) = (v4u){vw[0], vw[1], vw[4], vw[5]}; *(LAS v4u*)(F.lds + HL_VT + d * HG_TS + 32 * tq + 16) = (v4u){vw[2], vw[3], vw[6], vw[7]};
        __syncthreads();
        const int eblk = F.wave & 3, tblk = F.wave >> 2;
        f32x16 acc;
#pragma unroll
        for (int r = 0; r < 16; ++r) acc[r] = 0.f;
        { const bf16* sp = st + ((size_t)item * 128 + 32 * eblk + l32) * 128 + 8 * hi;
#pragma unroll
          for (int ks = 0; ks < 8; ++ks) { const bf16x8 af = *(const bf16x8*)(sp + 16 * ks);
              const bf16x8 bfr = *(const LAS bf16x8*)(F.lds + HL_QH + (32 * tblk + l32) * HG_DS + 32 * ks + 16 * hi);
              acc = MFMA32(af, bfr, acc); } }
#pragma unroll
        for (int stl = 0; stl < 2; ++stl) {
            if (stl <= tblk) {
                f32x16 P;
#pragma unroll
                for (int r = 0; r < 16; ++r) P[r] = 0.f;
#pragma unroll
                for (int ks = 0; ks < 8; ++ks) { const bf16x8 af = *(const LAS bf16x8*)(F.lds + HL_K2 + (32 * stl + l32) * HG_DS + 32 * ks + 16 * hi);
                    const bf16x8 bfr = *(const LAS bf16x8*)(F.lds + HL_QT + (32 * tblk + l32) * HG_DS + 32 * ks + 16 * hi);
                    P = MFMA32(af, bfr, P); }
                if (stl == tblk) {
#pragma unroll
                    for (int r = 0; r < 16; ++r) { const int sl = (r & 3) + 8 * (r >> 2) + 4 * hi; if (sl > l32) P[r] = 0.f; } }
#pragma unroll
                for (int hf = 0; hf < 2; ++hf) {
                    const v4u pw = (v4u){cvtpk(P[8 * hf], P[8 * hf + 1]), cvtpk(P[8 * hf + 2], P[8 * hf + 3]), cvtpk(P[8 * hf + 4], P[8 * hf + 5]), cvtpk(P[8 * hf + 6], P[8 * hf + 7])};
                    const bf16x8 af = *(const LAS bf16x8*)(F.lds + HL_VT + (32 * eblk + l32) * HG_TS + (32 * stl + 16 * hf) * 2 + 16 * hi);
                    acc = MFMA32(af, __builtin_bit_cast(bf16x8, pw), acc); }
            }
        }
        float ssq = 0.f;
#pragma unroll
        for (int r = 0; r < 16; ++r) ssq += acc[r] * acc[r];
        ssq += __shfl_xor(ssq, 32);
        LAS float* red = (LAS float*)(F.lds + HL_RED);
        if (hi == 0) red[eblk * 64 + 32 * tblk + l32] = ssq;
        __syncthreads();
        const int t = 32 * tblk + l32;
        const float tot = (red[t] + red[64 + t]) + (red[128 + t] + red[192 + t]);
        const float rinv = rsqrtf(tot * (1.0f / 128.0f) + EPS);
#pragma unroll
        for (int q = 0; q < 4; ++q) { const int e0 = 32 * eblk + 8 * q + 4 * hi;
            const f32x4 g4 = *(const f32x4*)(gn + h * 128 + e0);
            const v2u hgw = *(const v2u*)(proj + (size_t)(m0 + t) * NPROJ + C_HG + h * 128 + e0);
            const float o0 = acc[4 * q] * rinv * g4.x * sigmoidf_(__uint_as_float(hgw.x << 16)), o1 = acc[4 * q + 1] * rinv * g4.y * sigmoidf_(__uint_as_float(hgw.x & 0xffff0000u));
            const float o2 = acc[4 * q + 2] * rinv * g4.z * sigmoidf_(__uint_as_float(hgw.y << 16)), o3 = acc[4 * q + 3] * rinv * g4.w * sigmoidf_(__uint_as_float(hgw.y & 0xffff0000u));
            *(v2u*)(omix + (size_t)(m0 + t) * D + 1024 + h * 128 + e0) = (v2u){cvtpk(o0, o1), cvtpk(o2, o3)}; }
    }
    __syncthreads();
}

constexpr int AT_KS = 272;
constexpr int AT_VS = 144;
constexpr int AL_K0 = 0, AL_K1 = 64 * AT_KS, AL_V0 = 2 * 64 * AT_KS, AL_V1 = AL_V0 + 128 * AT_VS, AL_END = AL_V1 + 128 * AT_VS;
constexpr int AL_KC = 0, AL_VC = 128 * AT_KS, AL_IMPH = 2 * 128 * AT_KS, AL_IMPS = AL_IMPH + 4 * 64 * 32 * 4, AL_SEL = AL_IMPS + 64 * 32 * 4, AL_FSC = AL_SEL + 64 * 4, AL_CEND = AL_FSC + 4 * 64 * 2 * 4;
static_assert(AL_CEND <= 131072 && AL_END <= 131072, "attention LDS map");
constexpr float AT_C = ATT_SCALE * 1.4426950408889634f;

__device__ __forceinline__ void attn_prep(KA a, Frame& F) {
    const bf16* proj = (const bf16*)(a->ws + WS_PROJ);
    const float* rc = (const float*)(a->ws + WS_MISC + MS_ROPEC); const float* rs = (const float*)(a->ws + WS_MISC + MS_ROPES);
    const long gt = (long)F.vb * 512 + F.tid, GT = (long)F.G * 512;
    for (long i = gt; i < 2L * T * 2 * 16; i += GT) {
        const int c8 = (int)(i & 15), g = (int)((i >> 4) & 1), m = (int)((i >> 5) % T), ten = (int)(i / (32L * T));
        const bf16* src = proj + (size_t)m * NPROJ + (ten ? C_KW : C_KS) + g * 128;
        v4u x = *(const v4u*)(src + 8 * c8);
        if (c8 < 4) { const v4u y = *(const v4u*)(src + 8 * (c8 ^ 2));
            const f32x4 c0 = *(const f32x4*)(rc + m * 16 + 8 * (c8 & 1)), c1 = *(const f32x4*)(rc + m * 16 + 8 * (c8 & 1) + 4), s0 = *(const f32x4*)(rs + m * 16 + 8 * (c8 & 1)), s1 = *(const f32x4*)(rs + m * 16 + 8 * (c8 & 1) + 4);
            const float cc[8] = {c0.x, c0.y, c0.z, c0.w, c1.x, c1.y, c1.z, c1.w}, sn[8] = {s0.x, s0.y, s0.z, s0.w, s1.x, s1.y, s1.z, s1.w};
            const unsigned xw[4] = {x.x, x.y, x.z, x.w}, yw[4] = {y.x, y.y, y.z, y.w}; unsigned ow[4];
            const float sg = (c8 < 2) ? -1.f : 1.f;
#pragma unroll
            for (int q = 0; q < 4; ++q) { const float x0 = __uint_as_float(xw[q] << 16), x1 = __uint_as_float(xw[q] & 0xffff0000u), y0 = __uint_as_float(yw[q] << 16), y1 = __uint_as_float(yw[q] & 0xffff0000u);
                ow[q] = cvtpk(x0 * cc[2 * q] + sg * y0 * sn[2 * q], x1 * cc[2 * q + 1] + sg * y1 * sn[2 * q + 1]); }
            x = (v4u){ow[0], ow[1], ow[2], ow[3]}; }
        const int b = m / S, s = m % S;
        *(v4u*)((bf16*)(a->ws + (ten ? WS_KWR : WS_KSR)) + (((size_t)(b * 2 + g) * S + s) * 128 + 8 * c8)) = x;
    }
    const int gw = F.vb * 8 + F.wave, NGW = F.G * 8;
    for (int it = gw; it < 2 * NB * 2 * 32; it += NGW) {
        const int kb = it & 31, g = (it >> 5) & 1, b = (it >> 6) & 3, ten = it >> 8;
        const bf16* src = proj + (size_t)(b * S + 64 * kb) * NPROJ + (ten ? C_VW : C_VS) + g * 128;
        bf16* dst = (bf16*)(a->ws + (ten ? WS_VWT : WS_VST)) + ((size_t)(b * 2 + g) * 128) * S + 64 * kb;
#pragma unroll
        for (int hd = 0; hd < 2; ++hd) { const int d = F.lane + 64 * hd;
            unsigned w[32];
#pragma unroll
            for (int k2 = 0; k2 < 32; ++k2) { const unsigned lo = src[(size_t)(2 * k2) * NPROJ + d], hi = src[(size_t)(2 * k2 + 1) * NPROJ + d]; w[k2] = lo | (hi << 16); }
#pragma unroll
            for (int g16 = 0; g16 < 4; ++g16) { const unsigned* p = w + 8 * g16;
                *(v4u*)(dst + (size_t)d * S + 16 * g16) = (v4u){p[0], p[1], p[4], p[5]}; *(v4u*)(dst + (size_t)d * S + 16 * g16 + 8) = (v4u){p[2], p[3], p[6], p[7]}; }
        }
    }
}

struct AttnState { f32x16 o[4]; float m, l; };
struct NoHook { __device__ __forceinline__ void operator()(const f32x16 (&)[2], float) const {} };
template <int VS, class Mask, class Hook>
__device__ __forceinline__ void attn_tile(AttnState& st, const bf16x8 (&qf)[8], const LAS unsigned char* kt, const LAS unsigned char* vt, int l32, int hi, bool need_mask, const Mask& valid, const Hook& hook) {
    f32x16 p[2];
#pragma unroll
    for (int kb = 0; kb < 2; ++kb) {
#pragma unroll
        for (int r = 0; r < 16; ++r) p[kb][r] = 0.f;
#pragma unroll
        for (int ks = 0; ks < 8; ++ks) { const bf16x8 kf = *(const LAS bf16x8*)(kt + (32 * kb + l32) * AT_KS + 32 * ks + 16 * hi); p[kb] = MFMA32(kf, qf[ks], p[kb]); }
        __builtin_amdgcn_sched_barrier(0);
    }
    if (need_mask) {
#pragma unroll
        for (int kb = 0; kb < 2; ++kb)
#pragma unroll
            for (int r = 0; r < 16; ++r) { const int kl = 32 * kb + (r & 3) + 8 * (r >> 2) + 4 * hi; if (!valid(kl)) p[kb][r] = -__builtin_inff(); }
    }
    float mx = p[0][0];
#pragma unroll
    for (int r = 1; r < 16; ++r) mx = fmaxf(mx, p[0][r]);
#pragma unroll
    for (int r = 0; r < 16; ++r) mx = fmaxf(mx, p[1][r]);
    mx = fmaxf(mx, __shfl_xor(mx, 32));
    const float mn = fmaxf(st.m, mx);
    const float alpha = __builtin_amdgcn_exp2f((st.m - mn) * AT_C);
    st.m = mn;
    const float mo = -mn * AT_C;
    float rs = 0.f;
#pragma unroll
    for (int kb = 0; kb < 2; ++kb)
#pragma unroll
        for (int r = 0; r < 16; ++r) { p[kb][r] = __builtin_amdgcn_exp2f(fmaf(p[kb][r], AT_C, mo)); rs += p[kb][r]; }
    rs += __shfl_xor(rs, 32);
    st.l = st.l * alpha + rs;
    hook(p, alpha);
#pragma unroll
    for (int db = 0; db < 4; ++db)
#pragma unroll
        for (int r = 0; r < 16; ++r) st.o[db][r] *= alpha;
#pragma unroll
    for (int kq = 0; kq < 4; ++kq) {
        const int kb = kq >> 1, h8 = 8 * (kq & 1);
        const v4u pw = (v4u){cvtpk(p[kb][h8], p[kb][h8 + 1]), cvtpk(p[kb][h8 + 2], p[kb][h8 + 3]), cvtpk(p[kb][h8 + 4], p[kb][h8 + 5]), cvtpk(p[kb][h8 + 6], p[kb][h8 + 7])};
        const bf16x8 pf = __builtin_bit_cast(bf16x8, pw);
#pragma unroll
        for (int db = 0; db < 4; ++db) { const bf16x8 vf = *(const LAS bf16x8*)(vt + (32 * db + l32) * VS + 32 * kq + 16 * hi); st.o[db] = MFMA32(vf, pf, st.o[db]); }
        __builtin_amdgcn_sched_barrier(0);
    }
}
struct TileRegs { v4u k[2], v[2]; };
__device__ __forceinline__ void tile_load(TileRegs& tr, const bf16* kg, const bf16* vg, int tid) {
#pragma unroll
    for (int u = 0; u < 2; ++u) { const int i = tid + 512 * u; tr.k[u] = *(const v4u*)(kg + (size_t)(i >> 4) * 128 + 8 * (i & 15)); tr.v[u] = *(const v4u*)(vg + (size_t)(i >> 3) * S + 8 * (i & 7)); }
}
__device__ __forceinline__ void tile_store(const TileRegs& tr, LAS unsigned char* kt, LAS unsigned char* vt, int tid) {
#pragma unroll
    for (int u = 0; u < 2; ++u) { const int i = tid + 512 * u; *(LAS v4u*)(kt + (i >> 4) * AT_KS + 16 * (i & 15)) = tr.k[u]; *(LAS v4u*)(vt + (i >> 3) * AT_VS + 16 * (i & 7)) = tr.v[u]; }
}
__device__ __forceinline__ void load_q(bf16x8 (&qf)[8], const bf16* qrow, int hi) {
#pragma unroll
    for (int ks = 0; ks < 8; ++ks) qf[ks] = *(const bf16x8*)(qrow + 16 * ks + 8 * hi);
}
__device__ __forceinline__ void rope_q(bf16x8 (&qf)[8], const float* rc, const float* rs, int hi) {
    const f32x4 c0 = *(const f32x4*)(rc + 8 * hi), c1 = *(const f32x4*)(rc + 8 * hi + 4), s0 = *(const f32x4*)(rs + 8 * hi), s1 = *(const f32x4*)(rs + 8 * hi + 4);
    const float cc[8] = {c0.x, c0.y, c0.z, c0.w, c1.x, c1.y, c1.z, c1.w}, sn[8] = {s0.x, s0.y, s0.z, s0.w, s1.x, s1.y, s1.z, s1.w};
    const v4u a = __builtin_bit_cast(v4u, qf[0]), b = __builtin_bit_cast(v4u, qf[1]);
    const unsigned aw[4] = {a.x, a.y, a.z, a.w}, bw[4] = {b.x, b.y, b.z, b.w}; unsigned oa[4], ob[4];
#pragma unroll
    for (int q = 0; q < 4; ++q) { const float a0 = __uint_as_float(aw[q] << 16), a1 = __uint_as_float(aw[q] & 0xffff0000u), b0 = __uint_as_float(bw[q] << 16), b1 = __uint_as_float(bw[q] & 0xffff0000u);
        oa[q] = cvtpk(a0 * cc[2 * q] - b0 * sn[2 * q], a1 * cc[2 * q + 1] - b1 * sn[2 * q + 1]);
        ob[q] = cvtpk(b0 * cc[2 * q] + a0 * sn[2 * q], b1 * cc[2 * q + 1] + a1 * sn[2 * q + 1]); }
    qf[0] = __builtin_bit_cast(bf16x8, (v4u){oa[0], oa[1], oa[2], oa[3]}); qf[1] = __builtin_bit_cast(bf16x8, (v4u){ob[0], ob[1], ob[2], ob[3]});
}

__device__ __forceinline__ void attn_cmp_sel(KA a, Frame& F) {
#define WSF(off) (({ KA _p = (KA)__builtin_amdgcn_kernarg_segment_ptr(); asm volatile("" : "+s"(_p)); _p; })->ws + (off))
    const int hh = F.wave >> 1, qh = F.wave & 1;
    for (int item = F.vb; item < NB * 2 * 32; item += F.G) {
        int tidl = F.tid; asm volatile("" : "+v"(tidl));
        int l32 = tidl & 31, hi = (tidl >> 5) & 1;
        const int qb = item >> 3, g = item & 1, b = (item >> 1) & 3, head = g * 4 + hh;
        const int sq = 64 * qb + 32 * qh + l32, m = b * S + sq;
        bf16x8 qf[8];
        load_q(qf, (const bf16*)WSF(WS_PROJ) + (size_t)m * NPROJ + C_Q + head * 128, hi);
        __syncthreads();
        { const bf16* kg = (const bf16*)WSF(WS_KCB) + (size_t)(b * 2 + g) * 128 * 128; const bf16* vg = (const bf16*)WSF(WS_VCT) + (size_t)(b * 2 + g) * 128 * 128;
#pragma unroll
          for (int u = 0; u < 4; ++u) { const int i = tidl + 512 * u; const int row = i >> 4, ch = i & 15;
              *(LAS v4u*)(F.lds + AL_KC + row * AT_KS + 16 * ch) = *(const v4u*)(kg + (size_t)row * 128 + 8 * ch);
              *(LAS v4u*)(F.lds + AL_VC + row * AT_KS + 16 * ch) = *(const v4u*)(vg + (size_t)row * 128 + 8 * ch); }
          if (tidl < 64) *(LAS unsigned*)(F.lds + AL_SEL + 4 * tidl) = 0u; }
        __syncthreads();
        const int nv = sq >= 31 ? (sq - 31) / 16 + 1 : 0;
        AttnState st;
#pragma unroll
        for (int db = 0; db < 4; ++db)
#pragma unroll
            for (int r = 0; r < 16; ++r) st.o[db][r] = 0.f;
        st.m = -1e30f; st.l = 0.f;
        float prev = 0.f, alpha1 = 1.f;
        LAS float* imph = (LAS float*)(F.lds + AL_IMPH) + (hh * 64 + 32 * qh + l32) * 32;
#pragma unroll
        for (int stp = 0; stp < 2; ++stp) {
            attn_tile<AT_KS>(st, qf, F.lds + AL_KC + 64 * stp * AT_KS, F.lds + AL_VC + 128 * stp, l32, hi, true, [&](int kl) { return 64 * stp + kl < nv; },
                [&](const f32x16 (&p)[2], float alpha) {
                    if (stp == 1) alpha1 = alpha;
                    prev *= alpha;
#pragma unroll
                    for (int kb = 0; kb < 2; ++kb)
#pragma unroll
                        for (int q = 0; q < 4; ++q) {
                            const float bk = 0.5f * p[kb][4 * q + 3];
                            const float ak = p[kb][4 * q] + p[kb][4 * q + 1] + p[kb][4 * q + 2] + bk;
                            const float ob = __shfl_xor(bk, 32);
                            imph[16 * stp + 8 * kb + 2 * q + hi] = ak + (hi ? ob : prev);
                            prev = ob;
                        }
                });
        }
        const float inv = 1.0f / fmaxf(st.l, 1e-30f);
        if (hi == 0) { LAS float* fsc = (LAS float*)(F.lds + AL_FSC) + (hh * 64 + 32 * qh + l32) * 2; fsc[0] = alpha1 * inv; fsc[1] = inv; }
        const bf16* gl = (const bf16*)WSF(WS_PROJ) + (size_t)m * NPROJ + C_GL + head * 3;
        const float g1 = sigmoidf_(bf2f(gl[1]));
        const float g0 = sigmoidf_(bf2f(gl[0])) * inv;
        { float* op = (float*)WSF(WS_OACC) + (size_t)m * 1024 + head * 128 + 4 * hi;
#pragma unroll
          for (int db = 0; db < 4; ++db)
#pragma unroll
              for (int q = 0; q < 4; ++q) *(f32x4*)(op + 32 * db + 8 * q) = (f32x4){g0 * st.o[db][4 * q], g0 * st.o[db][4 * q + 1], g0 * st.o[db][4 * q + 2], g0 * st.o[db][4 * q + 3]}; }
        unsigned mymask;
        if (qb < 16) { mymask = (2u << qb) - 1u; __syncthreads(); }
        else {
            __syncthreads();
            LAS float* imph = (LAS float*)(F.lds + AL_IMPH); LAS float* imps = (LAS float*)(F.lds + AL_IMPS); LAS unsigned* selw = (LAS unsigned*)(F.lds + AL_SEL); LAS float* fsc = (LAS float*)(F.lds + AL_FSC);
            int tids = F.tid; asm volatile("" : "+v"(tids)); const int qq = tids >> 3, part = tids & 7;
#pragma unroll
            for (int u = 0; u < 4; ++u) { const int j = 4 * part + u;
                const int sc = j >> 4;
                const float v = ((imph[(0 * 64 + qq) * 32 + j] * fsc[(0 * 64 + qq) * 2 + sc] + imph[(1 * 64 + qq) * 32 + j] * fsc[(1 * 64 + qq) * 2 + sc]) + imph[(2 * 64 + qq) * 32 + j] * fsc[(2 * 64 + qq) * 2 + sc]) + imph[(3 * 64 + qq) * 32 + j] * fsc[(3 * 64 + qq) * 2 + sc];
                const bool forced = (j == 0) || (j == qb) || (j + 1 == qb);
                imps[qq * 32 + j] = forced ? __builtin_inff() : (j <= qb ? v : -__builtin_inff()); }
            __syncthreads();
            unsigned bits = 0u;
#pragma unroll
            for (int u = 0; u < 4; ++u) { const int j = 4 * part + u; const float sj = imps[qq * 32 + j]; int rank = 0;
#pragma unroll 8
                for (int k = 0; k < 32; ++k) { const float o = imps[qq * 32 + k]; rank += (o > sj || (o == sj && k < j)) ? 1 : 0; }
                if (rank < 16 && j <= qb) bits |= 1u << j; }
            if (bits) __hip_atomic_fetch_or(selw + qq, bits, __ATOMIC_RELAXED, __HIP_MEMORY_SCOPE_WORKGROUP);
            __syncthreads();
            mymask = selw[32 * qh + l32];
        }
        unsigned anym = mymask;
        if (qb >= 16) { LAS unsigned* selw = (LAS unsigned*)(F.lds + AL_SEL); anym = 0u;
#pragma unroll 8
            for (int k = 0; k < 64; ++k) anym |= selw[k]; }
        anym = __builtin_amdgcn_readfirstlane(anym);
        { int t2 = F.tid; asm volatile("" : "+v"(t2)); tidl = t2; l32 = t2 & 31; hi = (t2 >> 5) & 1; }
        load_q(qf, (const bf16*)WSF(WS_PROJ) + (size_t)m * NPROJ + C_Q + head * 128, hi);
        rope_q(qf, (const float*)WSF(WS_MISC + MS_ROPEC) + (size_t)m * 16, (const float*)WSF(WS_MISC + MS_ROPES) + (size_t)m * 16, hi);
#pragma unroll
        for (int db = 0; db < 4; ++db)
#pragma unroll
            for (int r = 0; r < 16; ++r) st.o[db][r] = 0.f;
        st.m = -1e30f; st.l = 0.f;
        const bf16* kg = (const bf16*)WSF(WS_KSR) + (size_t)(b * 2 + g) * S * 128; const bf16* vg = (const bf16*)WSF(WS_VST) + (size_t)(b * 2 + g) * 128 * S;
        __syncthreads();
        TileRegs tr; int buf = 0;
        int j = 0;
        tile_load(tr, kg, vg, tidl); tile_store(tr, F.lds + AL_K0, F.lds + AL_V0, tidl);
        __syncthreads();
        while (j <= qb) {
            int jn = j + 1; while (jn <= qb && !((anym >> jn) & 1u)) ++jn;
            if (jn <= qb) tile_load(tr, kg + (size_t)jn * 64 * 128, vg + 64 * jn, tidl);
            const bool selj = (mymask >> j) & 1u; const int sl = 32 * qh + l32;
            const bool nm = (j == qb) || !__all(selj);
            attn_tile<AT_VS>(st, qf, F.lds + (buf ? AL_K1 : AL_K0), F.lds + (buf ? AL_V1 : AL_V0), l32, hi, nm, [&](int kl) { return selj && (j < qb || kl <= sl); }, NoHook());
            if (jn <= qb) tile_store(tr, F.lds + (buf ? AL_K0 : AL_K1), F.lds + (buf ? AL_V0 : AL_V1), tidl);
            __syncthreads();
            buf ^= 1; j = jn;
        }
        const float il = g1 / st.l;
        asm volatile("s_waitcnt vmcnt(0)" ::: "memory");
        float* op = (float*)WSF(WS_OACC) + (size_t)m * 1024 + head * 128 + 4 * hi;
#pragma unroll
        for (int db = 0; db < 4; ++db)
#pragma unroll
            for (int q = 0; q < 4; ++q) { const f32x4 base = *(const f32x4*)(op + 32 * db + 8 * q);
                *(f32x4*)(op + 32 * db + 8 * q) = (f32x4){base.x + il * st.o[db][4 * q], base.y + il * st.o[db][4 * q + 1], base.z + il * st.o[db][4 * q + 2], base.w + il * st.o[db][4 * q + 3]}; }
    }
    __syncthreads();
}

__device__ __forceinline__ void attn_win(KA a, Frame& F) {
    const bf16* proj = (const bf16*)(a->ws + WS_PROJ); const float* oacc = (const float*)(a->ws + WS_OACC); bf16* omix = (bf16*)(a->ws + WS_OMIX);
    const bf16* kwr = (const bf16*)(a->ws + WS_KWR); const bf16* vwt = (const bf16*)(a->ws + WS_VWT);
    const float* rc = (const float*)(a->ws + WS_MISC + MS_ROPEC); const float* rs = (const float*)(a->ws + WS_MISC + MS_ROPES);
    const int hh = F.wave >> 1, qh = F.wave & 1;
    for (int item = F.vb; item < NB * 2 * 32; item += F.G) {
        int tidl = F.tid; asm volatile("" : "+v"(tidl)); const int l32 = tidl & 31, hi = (tidl >> 5) & 1;
        const int qb = item >> 3, g = item & 1, b = (item >> 1) & 3, head = g * 4 + hh;
        const int sl = 32 * qh + l32, sq = 64 * qb + sl, m = b * S + sq;
        bf16x8 qf[8];
        load_q(qf, proj + (size_t)m * NPROJ + C_Q + head * 128, hi);
        rope_q(qf, rc + (size_t)m * 16, rs + (size_t)m * 16, hi);
        AttnState st;
#pragma unroll
        for (int db = 0; db < 4; ++db)
#pragma unroll
            for (int r = 0; r < 16; ++r) st.o[db][r] = 0.f;
        st.m = -1e30f; st.l = 0.f;
        const bf16* kg = kwr + (size_t)(b * 2 + g) * S * 128; const bf16* vg = vwt + (size_t)(b * 2 + g) * 128 * S;
        const int j0 = qb >= 8 ? qb - 8 : 0;
        TileRegs tr; int buf = 0;
        __syncthreads();
        tile_load(tr, kg + (size_t)j0 * 64 * 128, vg + 64 * j0, tidl); tile_store(tr, F.lds + AL_K0, F.lds + AL_V0, tidl);
        __syncthreads();
        for (int j = j0; j <= qb; ++j) {
            if (j < qb) tile_load(tr, kg + (size_t)(j + 1) * 64 * 128, vg + 64 * (j + 1), tidl);
            const int rel = 64 * (qb - j) + sl;
            const bool nm = (j == qb) || (j + 8 <= qb);
            attn_tile<AT_VS>(st, qf, F.lds + (buf ? AL_K1 : AL_K0), F.lds + (buf ? AL_V1 : AL_V0), l32, hi, nm, [&](int kl) { return (unsigned)(rel - kl) < 512u; }, NoHook());
            if (j < qb) tile_store(tr, F.lds + (buf ? AL_K0 : AL_K1), F.lds + (buf ? AL_V0 : AL_V1), tidl);
            __syncthreads();
            buf ^= 1;
        }
        const float g2 = sigmoidf_(bf2f(proj[(size_t)m * NPROJ + C_GL + head * 3 + 2]));
        const float il = g2 / st.l;
        const float* ip = oacc + (size_t)m * 1024 + head * 128 + 4 * hi; bf16* op = omix + (size_t)m * D + head * 128 + 4 * hi;
#pragma unroll
        for (int db = 0; db < 4; ++db)
#pragma unroll
            for (int q = 0; q < 4; ++q) { const f32x4 base = *(const f32x4*)(ip + 32 * db + 8 * q);
                *(v2u*)(op + 32 * db + 8 * q) = (v2u){cvtpk(base.x + il * st.o[db][4 * q], base.y + il * st.o[db][4 * q + 1]), cvtpk(base.z + il * st.o[db][4 * q + 2], base.w + il * st.o[db][4 * q + 3])}; }
    }
    __syncthreads();
}

#define MFMA16(a, b, c) __builtin_amdgcn_mfma_f32_16x16x32_bf16((a), (b), (c), 0, 0, 0)
constexpr int CM_HS = 528;
__device__ __forceinline__ void cmp_mlp(KA a, Frame& F, int l) {
    for (int item = F.vb; item < 128; item += F.G) {
        int tidl = F.tid; asm volatile("" : "+v"(tidl));
        const int r = tidl & 15, quad = (tidl >> 4) & 3, w = F.wave;
        const int nt = item & 7, g = (item >> 3) & 1, b = (item >> 4) & 3, kv = item >> 6, lk = l * 2 + kv;
        const bf16* arow = (const bf16*)(a->ws + WS_PROJ) + (size_t)(b * S + 16 * (16 * nt + r)) * NPROJ + (kv ? C_VC : C_KC) + g * 128 + 8 * quad;
        const bf16* w1a = (const bf16*)(a->ws + WS_W1T) + ((size_t)lk * 256 + 32 * w + r) * 4096 + 8 * quad;
        const bf16* w1b = w1a + 16 * 4096;
        f32x4 acc0 = (f32x4){0.f, 0.f, 0.f, 0.f}, acc1 = acc0;
#pragma unroll 8
        for (int ks = 0; ks < 128; ++ks) {
            const bf16x8 af = *(const bf16x8*)(arow + (size_t)(ks >> 2) * NPROJ + 32 * (ks & 3));
            const bf16x8 b0 = *(const bf16x8*)(w1a + 32 * ks), b1 = *(const bf16x8*)(w1b + 32 * ks);
            acc0 = MFMA16(af, b0, acc0); acc1 = MFMA16(af, b1, acc1);
        }
        const float* bp = (const float*)(a->ws + WS_B1P) + lk * 256 + 32 * w + r;
        float bias0 = 0.f, bias1 = 0.f;
#pragma unroll 1
        for (int kc = 0; kc < 16; ++kc) { bias0 += bp[kc * 4 * 256]; bias1 += bp[kc * 4 * 256 + 16]; }
        __syncthreads();
#pragma unroll
        for (int i = 0; i < 4; ++i) {
            *(LAS bf16*)(F.lds + (4 * quad + i) * CM_HS + 2 * (32 * w + r)) = (bf16)(cvtpk(gelu_tanh(acc0[i] + bias0), 0.f) & 0xffffu);
            *(LAS bf16*)(F.lds + (4 * quad + i) * CM_HS + 2 * (32 * w + 16 + r)) = (bf16)(cvtpk(gelu_tanh(acc1[i] + bias1), 0.f) & 0xffffu); }
        __syncthreads();
        const bf16* w2r = (const bf16*)(a->ws + WS_W2T) + ((size_t)lk * 128 + 16 * w + r) * 256 + 8 * quad;
        f32x4 acc2 = (f32x4){0.f, 0.f, 0.f, 0.f};
#pragma unroll
        for (int ks = 0; ks < 8; ++ks) { const bf16x8 af = *(const LAS bf16x8*)(F.lds + r * CM_HS + 2 * (32 * ks + 8 * quad)); const bf16x8 bfr = *(const bf16x8*)(w2r + 32 * ks); acc2 = MFMA16(af, bfr, acc2); }
        const int j = 16 * w + r; const float b2 = ((const float*)a->in[kv ? I_CVB2 : I_CKB2])[l * 128 + j];
        float o[4];
#pragma unroll
        for (int i = 0; i < 4; ++i) { const int n = 16 * nt + 4 * quad + i; o[i] = (n == NCMP) ? 0.f : acc2[i] + b2; }
        if (kv == 0) { bf16* kc = (bf16*)(a->ws + WS_KCB) + ((size_t)(b * 2 + g) * 128 + 16 * nt + 4 * quad) * 128 + j;
#pragma unroll
            for (int i = 0; i < 4; ++i) kc[(size_t)i * 128] = (bf16)(cvtpk(o[i], 0.f) & 0xffffu); }
        else { const int pos = (quad == 1) ? 8 : (quad == 2 ? 4 : 4 * quad);
            *(v2u*)((bf16*)(a->ws + WS_VCT) + ((size_t)(b * 2 + g) * 128 + j) * 128 + 16 * nt + pos) = (v2u){cvtpk(o[0], o[1]), cvtpk(o[2], o[3])}; }
    }
    __syncthreads();
}

constexpr int TK_RS = 129;
constexpr int TL_SC = 0, TL_LIST = 2 * 32 * TK_RS * 4, TL_END = TL_LIST + 8 * 512;
__device__ __forceinline__ unsigned fkey(float v) { const unsigned u = __float_as_uint(v); return (u & 0x80000000u) ? ~u : (u | 0x80000000u); }
__device__ __forceinline__ int lane_rank(unsigned long long m) { return (int)__builtin_amdgcn_mbcnt_hi((unsigned)(m >> 32), __builtin_amdgcn_mbcnt_lo((unsigned)m, 0u)); }
__device__ __forceinline__ void peer_topk2(KA a, Frame& F, int l) {
    const bf16* pq = (const bf16*)(a->ws + WS_PQ); int* eidx = (int*)(a->ws + WS_EIDX); float* egate = (float*)(a->ws + WS_EGATE);
    const bf16* pkb = (const bf16*)(a->ws + WS_PKB) + (size_t)l * 8 * 2 * 128 * 128;
    LAS float* sc = (LAS float*)(F.lds + TL_SC);
    LAS float* lv = (LAS float*)(F.lds + TL_LIST + F.wave * 512);
    LAS int* li = (LAS int*)(lv + 32); LAS float* fv = lv + 64; LAS int* fc = (LAS int*)(lv + 80);
    const int l32 = F.lane & 31, hi = F.lane >> 5, p = F.wave >> 2, kb = F.wave & 3;
    for (int item = F.vb; item < (T / 32) * 8; item += F.G) {
        const int h = item & 7, t0 = (item >> 3) * 32;
        { const bf16* kr = pkb + ((size_t)(h * 2 + p) * 128 + 32 * kb + l32) * 128 + 8 * hi; const bf16* qr = pq + (size_t)(t0 + l32) * D + h * 256 + p * 128 + 8 * hi;
          f32x16 c;
#pragma unroll
          for (int r = 0; r < 16; ++r) c[r] = 0.f;
#pragma unroll
          for (int ks = 0; ks < 8; ++ks) c = MFMA32(*(const bf16x8*)(kr + 16 * ks), *(const bf16x8*)(qr + 16 * ks), c);
          __syncthreads();
          LAS float* dst = sc + (p * 32 + l32) * TK_RS + 32 * kb + 4 * hi;
#pragma unroll
          for (int r = 0; r < 16; ++r) dst[(r & 3) + 8 * (r >> 2)] = c[r]; }
        __syncthreads();
        for (int tt = 0; tt < 4; ++tt) {
            const int tl = 4 * F.wave + tt;
#pragma unroll
            for (int pp = 0; pp < 2; ++pp) {
                const float v0 = sc[(pp * 32 + tl) * TK_RS + F.lane], v1 = sc[(pp * 32 + tl) * TK_RS + 64 + F.lane];
                const unsigned u0 = fkey(v0), u1 = fkey(v1);
                unsigned pre = 0u;
#pragma unroll 1
                for (int bit = 31; bit >= 0; --bit) { const unsigned cand = pre | (1u << bit);
                    const int cnt = __popcll(__ballot(u0 >= cand)) + __popcll(__ballot(u1 >= cand));
                    if (cnt >= 16) pre = cand; }
                const unsigned long long g0 = __ballot(u0 > pre), g1 = __ballot(u1 > pre), e0 = __ballot(u0 == pre), e1 = __ballot(u1 == pre);
                const int need = 16 - (__popcll(g0) + __popcll(g1));
                const bool s0 = (u0 > pre) || (u0 == pre && lane_rank(e0) < need);
                const bool s1 = (u1 > pre) || (u1 == pre && __popcll(e0) + lane_rank(e1) < need);
                const unsigned long long m0 = __ballot(s0), m1 = __ballot(s1);
                if (s0) { const int pos = lane_rank(m0); lv[pp * 16 + pos] = v0; li[pp * 16 + pos] = F.lane; }
                if (s1) { const int pos = __popcll(m0) + lane_rank(m1); lv[pp * 16 + pos] = v1; li[pp * 16 + pos] = F.lane + 64; }
            }
            asm volatile("s_waitcnt lgkmcnt(0)" ::: "memory");
            float cv[4]; unsigned cu[4]; const float s2 = lv[16 + (F.lane & 15)];
#pragma unroll
            for (int r = 0; r < 4; ++r) { cv[r] = lv[(F.lane >> 4) + 4 * r] + s2; cu[r] = fkey(cv[r]); }
            unsigned pre = 0u;
#pragma unroll 1
            for (int bit = 31; bit >= 0; --bit) { const unsigned cand = pre | (1u << bit);
                const int cnt = (__popcll(__ballot(cu[0] >= cand)) + __popcll(__ballot(cu[1] >= cand))) + (__popcll(__ballot(cu[2] >= cand)) + __popcll(__ballot(cu[3] >= cand)));
                if (cnt >= 16) pre = cand; }
            int ngt = 0;
#pragma unroll
            for (int r = 0; r < 4; ++r) ngt += __popcll(__ballot(cu[r] > pre));
            const int need = 16 - ngt; int eqb = 0, selb = 0;
#pragma unroll
            for (int r = 0; r < 4; ++r) {
                const unsigned long long er = __ballot(cu[r] == pre);
                const bool sr = (cu[r] > pre) || (cu[r] == pre && eqb + lane_rank(er) < need);
                eqb += __popcll(er);
                const unsigned long long mr = __ballot(sr);
                if (sr) { const int pos = selb + lane_rank(mr); fv[pos] = cv[r]; fc[pos] = F.lane + 64 * r; }
                selb += __popcll(mr);
            }
            asm volatile("s_waitcnt lgkmcnt(0)" ::: "memory");
            const int kk = F.lane & 15; const float bs = fv[kk]; const int bc = fc[kk];
            float mx = bs;
#pragma unroll
            for (int o = 1; o < 16; o <<= 1) mx = fmaxf(mx, __shfl_xor(mx, o));
            const float e = __expf(bs - mx); float sum = e;
#pragma unroll
            for (int o = 1; o < 16; o <<= 1) sum += __shfl_xor(sum, o);
            if (F.lane < 16) { const size_t o = (size_t)(t0 + tl) * 128 + h * 16 + F.lane; eidx[o] = li[bc >> 4] * 128 + li[16 + (bc & 15)]; egate[o] = e / sum; }
            asm volatile("s_waitcnt lgkmcnt(0)" ::: "memory");
        }
    }
    __syncthreads();
}

#ifdef SKIP0
#define SK0(...)
#else
#define SK0(...) __VA_ARGS__
#endif
#ifdef SKIP1
#define SK1(...)
#else
#define SK1(...) __VA_ARGS__
#endif
#ifdef SKIP2
#define SK2(...)
#else
#define SK2(...) __VA_ARGS__
#endif
#ifdef SKIP3
#define SK3(...)
#else
#define SK3(...) __VA_ARGS__
#endif
#ifdef SKIP4
#define SK4(...)
#else
#define SK4(...) __VA_ARGS__
#endif
#ifdef SKIP5
#define SK5(...)
#else
#define SK5(...) __VA_ARGS__
#endif
#ifdef SKIP6
#define SK6(...)
#else
#define SK6(...) __VA_ARGS__
#endif

constexpr int NKIND = 12;
#define FRESH() ({ KA _p = (KA)__builtin_amdgcn_kernarg_segment_ptr(); asm volatile("" : "+s"(_p)); _p; })
template <int KIND>
__device__ __forceinline__ void run_phase(Frame& F, unsigned char* ws, const int l) {
    float* mod = (float*)(ws + WS_MOD);
    bf16* Hb = (bf16*)(ws + WS_H); bf16* proj = (bf16*)(ws + WS_PROJ); bf16* omix = (bf16*)(ws + WS_OMIX); bf16* pq = (bf16*)(ws + WS_PQ);
    float* XA = (float*)(ws + WS_XA); float* XB = (float*)(ws + WS_XB);
    const float* mod_l = mod + (size_t)l * 4 * 12288;
    if constexpr (KIND == 0) { SK0(p0_prologue(FRESH(), F);) }
    if constexpr (KIND == 1) { if (l == 0) norm_phase<true>(F, ws, (const float*)FRESH()->in[I_X], (const float*)FRESH()->in[I_NMIX], 0, 0, 2048, Hb); else norm_phase<false>(F, ws, XB, (const float*)FRESH()->in[I_NMIX] + l * D, l, 0, 2048, Hb); }
    if constexpr (KIND == 2) {
        pg8::Gemm g{Hb, (const bf16*)(ws + WS_WINT) + (size_t)l * NPROJ * D, T, NPROJ, D}; pg8::StaticOrder So; So.init(T, NPROJ, F.G, (int)blockIdx.x);
        pg8::EpiStoreBf16 E{proj, NPROJ};
        pg8::gemm_phase<pg8::EpiStoreBf16, pg8::StaticOrder, PG8_ALIGN, PG8_SP2>(F.lds, g, So, E);
    }
    if constexpr (KIND == 3) { SK3(attn_prep(FRESH(), F);) SK1(cmp_mlp(FRESH(), F, l);) SK2(hgrn_local(FRESH(), F, l);) }
    if constexpr (KIND == 4) { }
    if constexpr (KIND == 5) { SK2(hgrn_scan(FRESH(), F);) SK3(attn_cmp_sel(FRESH(), F);) }
    if constexpr (KIND == 6) { SK4(attn_win(FRESH(), F);) SK2(hgrn_out(FRESH(), F, l);) }
    if constexpr (KIND == 7) {
        pg8::Gemm g{omix, (const bf16*)(ws + WS_WOUTT) + (size_t)l * D * D, T, D, D}; pg8::StaticOrder So; So.init(T, D, F.G, (int)blockIdx.x);
        pg8::EpiResGate E{(l == 0) ? (const float*)FRESH()->in[I_X] : XB, XA, D, mod_l + 2 * 2048, 12288, S};
        pg8::gemm_phase<pg8::EpiResGate, pg8::StaticOrder, PG8_ALIGN, PG8_SP2>(F.lds, g, So, E);
    }
    if constexpr (KIND == 8) norm_phase<false>(F, ws, XA, (const float*)FRESH()->in[I_NFFN] + l * D, l, 3 * 2048, 4 * 2048, Hb);
    if constexpr (KIND == 9) {
        pg8::Gemm g{Hb, (const bf16*)(ws + WS_WQT) + (size_t)l * D * D, T, D, D}; pg8::StaticOrder So; So.init(T, D, F.G, (int)blockIdx.x);
        pg8::EpiStoreBf16 E{pq, D};
        pg8::gemm_phase<pg8::EpiStoreBf16, pg8::StaticOrder, PG8_ALIGN, PG8_SP2>(F.lds, g, So, E);
    }
    if constexpr (KIND == 10) { SK5(peer_topk2(FRESH(), F, l);) }
    if constexpr (KIND == 11) {
        SK6(if (l == DEPTH - 1) peer_gather<true>(FRESH(), F, l, XA, FRESH()->out, mod_l + 5 * 2048);
        else peer_gather<false>(FRESH(), F, l, XA, XB, mod_l + 5 * 2048);)
    }
}
__device__ __forceinline__ void frame_init(Frame& F, unsigned char* lds_raw) {
    F.lds = (LAS unsigned char*)lds_raw;
    { int t_ = threadIdx.x; asm volatile("" : "+v"(t_)); F.tid = t_; } F.lane = F.tid & 63; F.wave = __builtin_amdgcn_readfirstlane(F.tid >> 6);
    { int gx = gridDim.x, bx = blockIdx.x; asm volatile("" : "+s"(gx), "+s"(bx));
      F.G = gx; F.vb = (gx % 8 == 0) ? (bx % 8) * (gx / 8) + bx / 8 : bx; }
}
#if !MK_ONE_LAUNCH
template <int KIND>
__global__ void __launch_bounds__(512, 2) k_phase(Args a) {
    extern __shared__ __attribute__((aligned(16))) unsigned char lds_raw[];
    Frame F; frame_init(F, lds_raw);
    run_phase<KIND>(F, a.ws, a.layer);
}
#else
extern __shared__ __attribute__((aligned(16))) unsigned char lds_dyn[];
__device__ __noinline__ void grid_sync(unsigned* barw, unsigned x) {
    XcdBarrier b; b.bar = barw; b.x = x; b.st = (volatile LAS unsigned*)((LAS unsigned char*)lds_dyn + MISC_OFF) + 8;
    xcd_barrier(b);
}
template <int KIND>
__device__ __forceinline__ void phase_fn(unsigned char* ws, int l) {
    asm volatile("" : "+s"(ws));
    Frame F; frame_init(F, lds_dyn);
    run_phase<KIND>(F, ws, l);
#ifdef PROBE_REP_KIND
    if constexpr (KIND == PROBE_REP_KIND) { __syncthreads(); run_phase<KIND>(F, ws, l); }
#endif
}
__global__ void __launch_bounds__(512, 2) trunk_fwd(Args a) {
    LAS unsigned char* lds = (LAS unsigned char*)lds_dyn;
    volatile LAS unsigned* MISC = (volatile LAS unsigned*)(lds + MISC_OFF);
    if (threadIdx.x < 32) MISC[threadIdx.x] = 0u;
    __syncthreads();
    unsigned char* ws = a.ws;
    XcdBarrier bar = xcd_barrier_post((unsigned*)(ws + WS_CTL) + CW_BAR, MISC + 8);
    phase_fn<0>(ws, 0); grid_sync(bar.bar, bar.x);
#pragma unroll
    for (int l = 0; l < DEPTH; ++l) {
        phase_fn<1>(ws, l); grid_sync(bar.bar, bar.x);
        phase_fn<2>(ws, l); grid_sync(bar.bar, bar.x);
        phase_fn<3>(ws, l); grid_sync(bar.bar, bar.x);
        phase_fn<5>(ws, l); grid_sync(bar.bar, bar.x);
        phase_fn<6>(ws, l); grid_sync(bar.bar, bar.x);
        phase_fn<7>(ws, l); grid_sync(bar.bar, bar.x);
        phase_fn<8>(ws, l); grid_sync(bar.bar, bar.x);
        phase_fn<9>(ws, l); grid_sync(bar.bar, bar.x);
        phase_fn<10>(ws, l); grid_sync(bar.bar, bar.x);
        phase_fn<11>(ws, l); if (l + 1 < DEPTH) grid_sync(bar.bar, bar.x);
    }
}
#endif

template <class KF> static bool prep_kernel(KF kf) {
    if (hipFuncSetAttribute((const void*)kf, hipFuncAttributeMaxDynamicSharedMemorySize, LDS_BYTES) != hipSuccess) { fprintf(stderr, "kernel_launch: hipFuncSetAttribute failed\n"); return false; }
    return true;
}
extern "C" void kernel_launch(void* const* d_in, const int* in_sizes, int n_in, void* d_out, int out_size, void* d_ws, size_t ws_size, hipStream_t stream) {
    static int grid = 0;
    if (grid == 0) {
        if (n_in != 26 || out_size != T * D || ws_size < WS_END) { fprintf(stderr, "kernel_launch: unexpected problem (n_in %d, out %d, ws %zu, need %zu)\n", n_in, out_size, ws_size, (size_t)WS_END); grid = -1; return; }
        int dev = 0, cus = 0;
        if (hipGetDevice(&dev) != hipSuccess || hipDeviceGetAttribute(&cus, hipDeviceAttributeMultiprocessorCount, dev) != hipSuccess) { grid = -1; return; }
        bool ok = true;
#if MK_ONE_LAUNCH
        ok = prep_kernel(trunk_fwd);
        int per_cu = 0;
        if (hipOccupancyMaxActiveBlocksPerMultiprocessor(&per_cu, (const void*)trunk_fwd, 512, LDS_BYTES) != hipSuccess || per_cu < 1) { fprintf(stderr, "kernel_launch: occupancy query says %d\n", per_cu); }
#else
        ok = prep_kernel(k_phase<0>) && prep_kernel(k_phase<1>) && prep_kernel(k_phase<2>) && prep_kernel(k_phase<3>) && prep_kernel(k_phase<4>) && prep_kernel(k_phase<5>) && prep_kernel(k_phase<6>)
          && prep_kernel(k_phase<7>) && prep_kernel(k_phase<8>) && prep_kernel(k_phase<9>) && prep_kernel(k_phase<10>) && prep_kernel(k_phase<11>);
#endif
        (void)hipGetLastError();
        if (!ok) { grid = -1; return; }
        grid = cus;
    }
    if (grid < 0) return;
    (void)hipMemsetAsync((char*)d_ws + WS_CTL, 0, CTL_ZERO_BYTES, stream);
    Args a{};
    for (int i = 0; i < 26; ++i) a.in[i] = d_in[i];
    a.out = (float*)d_out; a.ws = (unsigned char*)d_ws; a.layer = 0; a.pad = 0;
#if MK_ONE_LAUNCH
    hipLaunchKernelGGL(trunk_fwd, dim3(grid), dim3(512), LDS_BYTES, stream, a);
#else
    hipLaunchKernelGGL(k_phase<0>, dim3(grid), dim3(512), LDS_BYTES, stream, a);
    for (int l = 0; l < DEPTH; ++l) { a.layer = l;
        hipLaunchKernelGGL(k_phase<1>, dim3(grid), dim3(512), LDS_BYTES, stream, a);
        hipLaunchKernelGGL(k_phase<2>, dim3(grid), dim3(512), LDS_BYTES, stream, a);
        hipLaunchKernelGGL(k_phase<3>, dim3(grid), dim3(512), LDS_BYTES, stream, a);
        hipLaunchKernelGGL(k_phase<5>, dim3(grid), dim3(512), LDS_BYTES, stream, a);
        hipLaunchKernelGGL(k_phase<6>, dim3(grid), dim3(512), LDS_BYTES, stream, a);
        hipLaunchKernelGGL(k_phase<7>, dim3(grid), dim3(512), LDS_BYTES, stream, a);
        hipLaunchKernelGGL(k_phase<8>, dim3(grid), dim3(512), LDS_BYTES, stream, a);
        hipLaunchKernelGGL(k_phase<9>, dim3(grid), dim3(512), LDS_BYTES, stream, a);
        hipLaunchKernelGGL(k_phase<10>, dim3(grid), dim3(512), LDS_BYTES, stream, a);
        hipLaunchKernelGGL(k_phase<11>, dim3(grid), dim3(512), LDS_BYTES, stream, a);
    }
#endif
}
```

```cpp
#include <hip/hip_runtime.h>
#include <cstdio>
#include <cstdint>
#ifndef MK_ONE_LAUNCH
#define MK_ONE_LAUNCH 1
#endif
namespace pg8 {
#define PG8_LAS __attribute__((address_space(3)))
typedef unsigned short bf16_t;
typedef short bf16x8 __attribute__((ext_vector_type(8)));
typedef float f32x4 __attribute__((ext_vector_type(4)));
typedef unsigned u32x4 __attribute__((ext_vector_type(4)));
constexpr int BM = 256, BK = 64, HALF = 128, HTB = HALF * BK * 2  , STAGE_BYTES = 8 * HTB, NXCD = 8, WGM = 8;

__host__ __device__ __forceinline__ int lds_byte(int r, int c) { const int st = (r >> 4) * 2 + (c >> 5), rr = r & 15, cc = c & 31, ob = rr * 64 + cc * 2; return st * 1024 + (ob ^ (((ob >> 9) & 1) << 5)); }
__host__ __device__ __forceinline__ void stage_rc(int b, int& R, int& C) { const int st = b / 1024, sb = b % 1024, swz = sb ^ (((sb >> 9) & 1) << 5); R = (st >> 1) * 16 + swz / 64; C = (st & 1) * 32 + (swz % 64) / 2; }
__host__ __device__ __forceinline__ int perm32(int rho) { const int n = rho >> 4, i = rho & 15; return 8 * (i >> 2) + 4 * n + (i & 3); }

struct Unit { int pm, pn; };
struct Gemm { const bf16_t* A; const bf16_t* Bt; int M, N, K; };

struct StaticOrder {
    int nM, nN, nwg, G, c;
    __host__ __device__ void init(int M, int N, int G_, int c_) { nM = M / BM; nN = N / BM; nwg = nM * nN; G = G_; c = c_; }
    __host__ __device__ bool next(int i, Unit& u) const {
        const long L = (long)i * G + c; if (L >= nwg) return false;
        int wgid = (int)L; { const int q = nwg / NXCD, r = nwg % NXCD, xcd = wgid % NXCD, off = wgid / NXCD; wgid = (xcd < r ? xcd * (q + 1) : r * (q + 1) + (xcd - r) * q) + off; }
        const int nig = WGM * nN, gid = wgid / nig, fm = gid * WGM, gsz = (nM - fm) < WGM ? (nM - fm) : WGM;
        u.pm = fm + ((wgid % nig) % gsz); u.pn = (wgid % nig) / gsz; return true;
    }
    __device__ __forceinline__ void a_ready(const Unit&) const {}
    __device__ __forceinline__ void done(const Unit&) const {}
};

__device__ __forceinline__ unsigned cvt_pk_bf16(float lo, float hi) { unsigned r; asm volatile("v_cvt_pk_bf16_f32 %0, %1, %2" : "=v"(r) : "v"(lo), "v"(hi)); return r; }
typedef float f32x2 __attribute__((ext_vector_type(2)));
struct EpiStoreBf16 {
    static constexpr bool PERM = true, AFTER_DRAIN = false;
    bf16_t* O; int ldc;
    __device__ __forceinline__ void operator()(const f32x4 (&acc)[2][2][4][2], const Unit& u, int wr, int wc, int fr, int fq) const {
        const int row0 = u.pm * BM + wr * 64 + fr, col0 = u.pn * BM + wc * 32 + 8 * fq;
#pragma unroll
        for (int ai = 0; ai < 2; ++ai)
#pragma unroll
            for (int m = 0; m < 4; ++m) { bf16_t* rowp = O + (size_t)(row0 + ai * HALF + m * 16) * ldc + col0;
#pragma unroll
                for (int bj = 0; bj < 2; ++bj) { const f32x4 v0 = acc[ai][bj][m][0], v1 = acc[ai][bj][m][1];
                    u32x4 w; w.x = cvt_pk_bf16(v0[0], v0[1]); w.y = cvt_pk_bf16(v0[2], v0[3]); w.z = cvt_pk_bf16(v1[0], v1[1]); w.w = cvt_pk_bf16(v1[2], v1[3]);
                    *(u32x4*)(rowp + bj * HALF) = w; } }
    }
};
struct EpiResGate {
    static constexpr bool PERM = false, AFTER_DRAIN = false;
    const float* base; float* out; int ldc; const float* gate; int gate_stride; int rows_per_b;
    __device__ __forceinline__ void operator()(const f32x4 (&acc)[2][2][4][2], const Unit& u, int wr, int wc, int fr, int fq) const {
        const int row0 = u.pm * BM + wr * 64 + fr, col0 = u.pn * BM + wc * 32 + 4 * fq;
        const float* gp = gate + (size_t)((u.pm * BM) / rows_per_b) * gate_stride + col0;
        f32x4 gv[2][2];
#pragma unroll
        for (int bj = 0; bj < 2; ++bj)
#pragma unroll
            for (int n = 0; n < 2; ++n) gv[bj][n] = *(const f32x4*)(gp + bj * HALF + n * 16);
#pragma unroll
        for (int ai = 0; ai < 2; ++ai)
#pragma unroll
            for (int m = 0; m < 4; ++m) { const size_t off = (size_t)(row0 + ai * HALF + m * 16) * ldc + col0;
#pragma unroll
                for (int bj = 0; bj < 2; ++bj)
#pragma unroll
                    for (int n = 0; n < 2; ++n) { const f32x4 x = *(const f32x4*)(base + off + bj * HALF + n * 16);

#ifdef EXP_NO_MIX
                        *(f32x4*)(out + off + bj * HALF + n * 16) = x; } }
#else
                        *(f32x4*)(out + off + bj * HALF + n * 16) = x + gv[bj][n] * acc[ai][bj][m][n]; } }
#endif
    }
};

template <class Epi, class Sched, bool ALIGN_EPI = false, bool SP2 = false>
__device__ __forceinline__ void gemm_phase(PG8_LAS unsigned char* lds, const Gemm g, const Sched& S, const Epi& E) {
    int tid_l = threadIdx.x; asm volatile("" : "+v"(tid_l));
    const int tid = tid_l, wid = __builtin_amdgcn_readfirstlane(tid >> 6), lane = tid & 63, wr = wid >> 2, wc = wid & 3, fr = lane & 15, fq = lane >> 4;
    const int K = g.K, nt = K / BK;
    unsigned voffA[2], voffB[2];
#pragma unroll
    for (int i = 0; i < 2; ++i) { int R, C; stage_rc(tid * 16 + i * 8192, R, C); const int Rb = Epi::PERM ? ((R & ~31) + perm32(R & 31)) : R;
        voffA[i] = (unsigned)(R * K + C) * 2u; voffB[i] = (unsigned)(Rb * K + C) * 2u; }
    const size_t kstep = (size_t)(BK * 2);
    const size_t hstep = (size_t)HALF * K * 2;
    const size_t tstep = 2 * hstep;
    const unsigned ldsw = (unsigned)wid * 1024u;
    const int aoff = lds_byte(wr * 64 + fr, fq * 8), boff = lds_byte(wc * 32 + fr, fq * 8);
#define PG8_SA(b, h) (((b) * 2 + (h)) * HTB)
#define PG8_SB(b, h) ((4 + (b) * 2 + (h)) * HTB)
#define PG8_STAGE(bufoff, gbase, voff) do { _Pragma("unroll") for (int _i = 0; _i < 2; ++_i) \
        __builtin_amdgcn_global_load_lds((const unsigned*)((const char*)(gbase) + (voff)[_i]), (PG8_LAS unsigned*)(lds + (bufoff) + ldsw + _i * 8192), 16, 0, 0); } while (0)
#define PG8_LDA(dst, b, h) do { _Pragma("unroll") for (int m = 0; m < 4; ++m) _Pragma("unroll") for (int k = 0; k < 2; ++k) dst[m][k] = *(const PG8_LAS bf16x8*)(lds + PG8_SA(b, h) + aoff + m * 2048 + k * 1024); } while (0)
#define PG8_LDB(dst, b, h) do { _Pragma("unroll") for (int n = 0; n < 2; ++n) _Pragma("unroll") for (int k = 0; k < 2; ++k) dst[n][k] = *(const PG8_LAS bf16x8*)(lds + PG8_SB(b, h) + boff + n * 2048 + k * 1024); } while (0)
#define PG8_MMA(ai, bj, At, Bt) do { __builtin_amdgcn_s_setprio(1); _Pragma("unroll") for (int m = 0; m < 4; ++m) _Pragma("unroll") for (int n = 0; n < 2; ++n) _Pragma("unroll") for (int k = 0; k < 2; ++k) \
        acc[ai][bj][m][n] = __builtin_amdgcn_mfma_f32_16x16x32_bf16(Bt[n][k], At[m][k], acc[ai][bj][m][n], 0, 0, 0); __builtin_amdgcn_s_setprio(0); } while (0)
#define PG8_WAIT_V(n) asm volatile("s_waitcnt vmcnt(" #n ")" ::: "memory")
#define PG8_WAIT_L(n) asm volatile("s_waitcnt lgkmcnt(" #n ")" ::: "memory")
#define PG8_BAR __builtin_amdgcn_s_barrier()
#define PG8_SCHED __builtin_amdgcn_sched_barrier(0)
    Unit cur, nxt; int ui = 0;
    if (!S.next(0, cur)) return;
    f32x4 acc[2][2][4][2];
#pragma unroll
    for (int a = 0; a < 2; ++a)
#pragma unroll
        for (int b = 0; b < 2; ++b)
#pragma unroll
            for (int m = 0; m < 4; ++m)
#pragma unroll
                for (int n = 0; n < 2; ++n) acc[a][b][m][n] = (f32x4){0.f, 0.f, 0.f, 0.f};
    bf16x8 At[4][2], B0[2][2], B1[2][2];
    const char* cA = (const char*)g.A + (size_t)cur.pm * tstep; const char* cB = (const char*)g.Bt + (size_t)cur.pn * tstep;
    S.a_ready(cur);
    if constexpr (SP2) {
        PG8_STAGE(PG8_SB(0, 0), cB, voffB); PG8_STAGE(PG8_SB(0, 1), cB + hstep, voffB); PG8_STAGE(PG8_SA(0, 0), cA, voffA); PG8_STAGE(PG8_SA(0, 1), cA + hstep, voffA);
        if (wr == 1) PG8_BAR;
        PG8_WAIT_V(2); PG8_BAR;
        PG8_STAGE(PG8_SB(1, 0), cB + kstep, voffB); PG8_STAGE(PG8_SA(1, 0), cA + kstep, voffA); PG8_STAGE(PG8_SB(1, 1), cB + hstep + kstep, voffB);
        PG8_WAIT_V(6); PG8_BAR;
    } else {
        PG8_STAGE(PG8_SB(0, 0), cB, voffB); PG8_STAGE(PG8_SA(0, 0), cA, voffA); PG8_STAGE(PG8_SB(0, 1), cB + hstep, voffB); PG8_STAGE(PG8_SA(0, 1), cA + hstep, voffA);
        if (wr == 1) PG8_BAR;
        PG8_WAIT_V(4); PG8_BAR;
        PG8_STAGE(PG8_SB(1, 0), cB + kstep, voffB); PG8_STAGE(PG8_SA(1, 0), cA + kstep, voffA); PG8_STAGE(PG8_SB(1, 1), cB + hstep + kstep, voffB);
        PG8_WAIT_V(6); PG8_BAR;
    }
    for (;;) {
        const bool has_next = S.next(ui + 1, nxt);
        const char* nA = has_next ? (const char*)g.A + (size_t)nxt.pm * tstep : cA; const char* nB = has_next ? (const char*)g.Bt + (size_t)nxt.pn * tstep : cB;
        for (int t = 0; t < nt; t += 2) {
            const bool last = (t == nt - 2);
            const char* a1 = cA + (size_t)(t + 1) * kstep;
            const char* a2 = last ? nA : cA + (size_t)(t + 2) * kstep; const char* b2 = last ? nB : cB + (size_t)(t + 2) * kstep;
            const char* a3 = a2 + kstep; const char* b3 = b2 + kstep;
            if (last && has_next) S.a_ready(nxt);
            if constexpr (SP2) {
            PG8_LDB(B0, 0, 0); PG8_LDB(B1, 0, 1); PG8_SCHED; PG8_LDA(At, 0, 0); PG8_STAGE(PG8_SA(1, 1), a1 + hstep, voffA);
            PG8_WAIT_V(8); PG8_WAIT_L(0); PG8_BAR; PG8_MMA(0, 0, At, B0); PG8_MMA(0, 1, At, B1); PG8_BAR; PG8_SCHED;
            PG8_LDA(At, 0, 1); PG8_STAGE(PG8_SB(0, 0), b2, voffB); PG8_STAGE(PG8_SB(0, 1), b2 + hstep, voffB); PG8_STAGE(PG8_SA(0, 0), a2, voffA);
            PG8_WAIT_V(8); PG8_WAIT_L(0); PG8_BAR; PG8_MMA(1, 0, At, B0); PG8_MMA(1, 1, At, B1); PG8_BAR; PG8_SCHED;
            PG8_LDB(B0, 1, 0); PG8_LDB(B1, 1, 1); PG8_SCHED; PG8_LDA(At, 1, 0); PG8_STAGE(PG8_SA(0, 1), a2 + hstep, voffA);
            PG8_WAIT_V(8); PG8_WAIT_L(0); PG8_BAR; PG8_MMA(0, 0, At, B0); PG8_MMA(0, 1, At, B1); PG8_BAR; PG8_SCHED;
            PG8_LDA(At, 1, 1); PG8_STAGE(PG8_SB(1, 0), b3, voffB); PG8_STAGE(PG8_SB(1, 1), b3 + hstep, voffB); PG8_STAGE(PG8_SA(1, 0), a3, voffA);
            PG8_WAIT_V(8); PG8_WAIT_L(0); PG8_BAR; PG8_MMA(1, 0, At, B0); PG8_MMA(1, 1, At, B1); PG8_BAR; PG8_SCHED;
            } else {
            PG8_LDB(B0, 0, 0); PG8_SCHED; PG8_LDA(At, 0, 0); PG8_STAGE(PG8_SA(1, 1), a1 + hstep, voffA);
            PG8_WAIT_L(8); PG8_BAR; PG8_WAIT_L(0); PG8_MMA(0, 0, At, B0); PG8_BAR; PG8_SCHED;
            PG8_LDB(B1, 0, 1); PG8_STAGE(PG8_SB(0, 0), b2, voffB);
            PG8_BAR; PG8_WAIT_L(0); PG8_MMA(0, 1, At, B1); PG8_BAR;
            PG8_LDA(At, 0, 1); PG8_STAGE(PG8_SA(0, 0), a2, voffA);
            PG8_BAR; PG8_WAIT_L(0); PG8_MMA(1, 0, At, B0); PG8_BAR; PG8_SCHED;
            PG8_STAGE(PG8_SB(0, 1), b2 + hstep, voffB);
            PG8_WAIT_V(6); PG8_BAR; PG8_MMA(1, 1, At, B1); PG8_BAR;
            PG8_LDB(B0, 1, 0); PG8_SCHED; PG8_LDA(At, 1, 0); PG8_STAGE(PG8_SA(0, 1), a2 + hstep, voffA);
            PG8_WAIT_L(8); PG8_BAR; PG8_WAIT_L(0); PG8_MMA(0, 0, At, B0); PG8_BAR; PG8_SCHED;
            PG8_LDB(B1, 1, 1); PG8_STAGE(PG8_SB(1, 0), b3, voffB);
            PG8_BAR; PG8_WAIT_L(0); PG8_MMA(0, 1, At, B1); PG8_BAR;
            PG8_LDA(At, 1, 1); PG8_STAGE(PG8_SA(1, 0), a3, voffA);
            PG8_BAR; PG8_WAIT_L(0); PG8_MMA(1, 0, At, B0); PG8_BAR; PG8_SCHED;
            PG8_STAGE(PG8_SB(1, 1), b3 + hstep, voffB);
            PG8_WAIT_V(6); PG8_BAR; PG8_MMA(1, 1, At, B1); PG8_BAR;
            }
        }
        if constexpr (ALIGN_EPI) { if (wr == 0) PG8_BAR; }
        if constexpr (!Epi::AFTER_DRAIN) { E(acc, cur, wr, wc, fr, fq); S.done(cur); }
        if (!has_next) break;
#pragma unroll
        for (int a = 0; a < 2; ++a)
#pragma unroll
            for (int b = 0; b < 2; ++b)
#pragma unroll
                for (int m = 0; m < 4; ++m)
#pragma unroll
                    for (int n = 0; n < 2; ++n) acc[a][b][m][n] = (f32x4){0.f, 0.f, 0.f, 0.f};
        cur = nxt; cA = nA; cB = nB; ++ui;
        if constexpr (ALIGN_EPI) { if (wr == 1) PG8_BAR; }
    }
    PG8_WAIT_V(0);
    if constexpr (!ALIGN_EPI) { if (wr == 0) PG8_BAR; }
    PG8_BAR;
    if constexpr (Epi::AFTER_DRAIN) { E.fused(acc, cur, wr, wc, fr, fq, lds, wid, lane); S.done(cur); }
#undef PG8_SA
#undef PG8_SB
#undef PG8_STAGE
#undef PG8_LDA
#undef PG8_LDB
#undef PG8_MMA
#undef PG8_WAIT_V
#undef PG8_WAIT_L
#undef PG8_BAR
#undef PG8_SCHED
}
}

#ifndef PG8_SP2
#define PG8_SP2 true
#endif
#ifndef PG8_ALIGN
#define PG8_ALIGN true
#endif
#define GAS __attribute__((address_space(1)))
#define LAS __attribute__((address_space(3)))
typedef unsigned short bf16;
typedef unsigned v4u __attribute__((ext_vector_type(4)));
typedef unsigned v2u __attribute__((ext_vector_type(2)));
typedef float f32x4 __attribute__((ext_vector_type(4)));
typedef float f32x2 __attribute__((ext_vector_type(2)));
typedef short bf16x8 __attribute__((ext_vector_type(8)));
typedef __bf16 bf16x2_t __attribute__((ext_vector_type(2)));
typedef GAS unsigned gu32;

constexpr int NB = 4, S = 2048, D = 2048, T = NB * S, DEPTH = 2;
constexpr int INW = 6680, NPROJ = 6912;
constexpr int C_Q = 0, C_KC = 1024, C_VC = 1280, C_KS = 1536, C_VS = 1792, C_KW = 2048, C_VW = 2304, C_HQ = 2560, C_HF = 3584, C_HI = 4608, C_HG = 5632, C_GL = 6656;
constexpr int NCMP = 127;
constexpr float EPS = 1e-6f;
constexpr float ATT_SCALE = 0.08838834764831845f;
__host__ __device__ __forceinline__ int winmap(int n) { return n < 2560 ? n : (n < 2584 ? C_GL + (n - 2560) : n - 24); }

constexpr size_t MiB = 1u << 20;
constexpr size_t WS_CTL = 0, CTL_ZERO_BYTES = 2 * MiB;
constexpr size_t WS_MOD = 256 * 1024;
constexpr size_t WS_B1P = 1 * MiB;
constexpr size_t WS_WINT = 2 * MiB, WS_WOUTT = 56 * MiB, WS_WQT = 72 * MiB, WS_W1T = 88 * MiB, WS_PU = 96 * MiB, WS_PV = 224 * MiB;
constexpr size_t WS_H = 352 * MiB, WS_PROJ = 384 * MiB, WS_OMIX = 492 * MiB, WS_OACC = 524 * MiB, WS_XA = 556 * MiB, WS_XB = 620 * MiB;
constexpr size_t WS_PQ = 684 * MiB, WS_EIDX = 716 * MiB, WS_EGATE = 720 * MiB, WS_MISC = 724 * MiB, WS_HRAW = 732 * MiB, WS_PARTS = 764 * MiB, WS_UT = 772 * MiB, WS_ST = 836 * MiB, WS_DEC = 868 * MiB, WS_KSR = 870 * MiB, WS_KWR = 874 * MiB, WS_VST = 878 * MiB, WS_VWT = 882 * MiB, WS_KCB = 886 * MiB, WS_VCT = 887 * MiB, WS_W2T = 887 * MiB + 512 * 1024, WS_PKB = 888 * MiB, WS_END = 889 * MiB;
constexpr size_t MS_KC = 0, MS_ROPEC = 1 * MiB, MS_ROPES = 1 * MiB + 512 * 1024, MS_SEL = 2 * MiB, MS_HID = 4 * MiB;
constexpr int CW_BAR = 4096;
constexpr int CW_PACE = 32768;

constexpr int LDS_BYTES = 163840;
constexpr int MISC_OFF = 163840 - 256;

#define RLX_AGENT __ATOMIC_RELAXED, __HIP_MEMORY_SCOPE_AGENT
__device__ __forceinline__ float bf2f(bf16 b) { return __uint_as_float(((unsigned)b) << 16); }
__device__ __forceinline__ unsigned f2bf(float f) { unsigned u = __float_as_uint(f); return (u + 0x7fffu + ((u >> 16) & 1u)) >> 16; }
__device__ __forceinline__ unsigned pk2(float lo, float hi) { return f2bf(lo) | (f2bf(hi) << 16); }
__device__ __forceinline__ float wave_sum(float v) {
#pragma unroll
    for (int o = 1; o < 64; o <<= 1) v += __shfl_xor(v, o);
    return v;
}
__device__ __forceinline__ float wave_max(float v) {
#pragma unroll
    for (int o = 1; o < 64; o <<= 1) v = fmaxf(v, __shfl_xor(v, o));
    return v;
}
__device__ __forceinline__ float sigmoidf_(float x) { return 1.0f / (1.0f + __expf(-x)); }
__device__ __forceinline__ float siluf_(float x) { return x / (1.0f + __expf(-x)); }
__device__ __forceinline__ float gelu_tanh(float x) { const float u = 0.7978845608028654f * (x + 0.044715f * x * x * x); const float e = __expf(2.0f * u); return 0.5f * x * (1.0f + (1.0f - 2.0f / (e + 1.0f))); }
#define XB_TMO      128
#define XB_XCNT(j)  (256  + 64 * (j))
#define XB_XSUB(j)  (1280 + 64 * (j))
#define XB_XGEN(j)  (2304 + 64 * (j))
#define XB_TOP      3328
#define XB_TOPGEN   3392
#define XCD_BAR_WORDS 3456
#define XB_SPIN_CAP (1u << 18)

__device__ __forceinline__ unsigned xb_ld(unsigned* p)              { return __hip_atomic_load(p, __ATOMIC_RELAXED, __HIP_MEMORY_SCOPE_AGENT); }
__device__ __forceinline__ unsigned xb_add(unsigned* p, unsigned v) { return __hip_atomic_fetch_add(p, v, __ATOMIC_RELAXED, __HIP_MEMORY_SCOPE_AGENT); }
__device__ __forceinline__ unsigned xb_xcc_id() { return (unsigned)__builtin_amdgcn_s_getreg((3 << 11) | 20) & 0xFu; }
#define XB_SPIN(cond, bar) do { unsigned _sp = 0; while (cond) { __builtin_amdgcn_s_sleep(1); \
    if ((++_sp & 255u) == 0u) { if (xb_ld(&(bar)[XB_TMO])) break; if (_sp > XB_SPIN_CAP) { atomicAdd(&(bar)[XB_TMO], 1u); break; } } } } while (0)

struct XcdBarrier {
    unsigned* bar; unsigned x;
    volatile LAS unsigned* st;
};

__device__ __forceinline__ XcdBarrier xcd_barrier_post(unsigned* bar, volatile LAS unsigned* st) {
    XcdBarrier b; b.bar = bar; b.x = xb_xcc_id(); b.st = st;
    if (threadIdx.x == 0) (void)xb_add(&bar[XB_XCNT(b.x)], 1u);
    return b;
}
__device__ __forceinline__ void xcd_barrier_complete(unsigned* bar, unsigned x, unsigned& nloc, unsigned& nx) {
    const unsigned G = gridDim.x * gridDim.y * gridDim.z;
    unsigned sum, cnt, mine, sp = 0u;
    for (;;) {
        sum = 0u; cnt = 0u; mine = 0u;
#pragma unroll
        for (unsigned j = 0; j < 16; ++j) { const unsigned c = xb_ld(&bar[XB_XCNT(j)]); sum += c; cnt += (c > 0u) ? 1u : 0u; mine = (j == x) ? c : mine; }
        if (sum == G) break;
        __builtin_amdgcn_s_sleep(1);
        if ((++sp & 255u) == 0u) { if (xb_ld(&bar[XB_TMO])) break; if (sp > XB_SPIN_CAP) { atomicAdd(&bar[XB_TMO], 1u); break; } }
    }
    nloc = mine > 0u ? mine : 1u; nx = cnt > 0u ? cnt : 1u;
}

__device__ __forceinline__ void xcd_barrier(const XcdBarrier& b) {
    asm volatile("s_waitcnt vmcnt(0)" ::: "memory");
    __syncthreads();
    if (threadIdx.x == 0) {
        unsigned* bar = b.bar;
        __builtin_amdgcn_s_waitcnt(0);
        unsigned nloc = b.st[0], nx = b.st[1];
        if (nloc == 0u) { xcd_barrier_complete(bar, b.x, nloc, nx); b.st[0] = nloc; b.st[1] = nx; }
        const unsigned old = xb_add(&bar[XB_XSUB(b.x)], 1u);
        const unsigned gen = old / nloc;
        if (old + 1u == (gen + 1u) * nloc) {
            __builtin_amdgcn_fence(__ATOMIC_RELEASE, "agent");
            asm volatile("s_waitcnt vmcnt(0)" ::: "memory");
            const unsigned og = xb_add(&bar[XB_TOP], 1u);
            const unsigned tg = og / nx;
            if (og + 1u == (tg + 1u) * nx) xb_add(&bar[XB_TOPGEN], 1u);
            else XB_SPIN(xb_ld(&bar[XB_TOPGEN]) == tg, bar);
            __builtin_amdgcn_fence(__ATOMIC_ACQUIRE, "agent");
            xb_add(&bar[XB_XGEN(b.x)], 1u);
            asm volatile("s_waitcnt vmcnt(0)" ::: "memory");
        } else {
            XB_SPIN(xb_ld(&bar[XB_XGEN(b.x)]) == gen, bar);
            __builtin_amdgcn_fence(__ATOMIC_ACQUIRE, "agent");
            asm volatile("s_waitcnt vmcnt(0)" ::: "memory");
        }
    }
    __syncthreads();
}

struct Args { const void* in[26]; float* out; unsigned char* ws; int layer, pad; };
typedef const __attribute__((address_space(4))) Args* KA;
__device__ __forceinline__ int perm16(int n) { const int k = n & 15; return (n & ~15) | (k < 4 ? k : (k < 8 ? k + 4 : (k < 12 ? k - 4 : k))); }
struct Frame {
    LAS unsigned char* lds;
    int tid, lane, wave, vb, G;
};
enum { I_X = 0, I_C, I_POS, I_NMIX, I_NFFN, I_WADA, I_BADA, I_WIN, I_WOUT, I_CKPOS, I_CKW1, I_CKB1, I_CKW2, I_CKB2, I_CVPOS, I_CVW1, I_CVB1, I_CVW2, I_CVB2, I_HNORM, I_HLB, I_PWQ, I_PKEYS, I_PU, I_PV, I_FNORM };

template <bool MAPPED>
__device__ __forceinline__ void p0_transpose_item(const float* W, int K, int N, bf16* WT, LAS float* scr, int item, int lane) {
    const int nblk = (N + 31) / 32, kb = item / nblk, nb = item % nblk, k0 = 64 * kb, n0 = 32 * nb;
    const int ncol = n0 + (lane & 31);
#pragma unroll 8
    for (int i = 0; i < 32; ++i) { const int kk = 2 * i + (lane >> 5); scr[kk * 33 + (lane & 31)] = (ncol < N) ? W[(size_t)(k0 + kk) * N + ncol] : 0.f; }
    asm volatile("s_waitcnt lgkmcnt(0)" ::: "memory");
    const int c = lane & 7;
#pragma unroll
    for (int j = 0; j < 4; ++j) { const int n = (lane >> 3) + 8 * j; const LAS float* s = scr + (8 * c) * 33 + n;
        v4u o; o.x = pk2(s[0 * 33], s[1 * 33]); o.y = pk2(s[2 * 33], s[3 * 33]); o.z = pk2(s[4 * 33], s[5 * 33]); o.w = pk2(s[6 * 33], s[7 * 33]);
        if (n0 + n < N) { const int row = MAPPED ? winmap(n0 + n) : (n0 + n); *(v4u*)(WT + (size_t)row * K + k0 + 8 * c) = o; } }
    asm volatile("s_waitcnt lgkmcnt(0)" ::: "memory");
}

__device__ __forceinline__ void p0_prologue(KA a, Frame& F) {
    unsigned char* ws = a->ws;
    LAS float* scr = (LAS float*)(F.lds + F.wave * 16384);
    const int gw = F.vb * 8 + F.wave, NGW = F.G * 8;
    const long gt = (long)F.vb * 512 + F.tid, GT = (long)F.G * 512;
    {
        constexpr int I_IN = (D / 64) * ((INW + 31) / 32);
        constexpr int I_SQ = (D / 64) * (D / 32);
        constexpr int I_W1 = (4096 / 64) * (256 / 32);
        constexpr int I_W2 = (256 / 64) * (128 / 32);
        constexpr int NITEMS = 2 * I_IN + 4 * I_SQ + 4 * I_W1 + 4 * I_W2;
        for (int it = gw; it < NITEMS; it += NGW) {
            int r = it;
            if (r < 2 * I_IN) { const int l = r / I_IN; p0_transpose_item<true>((const float*)a->in[I_WIN] + (size_t)l * D * INW, D, INW, (bf16*)(ws + WS_WINT) + (size_t)l * NPROJ * D, scr, r % I_IN, F.lane); continue; }
            r -= 2 * I_IN;
            if (r < 2 * I_SQ) { const int l = r / I_SQ; p0_transpose_item<false>((const float*)a->in[I_WOUT] + (size_t)l * D * D, D, D, (bf16*)(ws + WS_WOUTT) + (size_t)l * D * D, scr, r % I_SQ, F.lane); continue; }
            r -= 2 * I_SQ;
            if (r < 2 * I_SQ) { const int l = r / I_SQ; p0_transpose_item<false>((const float*)a->in[I_PWQ] + (size_t)l * D * D, D, D, (bf16*)(ws + WS_WQT) + (size_t)l * D * D, scr, r % I_SQ, F.lane); continue; }
            r -= 2 * I_SQ;
            if (r < 4 * I_W1) { const int lk = r / I_W1, l = lk >> 1, kv = lk & 1;
              p0_transpose_item<false>((const float*)a->in[kv ? I_CVW1 : I_CKW1] + (size_t)l * 4096 * 256, 4096, 256, (bf16*)(ws + WS_W1T) + (size_t)lk * 256 * 4096, scr, r % I_W1, F.lane); continue; }
            r -= 4 * I_W1;
            { const int lk = r / I_W2, l = lk >> 1, kv = lk & 1;
              p0_transpose_item<false>((const float*)a->in[kv ? I_CVW2 : I_CKW2] + (size_t)l * 256 * 128, 256, 128, (bf16*)(ws + WS_W2T) + (size_t)lk * 128 * 256, scr, r % I_W2, F.lane); }
        }
    }
    {
        constexpr int CH = (NPROJ - INW) * D / 8;
        for (long i = gt; i < 2L * CH; i += GT) { const int l = (int)(i / CH); const long c = i % CH;
            *(v4u*)((bf16*)(ws + WS_WINT) + (size_t)l * NPROJ * D + (size_t)INW * D + c * 8) = (v4u){0u, 0u, 0u, 0u}; }
    }
    {
        const f32x4* sk = (const f32x4*)a->in[I_PKEYS]; v2u* dk = (v2u*)(ws + WS_PKB);
        for (long i = gt; i < 2L * 8 * 2 * 128 * 128 / 4; i += GT) { const f32x4 v = sk[i]; dk[i] = (v2u){pk2(v.x, v.y), pk2(v.z, v.w)}; }
    }
    {
        const int* pos = (const int*)a->in[I_POS]; float* rc = (float*)(ws + WS_MISC + MS_ROPEC); float* rs = (float*)(ws + WS_MISC + MS_ROPES);
        for (long i = gt; i < (long)T * 16; i += GT) { const int m = (int)(i >> 4), j = (int)(i & 15);
            const float inv = powf(500000.0f, -(float)(2 * j) / 32.0f); const float ang = (float)pos[m] * inv;
            rc[i] = cosf(ang); rs[i] = sinf(ang); }
    }
    {
        LAS float* cs = (LAS float*)(F.lds + 131072 - 4096);
        const float* cin = (const float*)a->in[I_C]; float* parts = (float*)(ws + WS_PARTS);
        for (int it = F.vb; it < 2 * 16 * 6; it += F.G) {
            const int l = it / 96, kc = (it % 96) / 6, cb = it % 6;
            __syncthreads();
            { const int b = F.tid >> 7, k = F.tid & 127; cs[F.tid] = siluf_(cin[b * D + kc * 128 + k]); }
            __syncthreads();
            const int col = cb * 2048 + F.tid * 4;
            const float* w = (const float*)a->in[I_WADA] + ((size_t)l * D + kc * 128) * 12288 + col;
            f32x4 acc[4];
#pragma unroll
            for (int b = 0; b < 4; ++b) acc[b] = (f32x4){0.f, 0.f, 0.f, 0.f};
            if (kc == 0) { const f32x4 bv = *(const f32x4*)((const float*)a->in[I_BADA] + (size_t)l * 12288 + col);
#pragma unroll
                for (int b = 0; b < 4; ++b) acc[b] = bv; }
#pragma unroll 8
            for (int k = 0; k < 128; ++k) { const f32x4 wv = *(const f32x4*)(w + (size_t)k * 12288);
#pragma unroll
                for (int b = 0; b < 4; ++b) acc[b] += wv * cs[b * 128 + k]; }
#pragma unroll
            for (int b = 0; b < 4; ++b) *(f32x4*)(parts + (((size_t)kc * 2 + l) * 4 + b) * 12288 + col) = acc[b];
        }
        __syncthreads();
    }
    {
        float* b1p = (float*)(ws + WS_B1P);
        for (int it = F.vb; it < 64; it += F.G) {
            const int lk = it >> 4, l = lk >> 1, kv = lk & 1, kc = it & 15;
            if (F.tid < 256) {
                const int c = F.tid;
                const float* w1 = (const float*)a->in[kv ? I_CVW1 : I_CKW1] + (size_t)l * 4096 * 256;
                const float* pe = (const float*)a->in[kv ? I_CVPOS : I_CKPOS] + (size_t)l * 4096;
                float acc = (kc == 0) ? ((const float*)a->in[kv ? I_CVB1 : I_CKB1])[l * 256 + c] : 0.f;
                const int k0 = kc * 256;
#pragma unroll 8
                for (int k = 0; k < 256; ++k) acc += pe[k0 + k] * w1[(size_t)(k0 + k) * 256 + c];
                b1p[(kc * 4 + lk) * 256 + c] = acc;
            }
        }
    }
}


constexpr int PC_UNITS = 65536, PC_U3 = 20480;
__device__ __forceinline__ void peer_convert(KA a, int l, int u0, int u1, int wave, int lane) {
    for (int u = u0 + wave; u < u1; u += 8) {
        const int tab = u >> 15; const size_t e0 = (size_t)l * 16384 * 2048 + (size_t)(u & 32767) * 1024;
        const float* src = (const float*)a->in[tab ? I_PV : I_PU] + e0; unsigned* dst = (unsigned*)(a->ws + (tab ? WS_PV : WS_PU) + e0);
        const float sc = tab ? 1.0f : 64.0f;
        f32x4 x[4];
#pragma unroll
        for (int q = 0; q < 4; ++q) x[q] = *(const f32x4*)(src + 256 * q + 4 * lane) * sc;
#pragma unroll
        for (int q = 0; q < 4; ++q) { int w = __builtin_amdgcn_cvt_pk_fp8_f32(x[q].x, x[q].y, 0, false); w = __builtin_amdgcn_cvt_pk_fp8_f32(x[q].z, x[q].w, w, true); dst[64 * q + lane] = (unsigned)w; }
    }
}

template <bool PART>
__device__ __forceinline__ void norm_phase(Frame& F, unsigned char* ws, const float* x, const float* gain, int l, int sh_off, int sc_off, bf16* out) {
    LAS float* shs = (LAS float*)F.lds; LAS float* scs = shs + 2048;
    const float* parts = (const float*)(ws + WS_PARTS); float* mod = (float*)(ws + WS_MOD);
    if (PART) {
        const long gt = (long)F.vb * 512 + F.tid, GT = (long)F.G * 512;
        for (long i = gt; i < 2L * 4 * 12288; i += GT) { float sacc = 0.f; const float* pp = parts + i;
#pragma unroll 1
            for (int kc = 0; kc < 16; ++kc) { sacc += *pp; pp += 2 * 4 * 12288; }
            mod[i] = sacc; }
    }
    for (int rb = F.vb; rb < T / 32; rb += F.G) {
        const int m0 = rb * 32, b = m0 / S;
        __syncthreads();
        for (int c = F.tid; c < 2048; c += 512) {
            float s0 = 0.f, s1 = 0.f;
            if (PART) { const float* pp = parts + ((size_t)l * 4 + b) * 12288 + c;
#pragma unroll 1
                for (int kc = 0; kc < 16; ++kc) { s0 += pp[sh_off]; s1 += pp[sc_off]; pp += 2 * 4 * 12288; }
            } else { const float* mp = mod + ((size_t)l * 4 + b) * 12288; s0 = mp[sh_off + c]; s1 = mp[sc_off + c]; }
            shs[c] = s0; scs[c] = s1 + 1.0f;
        }
        __syncthreads();
        for (int r = 0; r < 4; ++r) {
            const int m = m0 + F.wave * 4 + r;
            const float* xr = x + (size_t)m * D;
            f32x4 v[8]; float ss = 0.f;
#pragma unroll
            for (int j = 0; j < 8; ++j) { v[j] = *(const f32x4*)(xr + F.lane * 4 + 256 * j); ss += v[j].x * v[j].x + v[j].y * v[j].y + v[j].z * v[j].z + v[j].w * v[j].w; }
            const float rr = rsqrtf(wave_sum(ss) * (1.0f / D) + EPS);
#pragma unroll
            for (int j = 0; j < 8; ++j) { const int c = F.lane * 4 + 256 * j;
                const f32x4 g = *(const f32x4*)(gain + c), s1 = *(const LAS f32x4*)(scs + c), s0 = *(const LAS f32x4*)(shs + c);
                const f32x4 y = (v[j] * rr) * g * s1 + s0;
                *(v2u*)(out + (size_t)m * D + c) = (v2u){pk2(y.x, y.y), pk2(y.z, y.w)}; }
        }
    }
    __syncthreads();
}

__device__ __forceinline__ void cmp1_naive(KA a, Frame& F, int l) {
    const bf16* proj = (const bf16*)(a->ws + WS_PROJ); float* hid = (float*)(a->ws + WS_MISC + MS_HID);
    const long gt = (long)F.vb * 512 + F.tid, GT = (long)F.G * 512;
    constexpr int ROWS = NB * NCMP * 2;
    for (long i = gt; i < 2L * ROWS * 256; i += GT) {
        const int c = (int)(i & 255); const int row = (int)((i >> 8) % ROWS), kv = (int)((i >> 8) / ROWS);
        const int g = row & 1, n = (row >> 1) % NCMP, b = (row >> 1) / NCMP;
        const float* w1 = (const float*)a->in[kv ? I_CVW1 : I_CKW1] + (size_t)l * 4096 * 256 + c;
        const float* pe = (const float*)a->in[kv ? I_CVPOS : I_CKPOS] + (size_t)l * 4096;
        const bf16* ap = proj + (size_t)(b * S + 16 * n) * NPROJ + (kv ? C_VC : C_KC) + g * 128;
        float acc = ((const float*)a->in[kv ? I_CVB1 : I_CKB1])[l * 256 + c];
        for (int tl = 0; tl < 32; ++tl) {
#pragma unroll 8
            for (int d = 0; d < 128; ++d) acc += (bf2f(ap[(size_t)tl * NPROJ + d]) + pe[tl * 128 + d]) * w1[(size_t)(tl * 128 + d) * 256];
        }
        hid[i] = gelu_tanh(acc);
    }
}
__device__ __forceinline__ void cmp2_naive(KA a, Frame& F, int l) {
    const float* hid = (const float*)(a->ws + WS_MISC + MS_HID); float* kc = (float*)(a->ws + WS_MISC + MS_KC);
    const long gt = (long)F.vb * 512 + F.tid, GT = (long)F.G * 512;
    constexpr int ROWS = NB * NCMP * 2;
    for (long i = gt; i < 2L * ROWS * 128; i += GT) {
        const int j = (int)(i & 127); const int row = (int)((i >> 7) % ROWS), kv = (int)((i >> 7) / ROWS);
        const float* w2 = (const float*)a->in[kv ? I_CVW2 : I_CKW2] + (size_t)l * 256 * 128 + j;
        const float* hr = hid + ((size_t)kv * ROWS + row) * 256;
        float acc = ((const float*)a->in[kv ? I_CVB2 : I_CKB2])[l * 128 + j];
#pragma unroll 8
        for (int c = 0; c < 256; ++c) acc += hr[c] * w2[(size_t)c * 128];
        const int g = row & 1, n = (row >> 1) % NCMP, b = (row >> 1) / NCMP;
        kc[((((size_t)kv * NB + b) * 128 + n) * 2 + g) * 128 + j] = acc;
        if (kv == 0) ((bf16*)(a->ws + WS_KCB))[((size_t)(b * 2 + g) * 128 + n) * 128 + j] = (bf16)f2bf(acc);
        else ((bf16*)(a->ws + WS_VCT))[((size_t)(b * 2 + g) * 128 + j) * 128 + perm16(n)] = (bf16)f2bf(acc);
    }
    for (long i = gt; i < 2L * NB * 2 * 128; i += GT) {
        const int j = (int)(i & 127), bg = (int)((i >> 7) & 7), kv = (int)(i >> 10);
        if (kv == 0) ((bf16*)(a->ws + WS_KCB))[((size_t)bg * 128 + 127) * 128 + j] = 0;
        else ((bf16*)(a->ws + WS_VCT))[((size_t)bg * 128 + j) * 128 + perm16(127)] = 0;
    }
}

__device__ __forceinline__ void hgrn_naive(KA a, Frame& F, int l) {
    if (F.wave != 0 || F.vb >= 128) return;
    const bf16* proj = (const bf16*)(a->ws + WS_PROJ); float* hraw = (float*)(a->ws + WS_HRAW);
    LAS float* fs = (LAS float*)(F.lds + 65536); LAS float* ks = fs + 128; LAS float* qs = fs + 256;
    const int item = F.vb, eq = item & 3, h = (item >> 2) & 7, b = item >> 5;
    const int e = eq * 32 + (F.lane & 31), dh = F.lane >> 5;
    const float* lbp = (const float*)a->in[I_HLB];
    float lb0, lb1;
    { const float a0 = lbp[h * 128 + F.lane], a1 = lbp[1024 + h * 128 + F.lane]; lb0 = (l == 0) ? 0.f : 1.0f / (1.0f + __expf(a0 - a1));
      const float c0 = lbp[h * 128 + 64 + F.lane], c1 = lbp[1024 + h * 128 + 64 + F.lane]; lb1 = (l == 0) ? 0.f : 1.0f / (1.0f + __expf(c0 - c1)); }
    float st[64];
#pragma unroll
    for (int d = 0; d < 64; ++d) st[d] = 0.f;
    for (int t = 0; t < S; ++t) {
        const bf16* pr = proj + (size_t)(b * S + t) * NPROJ;
        const float f0 = lb0 + (1.0f - lb0) * sigmoidf_(bf2f(pr[C_HF + h * 128 + F.lane])), f1 = lb1 + (1.0f - lb1) * sigmoidf_(bf2f(pr[C_HF + h * 128 + 64 + F.lane]));
        fs[F.lane] = f0; fs[64 + F.lane] = f1; ks[F.lane] = 1.0f - f0; ks[64 + F.lane] = 1.0f - f1;
        qs[F.lane] = siluf_(bf2f(pr[C_HQ + h * 128 + F.lane])); qs[64 + F.lane] = siluf_(bf2f(pr[C_HQ + h * 128 + 64 + F.lane]));
        const float v = bf2f(pr[C_HI + h * 128 + e]);
        asm volatile("s_waitcnt lgkmcnt(0)" ::: "memory");
        float o = 0.f;
#pragma unroll
        for (int d = 0; d < 64; ++d) { st[d] = fs[dh * 64 + d] * st[d] + ks[dh * 64 + d] * v; o += st[d] * qs[dh * 64 + d]; }
        o += __shfl_xor(o, 32);
        if (dh == 0) hraw[(size_t)(b * S + t) * 1024 + h * 128 + e] = o;
        asm volatile("s_waitcnt lgkmcnt(0)" ::: "memory");
    }
}
__device__ __forceinline__ void hgrn_norm_naive(KA a, Frame& F, int l) {
    const bf16* proj = (const bf16*)(a->ws + WS_PROJ); const float* hraw = (const float*)(a->ws + WS_HRAW); bf16* omix = (bf16*)(a->ws + WS_OMIX);
    const float* gn = (const float*)a->in[I_HNORM] + l * 1024;
    const int gw = F.vb * 8 + F.wave, NGW = F.G * 8;
    for (int i = gw; i < T * 8; i += NGW) { const int m = i >> 3, h = i & 7;
        const float o0 = hraw[(size_t)m * 1024 + h * 128 + F.lane], o1 = hraw[(size_t)m * 1024 + h * 128 + 64 + F.lane];
        const float r = rsqrtf(wave_sum(o0 * o0 + o1 * o1) * (1.0f / 128.0f) + EPS);
        const bf16* pr = proj + (size_t)m * NPROJ + C_HG + h * 128;
#ifdef EXP_NO_HGRN
        omix[(size_t)m * D + 1024 + h * 128 + F.lane] = 0; omix[(size_t)m * D + 1024 + h * 128 + 64 + F.lane] = 0; continue;
#endif
        omix[(size_t)m * D + 1024 + h * 128 + F.lane] = (bf16)f2bf(o0 * r * gn[h * 128 + F.lane] * sigmoidf_(bf2f(pr[F.lane])));
        omix[(size_t)m * D + 1024 + h * 128 + 64 + F.lane] = (bf16)f2bf(o1 * r * gn[h * 128 + 64 + F.lane] * sigmoidf_(bf2f(pr[64 + F.lane])));
    }
}

__device__ __forceinline__ void catt_naive(KA a, Frame& F) {
    const bf16* proj = (const bf16*)(a->ws + WS_PROJ); const float* kc = (const float*)(a->ws + WS_MISC + MS_KC); const float* vc = kc + (size_t)NB * 128 * 2 * 128;
    float* oacc = (float*)(a->ws + WS_OACC); unsigned* sel = (unsigned*)(a->ws + WS_MISC + MS_SEL);
    LAS float* qs = (LAS float*)(F.lds + F.wave * 2048); LAS float* ps = qs + 128;
    const int gw = F.vb * 8 + F.wave, NGW = F.G * 8;
    for (int i = gw; i < NB * 2 * S; i += NGW) {
        const int s = i % S, g = (i / S) & 1, b = i / (2 * S), m = b * S + s;
        const int nv = s >= 31 ? (s - 31) / 16 + 1 : 0;
        const bf16* pr = proj + (size_t)m * NPROJ;
        float imp = 0.f;
        for (int hh = 0; hh < 4; ++hh) {
            const int head = g * 4 + hh;
            qs[F.lane] = bf2f(pr[C_Q + head * 128 + F.lane]); qs[64 + F.lane] = bf2f(pr[C_Q + head * 128 + 64 + F.lane]);
            asm volatile("s_waitcnt lgkmcnt(0)" ::: "memory");
            float sc[2];
#pragma unroll
            for (int u = 0; u < 2; ++u) { const int n = F.lane + 64 * u; float acc = 0.f;
                if (n < nv) { const float* kr = kc + (((size_t)b * 128 + n) * 2 + g) * 128;
#pragma unroll 8
                    for (int d = 0; d < 128; ++d) acc += qs[d] * kr[d]; }
                sc[u] = (n < nv) ? acc * ATT_SCALE : -__builtin_inff(); }
            float mx = wave_max(fmaxf(sc[0], sc[1])); if (!(mx > -1e30f)) mx = 0.f;
            const float e0 = (F.lane < nv) ? __expf(sc[0] - mx) : 0.f, e1 = (F.lane + 64 < nv) ? __expf(sc[1] - mx) : 0.f;
            const float den = fmaxf(wave_sum(e0 + e1), 1e-30f);
            ps[F.lane] = e0 / den; ps[64 + F.lane] = e1 / den;
            asm volatile("s_waitcnt lgkmcnt(0)" ::: "memory");
            float o0 = 0.f, o1 = 0.f;
            for (int n = 0; n < nv; ++n) { const float p = ps[n]; const float* vr = vc + (((size_t)b * 128 + n) * 2 + g) * 128; o0 += p * vr[F.lane]; o1 += p * vr[64 + F.lane]; }
            const float g0 = sigmoidf_(bf2f(pr[C_GL + head * 3 + 0]));
            oacc[(size_t)m * 1024 + head * 128 + F.lane] = g0 * o0; oacc[(size_t)m * 1024 + head * 128 + 64 + F.lane] = g0 * o1;
            if (F.lane < 32) { const int j = F.lane; float v = ps[4 * j] + ps[4 * j + 1] + ps[4 * j + 2] + 0.5f * (4 * j + 3 < NCMP ? ps[4 * j + 3] : 0.f); if (j > 0) v += 0.5f * ps[4 * j - 1]; imp += v; }
            asm volatile("s_waitcnt lgkmcnt(0)" ::: "memory");
        }
        const int qb = s >> 6, j = F.lane & 31;
        const bool forced = (j == 0) || (j == qb) || (j + 1 == qb);
        const float score = forced ? __builtin_inff() : (j <= qb ? imp : -__builtin_inff());
        int rank = 0;
#pragma unroll
        for (int k = 0; k < 32; ++k) { const float o = __shfl(score, k); rank += (o > score || (o == score && k < j)) ? 1 : 0; }
        const unsigned long long bal = __ballot(F.lane < 32 && rank < 16 && j <= qb);
        if (F.lane == 0) sel[i] = (unsigned)bal;
    }
}

__device__ __forceinline__ float dot_rope(const LAS float* qs, const bf16* kr, const float* cr, const float* sr) {
    float acc = 0.f;
#pragma unroll
    for (int d = 0; d < 16; ++d) { const float k1 = bf2f(kr[d]), k2 = bf2f(kr[d + 16]), c = cr[d], sn = sr[d];
        acc += qs[d] * (k1 * c - k2 * sn) + qs[d + 16] * (k2 * c + k1 * sn); }
#pragma unroll 8
    for (int d = 32; d < 128; ++d) acc += qs[d] * bf2f(kr[d]);
    return acc;
}
__device__ __forceinline__ void satt_naive(KA a, Frame& F) {
    const bf16* proj = (const bf16*)(a->ws + WS_PROJ); const float* oacc = (const float*)(a->ws + WS_OACC); bf16* omix = (bf16*)(a->ws + WS_OMIX);
    const unsigned* sel = (const unsigned*)(a->ws + WS_MISC + MS_SEL);
    const float* rc = (const float*)(a->ws + WS_MISC + MS_ROPEC); const float* rs = (const float*)(a->ws + WS_MISC + MS_ROPES);
    LAS float* qs = (LAS float*)(F.lds + F.wave * 8192); LAS float* ps = qs + 128;
    const int gw = F.vb * 8 + F.wave, NGW = F.G * 8;
    for (int i = gw; i < NB * 8 * S; i += NGW) {
        const int s = i % S, head = (i / S) & 7, b = i / (8 * S), m = b * S + s, g = head >> 2;
        const bf16* pr = proj + (size_t)m * NPROJ;
        { const float q0 = bf2f(pr[C_Q + head * 128 + F.lane]), q1 = bf2f(pr[C_Q + head * 128 + 64 + F.lane]);
          float qo = q0; const float other = __shfl_xor(q0, 16);
          if (F.lane < 32) { const int dd = F.lane & 15; const float c = rc[m * 16 + dd], sn = rs[m * 16 + dd];
              qo = (F.lane < 16) ? q0 * c - other * sn : q0 * c + other * sn; }
          qs[F.lane] = qo; qs[64 + F.lane] = q1; }
        asm volatile("s_waitcnt lgkmcnt(0)" ::: "memory");
        float res0 = oacc[(size_t)m * 1024 + head * 128 + F.lane], res1 = oacc[(size_t)m * 1024 + head * 128 + 64 + F.lane];
        const float g1 = sigmoidf_(bf2f(pr[C_GL + head * 3 + 1])), g2 = sigmoidf_(bf2f(pr[C_GL + head * 3 + 2]));
        {
            const unsigned mask = sel[(b * 2 + g) * S + s];
            unsigned mm = mask; float mx = -__builtin_inff();
#pragma nounroll
            for (int u = 0; u < 16; ++u) { float v = -__builtin_inff();
                if (mm) { const int j = __builtin_ctz(mm); mm &= mm - 1; const int key = 64 * j + F.lane;
                    if (key <= s) { const int mk = b * S + key; v = dot_rope(qs, proj + (size_t)mk * NPROJ + C_KS + g * 128, rc + mk * 16, rs + mk * 16) * ATT_SCALE; } }
                ps[u * 64 + F.lane] = v; mx = fmaxf(mx, v); }
            mx = wave_max(mx);
            float sum = 0.f;
#pragma nounroll
            for (int u = 0; u < 16; ++u) { const float e = __expf(ps[u * 64 + F.lane] - mx); ps[u * 64 + F.lane] = e; sum += e; }
            sum = wave_sum(sum);
            asm volatile("s_waitcnt lgkmcnt(0)" ::: "memory");
            float o0 = 0.f, o1 = 0.f; mm = mask;
            for (int u = 0; u < 16 && mm; ++u) { const int j = __builtin_ctz(mm); mm &= mm - 1;
                const int kmax = min(63, s - 64 * j);
                for (int k = 0; k <= kmax; ++k) { const float p = ps[u * 64 + k]; const bf16* vr = proj + (size_t)(b * S + 64 * j + k) * NPROJ + C_VS + g * 128;
                    o0 += p * bf2f(vr[F.lane]); o1 += p * bf2f(vr[64 + F.lane]); } }
            res0 += g1 * o0 / sum; res1 += g1 * o1 / sum;
            asm volatile("s_waitcnt lgkmcnt(0)" ::: "memory");
        }
        {
            float mx = -__builtin_inff();
#pragma nounroll
            for (int u = 0; u < 8; ++u) { const int key = s - 511 + 64 * u + F.lane; float v = -__builtin_inff();
                if (key >= 0) { const int mk = b * S + key; v = dot_rope(qs, proj + (size_t)mk * NPROJ + C_KW + g * 128, rc + mk * 16, rs + mk * 16) * ATT_SCALE; }
                ps[u * 64 + F.lane] = v; mx = fmaxf(mx, v); }
            mx = wave_max(mx);
            float sum = 0.f;
#pragma nounroll
            for (int u = 0; u < 8; ++u) { const float e = __expf(ps[u * 64 + F.lane] - mx); ps[u * 64 + F.lane] = e; sum += e; }
            sum = wave_sum(sum);
            asm volatile("s_waitcnt lgkmcnt(0)" ::: "memory");
            float o0 = 0.f, o1 = 0.f;
            const int k0 = max(0, 511 - s);
            for (int k = k0; k < 512; ++k) { const float p = ps[k]; const bf16* vr = proj + (size_t)(b * S + s - 511 + k) * NPROJ + C_VW + g * 128;
                o0 += p * bf2f(vr[F.lane]); o1 += p * bf2f(vr[64 + F.lane]); }
            res0 += g2 * o0 / sum; res1 += g2 * o1 / sum;
            asm volatile("s_waitcnt lgkmcnt(0)" ::: "memory");
        }
#ifdef EXP_NO_NSA
        res0 = 0.f; res1 = 0.f;
#endif
        omix[(size_t)m * D + head * 128 + F.lane] = (bf16)f2bf(res0); omix[(size_t)m * D + head * 128 + 64 + F.lane] = (bf16)f2bf(res1);
    }
}

__device__ __forceinline__ void wave_argmax(float& v, int& i) {
#pragma unroll
    for (int o = 1; o < 64; o <<= 1) { const float ov = __shfl_xor(v, o); const int oi = __shfl_xor(i, o); if (ov > v || (ov == v && oi < i)) { v = ov; i = oi; } }
}
__device__ __forceinline__ void peer_topk(KA a, Frame& F, int l) {
    const bf16* pq = (const bf16*)(a->ws + WS_PQ); int* eidx = (int*)(a->ws + WS_EIDX); float* egate = (float*)(a->ws + WS_EGATE);
    const float* keys = (const float*)a->in[I_PKEYS] + (size_t)l * 8 * 2 * 128 * 128;
    LAS float* qs = (LAS float*)(F.lds + F.wave * 1024);
    const int gw = F.vb * 8 + F.wave, NGW = F.G * 8;
    const float NEG = -__builtin_inff();
    for (int i = gw; i < T * 8; i += NGW) {
        const int t = i >> 3, h = i & 7;
        const bf16* qr = pq + (size_t)t * D + h * 256;
#pragma unroll
        for (int u = 0; u < 4; ++u) qs[u * 64 + F.lane] = bf2f(qr[u * 64 + F.lane]);
        asm volatile("s_waitcnt lgkmcnt(0)" ::: "memory");
        float sv[2]; int si[2];
#pragma unroll
        for (int p = 0; p < 2; ++p) {
            const float* kp = keys + ((size_t)(h * 2 + p) * 128) * 128;
            float c0 = 0.f, c1 = 0.f;
#pragma unroll 4
            for (int d = 0; d < 128; ++d) { const float q = qs[p * 128 + d]; c0 += q * kp[(size_t)F.lane * 128 + d]; c1 += q * kp[(size_t)(F.lane + 64) * 128 + d]; }
            float tv = NEG; int ti = 0;
#pragma nounroll
            for (int r = 0; r < 16; ++r) {
                float bv; int bi; if (c1 > c0) { bv = c1; bi = F.lane + 64; } else { bv = c0; bi = F.lane; }
                wave_argmax(bv, bi);
                if (bi == F.lane) c0 = NEG; if (bi == F.lane + 64) c1 = NEG;
                if (F.lane == r) { tv = bv; ti = bi; }
            }
            sv[p] = tv; si[p] = ti;
        }
        float cv[4]; const int bsel = F.lane & 15; const float s2 = __shfl(sv[1], bsel);
#pragma unroll
        for (int r = 0; r < 4; ++r) cv[r] = __shfl(sv[0], (F.lane >> 4) + 4 * r) + s2;
        float tv = NEG; int tp = 0;
#pragma nounroll
        for (int r = 0; r < 16; ++r) {
            float bv = cv[0]; int bi = F.lane;
#pragma unroll
            for (int u = 1; u < 4; ++u) if (cv[u] > bv) { bv = cv[u]; bi = F.lane + 64 * u; }
            wave_argmax(bv, bi);
#pragma unroll
            for (int u = 0; u < 4; ++u) if (bi == F.lane + 64 * u) cv[u] = NEG;
            if (F.lane == r) { tv = bv; tp = bi; }
        }
        const int ia = __shfl(si[0], (tp >> 4) & 15), ib = __shfl(si[1], tp & 15);
        const float top = __shfl(tv, 0);
        float e = (F.lane < 16) ? __expf(tv - top) : 0.f;
        float sum = e;
#pragma unroll
        for (int o = 1; o < 16; o <<= 1) sum += __shfl_xor(sum, o);
        if (F.lane < 16) { eidx[(size_t)t * 128 + h * 16 + F.lane] = ia * 128 + ib; egate[(size_t)t * 128 + h * 16 + F.lane] = e / sum; }
    }
}

template <bool LAST>
__device__ __forceinline__ void peer_gather(KA a, Frame& F, int l, const float* x1, float* xo, const float* gate2  ) {
    const bf16* hb = (const bf16*)(a->ws + WS_H); const int* eidx = (const int*)(a->ws + WS_EIDX); const float* egate = (const float*)(a->ws + WS_EGATE);
    const bf16* pu = (const bf16*)(a->ws + WS_PU) + (size_t)l * 16384 * 2048; const bf16* pv = (const bf16*)(a->ws + WS_PV) + (size_t)l * 16384 * 2048;
    const int gw = F.vb * 8 + F.wave, NGW = F.G * 8;
    for (int t = gw; t < T; t += NGW) {
        v4u xh[4];
#pragma unroll
        for (int j = 0; j < 4; ++j) xh[j] = *(const v4u*)(hb + (size_t)t * D + 512 * j + 8 * F.lane);
        f32x2 acc[4][4];
#pragma unroll
        for (int j = 0; j < 4; ++j)
#pragma unroll
            for (int q = 0; q < 4; ++q) acc[j][q] = (f32x2){0.f, 0.f};
        const int* ei = eidx + (size_t)t * 128; const float* eg = egate + (size_t)t * 128;
#pragma unroll 2
        for (int k = 0; k < 128; ++k) {
            const int e = __builtin_amdgcn_readfirstlane(ei[k]); const float gk = __uint_as_float(__builtin_amdgcn_readfirstlane(__float_as_uint(eg[k])));
            const bf16* ur = pu + (size_t)e * 2048 + 8 * F.lane; const bf16* vr = pv + (size_t)e * 2048 + 8 * F.lane;
            v4u uu[4], vv[4];
#pragma unroll
            for (int j = 0; j < 4; ++j) { uu[j] = *(const v4u*)(ur + 512 * j); vv[j] = *(const v4u*)(vr + 512 * j); }
            float d = 0.f;
#pragma unroll
            for (int j = 0; j < 4; ++j) {
                const unsigned uw[4] = {uu[j].x, uu[j].y, uu[j].z, uu[j].w}, xw[4] = {xh[j].x, xh[j].y, xh[j].z, xh[j].w};
#pragma unroll
                for (int q = 0; q < 4; ++q) d += __uint_as_float(uw[q] << 16) * __uint_as_float(xw[q] << 16) + __uint_as_float(uw[q] & 0xffff0000u) * __uint_as_float(xw[q] & 0xffff0000u);
            }
            d = wave_sum(d);
            const float cf = gk * gelu_tanh(d);
#pragma unroll
            for (int j = 0; j < 4; ++j) {
                const unsigned w[4] = {vv[j].x, vv[j].y, vv[j].z, vv[j].w};
#pragma unroll
                for (int q = 0; q < 4; ++q) { const f32x2 vf = (f32x2){__uint_as_float(w[q] << 16), __uint_as_float(w[q] & 0xffff0000u)}; acc[j][q] += vf * cf; }
            }
        }
        const int b = t / S; const float* g2 = gate2 + (size_t)b * 12288;
        f32x4 o[4][2]; float ss = 0.f;
#pragma unroll
        for (int j = 0; j < 4; ++j)
#pragma unroll
            for (int hf = 0; hf < 2; ++hf) { const int c = 512 * j + 8 * F.lane + 4 * hf;
                const f32x4 xv = *(const f32x4*)(x1 + (size_t)t * D + c), gv = *(const f32x4*)(g2 + c);
                const f32x4 av = (f32x4){acc[j][2 * hf].x, acc[j][2 * hf].y, acc[j][2 * hf + 1].x, acc[j][2 * hf + 1].y};
#ifdef EXP_NO_PEER
                o[j][hf] = xv;
#elif defined(EXP_NEG_PEER)
                o[j][hf] = xv - gv * av;
#else
                o[j][hf] = xv + gv * av;
#endif
                ss += o[j][hf].x * o[j][hf].x + o[j][hf].y * o[j][hf].y + o[j][hf].z * o[j][hf].z + o[j][hf].w * o[j][hf].w; }
        if (LAST) { const float r = rsqrtf(wave_sum(ss) * (1.0f / D) + EPS); const float* fn = (const float*)a->in[I_FNORM];
#pragma unroll
            for (int j = 0; j < 4; ++j)
#pragma unroll
                for (int hf = 0; hf < 2; ++hf) { const int c = 512 * j + 8 * F.lane + 4 * hf; *(f32x4*)(xo + (size_t)t * D + c) = (o[j][hf] * r) * *(const f32x4*)(fn + c); } }
        else {
#pragma unroll
            for (int j = 0; j < 4; ++j)
#pragma unroll
                for (int hf = 0; hf < 2; ++hf) { const int c = 512 * j + 8 * F.lane + 4 * hf; *(f32x4*)(xo + (size_t)t * D + c) = o[j][hf]; } }
    }
}

typedef float f32x16 __attribute__((ext_vector_type(16)));
#define MFMA32(a, b, c) __builtin_amdgcn_mfma_f32_32x32x16_bf16((a), (b), (c), 0, 0, 0)
__device__ __forceinline__ unsigned cvtpk(float lo, float hi) { f32x2 v = {lo, hi}; bf16x2_t b = __builtin_convertvector(v, bf16x2_t); return __builtin_bit_cast(unsigned, b); }
constexpr int HG_TS = 144;
constexpr int HG_DS = 272;
constexpr int HL_SEG = 0, HL_KT = 2048, HL_VT = HL_KT + 128 * HG_TS, HL_QH = HL_VT + 128 * HG_TS, HL_QT = HL_QH + 64 * HG_DS, HL_K2 = HL_QT + 64 * HG_DS, HL_RED = HL_K2 + 64 * HG_DS;
static_assert(HL_RED + 1024 <= 131072, "hgrn LDS map");

__device__ __forceinline__ void hgrn_decay(const bf16* proj, const float* lbp, int l, int m0, int h, int d, int tq, LAS unsigned char* lds, float (&A)[16], float (&kk)[16], float& Aend, float& Amid) {
    float lb = 0.f;
    if (l != 0) { const float a0 = lbp[h * 128 + d], a1 = lbp[1024 + h * 128 + d]; lb = 1.0f / (1.0f + __expf(a0 - a1)); }
    float run = 0.f;
#pragma unroll
    for (int i = 0; i < 16; ++i) { const float x = bf2f(proj[(size_t)(m0 + 16 * tq + i) * NPROJ + C_HF + h * 128 + d]);
        const float f = lb + (1.0f - lb) * sigmoidf_(x); kk[i] = 1.0f - f; run += __logf(f); A[i] = run; }
    LAS float* seg = (LAS float*)(lds + HL_SEG);
    __syncthreads();
    seg[tq * 128 + d] = run;
    __syncthreads();
    const float s0 = seg[d], s1 = seg[128 + d], s2 = seg[256 + d], s3 = seg[384 + d];
    const float off = (tq > 0 ? s0 : 0.f) + (tq > 1 ? s1 : 0.f) + (tq > 2 ? s2 : 0.f);
#pragma unroll
    for (int i = 0; i < 16; ++i) A[i] += off;
    Aend = (s0 + s1) + (s2 + s3); Amid = s0 + s1;
}

__device__ __forceinline__ void hgrn_local(KA a, Frame& F, int l) {
    const bf16* proj = (const bf16*)(a->ws + WS_PROJ); float* ut = (float*)(a->ws + WS_UT); float* dec = (float*)(a->ws + WS_DEC);
    const float* lbp = (const float*)a->in[I_HLB];
    const int d = F.tid & 127, tq = F.tid >> 7, l32 = F.lane & 31, hi = F.lane >> 5;
    const bool deal = (F.G == 256); const int nmine = deal ? (F.vb < 128 ? 1 : 7) : (NB * 8 * 32 - F.vb + F.G - 1) / F.G;
    for (int it = 0; it < nmine; ++it) {
        const int item = deal ? (F.vb < 128 ? F.vb + it : 128 + 7 * (F.vb - 128) + it) : F.vb + it * F.G;
        const int c = item & 31, h = (item >> 5) & 7, b = item >> 8, m0 = b * S + c * 64;
        float A[16], kk[16], Aend, Amid;
        hgrn_decay(proj, lbp, l, m0, h, d, tq, F.lds, A, kk, Aend, Amid);
        unsigned kw[8], vw[8];
#pragma unroll
        for (int i = 0; i < 8; ++i) {
            kw[i] = cvtpk(kk[2 * i] * __expf(Aend - A[2 * i]), kk[2 * i + 1] * __expf(Aend - A[2 * i + 1]));
            const bf16 v0 = proj[(size_t)(m0 + 16 * tq + 2 * i) * NPROJ + C_HI + h * 128 + d], v1 = proj[(size_t)(m0 + 16 * tq + 2 * i + 1) * NPROJ + C_HI + h * 128 + d];
            vw[i] = (unsigned)v0 | ((unsigned)v1 << 16); }
        *(LAS v4u*)(F.lds + HL_KT + d * HG_TS + 32 * tq) = (v4u){kw[0], kw[1], kw[2], kw[3]}; *(LAS v4u*)(F.lds + HL_KT + d * HG_TS + 32 * tq + 16) = (v4u){kw[4], kw[5], kw[6], kw[7]};
        *(LAS v4u*)(F.lds + HL_VT + d * HG_TS + 32 * tq) = (v4u){vw[0], vw[1], vw[2], vw[3]}; *(LAS v4u*)(F.lds + HL_VT + d * HG_TS + 32 * tq + 16) = (v4u){vw[4], vw[5], vw[6], vw[7]};
        if (tq == 0) dec[(size_t)item * 128 + d] = __expf(Aend);
        __syncthreads();
        const int eblk = F.wave & 3;
#pragma unroll
        for (int dd = 0; dd < 2; ++dd) { const int dblk = 2 * (F.wave >> 2) + dd;
            f32x16 acc;
#pragma unroll
            for (int r = 0; r < 16; ++r) acc[r] = 0.f;
#pragma unroll
            for (int ks = 0; ks < 4; ++ks) {
                const bf16x8 af = *(const LAS bf16x8*)(F.lds + HL_KT + (32 * dblk + l32) * HG_TS + 32 * ks + 16 * hi);
                const bf16x8 bfr = *(const LAS bf16x8*)(F.lds + HL_VT + (32 * eblk + l32) * HG_TS + 32 * ks + 16 * hi);
                acc = MFMA32(af, bfr, acc); }
            float* up = ut + ((size_t)item * 128 + 32 * eblk + l32) * 128 + 32 * dblk + 4 * hi;
#pragma unroll
            for (int q = 0; q < 4; ++q) *(f32x4*)(up + 8 * q) = (f32x4){acc[4 * q], acc[4 * q + 1], acc[4 * q + 2], acc[4 * q + 3]};
        }
    }
    __syncthreads();
}

__device__ __forceinline__ void hgrn_scan(KA a, Frame& F) {
    const float* ut = (const float*)(a->ws + WS_UT); const float* dec = (const float*)(a->ws + WS_DEC); bf16* st = (bf16*)(a->ws + WS_ST);
    const long gt = (long)F.vb * 512 + F.tid, GT = (long)F.G * 512;
    for (long g = gt; g < 32L * 128 * 32; g += GT) {
        const int dq = (int)(g & 31), e = (int)((g >> 5) & 127), bh = (int)(g >> 12);
        f32x4 sacc = (f32x4){0.f, 0.f, 0.f, 0.f};
#pragma unroll 4
        for (int c = 0; c < 32; ++c) {
            const size_t idx = (((size_t)bh * 32 + c) * 128 + e) * 128 + 4 * dq;
            *(v2u*)(st + idx) = (v2u){cvtpk(sacc.x, sacc.y), cvtpk(sacc.z, sacc.w)};
            const f32x4 u = *(const f32x4*)(ut + idx), dc = *(const f32x4*)(dec + ((size_t)bh * 32 + c) * 128 + 4 * dq);
            sacc = dc * sacc + u; }
    }
}

__device__ __forceinline__ void hgrn_out(KA a, Frame& F, int l) {
    const bf16* proj = (const bf16*)(a->ws + WS_PROJ); const bf16* st = (const bf16*)(a->ws + WS_ST); bf16* omix = (bf16*)(a->ws + WS_OMIX);
    const float* lbp = (const float*)a->in[I_HLB]; const float* gn = (const float*)a->in[I_HNORM] + l * 1024;
    const int d = F.tid & 127, tq = F.tid >> 7, l32 = F.lane & 31, hi = F.lane >> 5;
    for (int item = F.vb; item < NB * 8 * 32; item += F.G) {
        const int c = item & 31, h = (item >> 5) & 7, b = item >> 8, m0 = b * S + c * 64;
        float A[16], kk[16], Aend, Amid;
        hgrn_decay(proj, lbp, l, m0, h, d, tq, F.lds, A, kk, Aend, Amid);
        unsigned vw[8];
#pragma unroll
        for (int i = 0; i < 16; ++i) { const int t = 16 * tq + i;
            const float qv = siluf_(bf2f(proj[(size_t)(m0 + t) * NPROJ + C_HQ + h * 128 + d]));
            *(LAS bf16*)(F.lds + HL_QH + t * HG_DS + 2 * d) = (bf16)(cvtpk(qv * __expf(A[i]), 0.f) & 0xffffu);
            *(LAS bf16*)(F.lds + HL_QT + t * HG_DS + 2 * d) = (bf16)(cvtpk(qv * __expf(A[i] - Amid), 0.f) & 0xffffu);
            *(LAS bf16*)(F.lds + HL_K2 + t * HG_DS + 2 * d) = (bf16)(cvtpk(kk[i] * __expf(Amid - A[i]), 0.f) & 0xffffu); }
#pragma unroll
        for (int i = 0; i < 8; ++i) {
            const bf16 v0 = proj[(size_t)(m0 + 16 * tq + 2 * i) * NPROJ + C_HI + h * 128 + d], v1 = proj[(size_t)(m0 + 16 * tq + 2 * i + 1) * NPROJ + C_HI + h * 128 + d];
            vw[i] = (unsigned)v0 | ((unsigned)v1 << 16); }
        *(LAS v4u*)(F.lds + HL_VT + d * HG_TS + 32 * tq) = (v4u){vw[0], vw[1], vw[4], vw[5]}; *(LAS v4u*)(F.lds + HL_VT + d * HG_TS + 32 * tq + 16) = (v4u){vw[2], vw[3], vw[6], vw[7]};
        __syncthreads();
        const int eblk = F.wave & 3, tblk = F.wave >> 2;
        f32x16 acc;
#pragma unroll
        for (int r = 0; r < 16; ++r) acc[r] = 0.f;
        { const bf16* sp = st + ((size_t)item * 128 + 32 * eblk + l32) * 128 + 8 * hi;
#pragma unroll
          for (int ks = 0; ks < 8; ++ks) { const bf16x8 af = *(const bf16x8*)(sp + 16 * ks);
              const bf16x8 bfr = *(const LAS bf16x8*)(F.lds + HL_QH + (32 * tblk + l32) * HG_DS + 32 * ks + 16 * hi);
              acc = MFMA32(af, bfr, acc); } }
#pragma unroll
        for (int stl = 0; stl < 2; ++stl) {
            if (stl <= tblk) {
                f32x16 P;
#pragma unroll
                for (int r = 0; r < 16; ++r) P[r] = 0.f;
#pragma unroll
                for (int ks = 0; ks < 8; ++ks) { const bf16x8 af = *(const LAS bf16x8*)(F.lds + HL_K2 + (32 * stl + l32) * HG_DS + 32 * ks + 16 * hi);
                    const bf16x8 bfr = *(const LAS bf16x8*)(F.lds + HL_QT + (32 * tblk + l32) * HG_DS + 32 * ks + 16 * hi);
                    P = MFMA32(af, bfr, P); }
                if (stl == tblk) {
#pragma unroll
                    for (int r = 0; r < 16; ++r) { const int sl = (r & 3) + 8 * (r >> 2) + 4 * hi; if (sl > l32) P[r] = 0.f; } }
#pragma unroll
                for (int hf = 0; hf < 2; ++hf) {
                    const v4u pw = (v4u){cvtpk(P[8 * hf], P[8 * hf + 1]), cvtpk(P[8 * hf + 2], P[8 * hf + 3]), cvtpk(P[8 * hf + 4], P[8 * hf + 5]), cvtpk(P[8 * hf + 6], P[8 * hf + 7])};
                    const bf16x8 af = *(const LAS bf16x8*)(F.lds + HL_VT + (32 * eblk + l32) * HG_TS + (32 * stl + 16 * hf) * 2 + 16 * hi);
                    acc = MFMA32(af, __builtin_bit_cast(bf16x8, pw), acc); }
            }
        }
        float ssq = 0.f;
#pragma unroll
        for (int r = 0; r < 16; ++r) ssq += acc[r] * acc[r];
        ssq += __shfl_xor(ssq, 32);
        LAS float* red = (LAS float*)(F.lds + HL_RED);
        if (hi == 0) red[eblk * 64 + 32 * tblk + l32] = ssq;
        __syncthreads();
        const int t = 32 * tblk + l32;
        const float tot = (red[t] + red[64 + t]) + (red[128 + t] + red[192 + t]);
        const float rinv = rsqrtf(tot * (1.0f / 128.0f) + EPS);
#pragma unroll
        for (int q = 0; q < 4; ++q) { const int e0 = 32 * eblk + 8 * q + 4 * hi;
            const f32x4 g4 = *(const f32x4*)(gn + h * 128 + e0);
            const v2u hgw = *(const v2u*)(proj + (size_t)(m0 + t) * NPROJ + C_HG + h * 128 + e0);
            const float o0 = acc[4 * q] * rinv * g4.x * sigmoidf_(__uint_as_float(hgw.x << 16)), o1 = acc[4 * q + 1] * rinv * g4.y * sigmoidf_(__uint_as_float(hgw.x & 0xffff0000u));
            const float o2 = acc[4 * q + 2] * rinv * g4.z * sigmoidf_(__uint_as_float(hgw.y << 16)), o3 = acc[4 * q + 3] * rinv * g4.w * sigmoidf_(__uint_as_float(hgw.y & 0xffff0000u));
            *(v2u*)(omix + (size_t)(m0 + t) * D + 1024 + h * 128 + e0) = (v2u){cvtpk(o0, o1), cvtpk(o2, o3)}; }
    }
    __syncthreads();
}

constexpr int AT_KS = 272;
constexpr int AT_VS = 144;
constexpr int AL_K0 = 0, AL_K1 = 64 * AT_KS, AL_V0 = 2 * 64 * AT_KS, AL_V1 = AL_V0 + 128 * AT_VS, AL_END = AL_V1 + 128 * AT_VS;
constexpr int AL_KC = 0, AL_VC = 128 * AT_KS, AL_IMPH = 2 * 128 * AT_KS, AL_IMPS = AL_IMPH + 4 * 64 * 32 * 4, AL_SEL = AL_IMPS + 64 * 32 * 4, AL_FSC = AL_SEL + 64 * 4, AL_CEND = AL_FSC + 4 * 64 * 2 * 4;
static_assert(AL_CEND <= 131072 && AL_END <= 131072, "attention LDS map");
constexpr float AT_C = ATT_SCALE * 1.4426950408889634f;

__device__ __forceinline__ void attn_prep(KA a, Frame& F) {
    const bf16* proj = (const bf16*)(a->ws + WS_PROJ);
    const float* rc = (const float*)(a->ws + WS_MISC + MS_ROPEC); const float* rs = (const float*)(a->ws + WS_MISC + MS_ROPES);
    const long gt = (long)F.vb * 512 + F.tid, GT = (long)F.G * 512;
    for (long i = gt; i < 2L * T * 2 * 16; i += GT) {
        const int c8 = (int)(i & 15), g = (int)((i >> 4) & 1), m = (int)((i >> 5) % T), ten = (int)(i / (32L * T));
        const bf16* src = proj + (size_t)m * NPROJ + (ten ? C_KW : C_KS) + g * 128;
        v4u x = *(const v4u*)(src + 8 * c8);
        if (c8 < 4) { const v4u y = *(const v4u*)(src + 8 * (c8 ^ 2));
            const f32x4 c0 = *(const f32x4*)(rc + m * 16 + 8 * (c8 & 1)), c1 = *(const f32x4*)(rc + m * 16 + 8 * (c8 & 1) + 4), s0 = *(const f32x4*)(rs + m * 16 + 8 * (c8 & 1)), s1 = *(const f32x4*)(rs + m * 16 + 8 * (c8 & 1) + 4);
            const float cc[8] = {c0.x, c0.y, c0.z, c0.w, c1.x, c1.y, c1.z, c1.w}, sn[8] = {s0.x, s0.y, s0.z, s0.w, s1.x, s1.y, s1.z, s1.w};
            const unsigned xw[4] = {x.x, x.y, x.z, x.w}, yw[4] = {y.x, y.y, y.z, y.w}; unsigned ow[4];
            const float sg = (c8 < 2) ? -1.f : 1.f;
#pragma unroll
            for (int q = 0; q < 4; ++q) { const float x0 = __uint_as_float(xw[q] << 16), x1 = __uint_as_float(xw[q] & 0xffff0000u), y0 = __uint_as_float(yw[q] << 16), y1 = __uint_as_float(yw[q] & 0xffff0000u);
                ow[q] = cvtpk(x0 * cc[2 * q] + sg * y0 * sn[2 * q], x1 * cc[2 * q + 1] + sg * y1 * sn[2 * q + 1]); }
            x = (v4u){ow[0], ow[1], ow[2], ow[3]}; }
        const int b = m / S, s = m % S;
        *(v4u*)((bf16*)(a->ws + (ten ? WS_KWR : WS_KSR)) + (((size_t)(b * 2 + g) * S + s) * 128 + 8 * c8)) = x;
    }
    const int gw = F.vb * 8 + F.wave, NGW = F.G * 8;
    for (int it = gw; it < 2 * NB * 2 * 32; it += NGW) {
        const int kb = it & 31, g = (it >> 5) & 1, b = (it >> 6) & 3, ten = it >> 8;
        const bf16* src = proj + (size_t)(b * S + 64 * kb) * NPROJ + (ten ? C_VW : C_VS) + g * 128;
        bf16* dst = (bf16*)(a->ws + (ten ? WS_VWT : WS_VST)) + ((size_t)(b * 2 + g) * 128) * S + 64 * kb;
#pragma unroll
        for (int hd = 0; hd < 2; ++hd) { const int d = F.lane + 64 * hd;
            unsigned w[32];
#pragma unroll
            for (int k2 = 0; k2 < 32; ++k2) { const unsigned lo = src[(size_t)(2 * k2) * NPROJ + d], hi = src[(size_t)(2 * k2 + 1) * NPROJ + d]; w[k2] = lo | (hi << 16); }
#pragma unroll
            for (int g16 = 0; g16 < 4; ++g16) { const unsigned* p = w + 8 * g16;
                *(v4u*)(dst + (size_t)d * S + 16 * g16) = (v4u){p[0], p[1], p[4], p[5]}; *(v4u*)(dst + (size_t)d * S + 16 * g16 + 8) = (v4u){p[2], p[3], p[6], p[7]}; }
        }
    }
}

struct AttnState { f32x16 o[4]; float m, l; };
struct NoHook { __device__ __forceinline__ void operator()(const f32x16 (&)[2], float) const {} };
template <int VS, class Mask, class Hook>
__device__ __forceinline__ void attn_tile(AttnState& st, const bf16x8 (&qf)[8], const LAS unsigned char* kt, const LAS unsigned char* vt, int l32, int hi, bool need_mask, const Mask& valid, const Hook& hook) {
    f32x16 p[2];
#pragma unroll
    for (int kb = 0; kb < 2; ++kb) {
#pragma unroll
        for (int r = 0; r < 16; ++r) p[kb][r] = 0.f;
#pragma unroll
        for (int ks = 0; ks < 8; ++ks) { const bf16x8 kf = *(const LAS bf16x8*)(kt + (32 * kb + l32) * AT_KS + 32 * ks + 16 * hi); p[kb] = MFMA32(kf, qf[ks], p[kb]); }
        __builtin_amdgcn_sched_barrier(0);
    }
    if (need_mask) {
#pragma unroll
        for (int kb = 0; kb < 2; ++kb)
#pragma unroll
            for (int r = 0; r < 16; ++r) { const int kl = 32 * kb + (r & 3) + 8 * (r >> 2) + 4 * hi; if (!valid(kl)) p[kb][r] = -__builtin_inff(); }
    }
    float mx = p[0][0];
#pragma unroll
    for (int r = 1; r < 16; ++r) mx = fmaxf(mx, p[0][r]);
#pragma unroll
    for (int r = 0; r < 16; ++r) mx = fmaxf(mx, p[1][r]);
    mx = fmaxf(mx, __shfl_xor(mx, 32));
    const float mn = fmaxf(st.m, mx);
    const float alpha = __builtin_amdgcn_exp2f((st.m - mn) * AT_C);
    st.m = mn;
    const float mo = -mn * AT_C;
    float rs = 0.f;
#pragma unroll
    for (int kb = 0; kb < 2; ++kb)
#pragma unroll
        for (int r = 0; r < 16; ++r) { p[kb][r] = __builtin_amdgcn_exp2f(fmaf(p[kb][r], AT_C, mo)); rs += p[kb][r]; }
    rs += __shfl_xor(rs, 32);
    st.l = st.l * alpha + rs;
    hook(p, alpha);
#pragma unroll
    for (int db = 0; db < 4; ++db)
#pragma unroll
        for (int r = 0; r < 16; ++r) st.o[db][r] *= alpha;
#pragma unroll
    for (int kq = 0; kq < 4; ++kq) {
        const int kb = kq >> 1, h8 = 8 * (kq & 1);
        const v4u pw = (v4u){cvtpk(p[kb][h8], p[kb][h8 + 1]), cvtpk(p[kb][h8 + 2], p[kb][h8 + 3]), cvtpk(p[kb][h8 + 4], p[kb][h8 + 5]), cvtpk(p[kb][h8 + 6], p[kb][h8 + 7])};
        const bf16x8 pf = __builtin_bit_cast(bf16x8, pw);
#pragma unroll
        for (int db = 0; db < 4; ++db) { const bf16x8 vf = *(const LAS bf16x8*)(vt + (32 * db + l32) * VS + 32 * kq + 16 * hi); st.o[db] = MFMA32(vf, pf, st.o[db]); }
        __builtin_amdgcn_sched_barrier(0);
    }
}
struct TileRegs { v4u k[2], v[2]; };
__device__ __forceinline__ void tile_load(TileRegs& tr, const bf16* kg, const bf16* vg, int tid) {
#pragma unroll
    for (int u = 0; u < 2; ++u) { const int i = tid + 512 * u; tr.k[u] = *(const v4u*)(kg + (size_t)(i >> 4) * 128 + 8 * (i & 15)); tr.v[u] = *(const v4u*)(vg + (size_t)(i >> 3) * S + 8 * (i & 7)); }
}
__device__ __forceinline__ void tile_store(const TileRegs& tr, LAS unsigned char* kt, LAS unsigned char* vt, int tid) {
#pragma unroll
    for (int u = 0; u < 2; ++u) { const int i = tid + 512 * u; *(LAS v4u*)(kt + (i >> 4) * AT_KS + 16 * (i & 15)) = tr.k[u]; *(LAS v4u*)(vt + (i >> 3) * AT_VS + 16 * (i & 7)) = tr.v[u]; }
}
__device__ __forceinline__ void load_q(bf16x8 (&qf)[8], const bf16* qrow, int hi) {
#pragma unroll
    for (int ks = 0; ks < 8; ++ks) qf[ks] = *(const bf16x8*)(qrow + 16 * ks + 8 * hi);
}
__device__ __forceinline__ void rope_q(bf16x8 (&qf)[8], const float* rc, const float* rs, int hi) {
    const f32x4 c0 = *(const f32x4*)(rc + 8 * hi), c1 = *(const f32x4*)(rc + 8 * hi + 4), s0 = *(const f32x4*)(rs + 8 * hi), s1 = *(const f32x4*)(rs + 8 * hi + 4);
    const float cc[8] = {c0.x, c0.y, c0.z, c0.w, c1.x, c1.y, c1.z, c1.w}, sn[8] = {s0.x, s0.y, s0.z, s0.w, s1.x, s1.y, s1.z, s1.w};
    const v4u a = __builtin_bit_cast(v4u, qf[0]), b = __builtin_bit_cast(v4u, qf[1]);
    const unsigned aw[4] = {a.x, a.y, a.z, a.w}, bw[4] = {b.x, b.y, b.z, b.w}; unsigned oa[4], ob[4];
#pragma unroll
    for (int q = 0; q < 4; ++q) { const float a0 = __uint_as_float(aw[q] << 16), a1 = __uint_as_float(aw[q] & 0xffff0000u), b0 = __uint_as_float(bw[q] << 16), b1 = __uint_as_float(bw[q] & 0xffff0000u);
        oa[q] = cvtpk(a0 * cc[2 * q] - b0 * sn[2 * q], a1 * cc[2 * q + 1] - b1 * sn[2 * q + 1]);
        ob[q] = cvtpk(b0 * cc[2 * q] + a0 * sn[2 * q], b1 * cc[2 * q + 1] + a1 * sn[2 * q + 1]); }
    qf[0] = __builtin_bit_cast(bf16x8, (v4u){oa[0], oa[1], oa[2], oa[3]}); qf[1] = __builtin_bit_cast(bf16x8, (v4u){ob[0], ob[1], ob[2], ob[3]});
}

__device__ __forceinline__ void attn_cmp_sel(KA a, Frame& F) {
#define WSF(off) (({ KA _p = (KA)__builtin_amdgcn_kernarg_segment_ptr(); asm volatile("" : "+s"(_p)); _p; })->ws + (off))
    const int hh = F.wave >> 1, qh = F.wave & 1;
    for (int item = F.vb; item < NB * 2 * 32; item += F.G) {
        int tidl = F.tid; asm volatile("" : "+v"(tidl));
        int l32 = tidl & 31, hi = (tidl >> 5) & 1;
        const int qb = item >> 3, g = item & 1, b = (item >> 1) & 3, head = g * 4 + hh;
        const int sq = 64 * qb + 32 * qh + l32, m = b * S + sq;
        bf16x8 qf[8];
        load_q(qf, (const bf16*)WSF(WS_PROJ) + (size_t)m * NPROJ + C_Q + head * 128, hi);
        __syncthreads();
        { const bf16* kg = (const bf16*)WSF(WS_KCB) + (size_t)(b * 2 + g) * 128 * 128; const bf16* vg = (const bf16*)WSF(WS_VCT) + (size_t)(b * 2 + g) * 128 * 128;
#pragma unroll
          for (int u = 0; u < 4; ++u) { const int i = tidl + 512 * u; const int row = i >> 4, ch = i & 15;
              *(LAS v4u*)(F.lds + AL_KC + row * AT_KS + 16 * ch) = *(const v4u*)(kg + (size_t)row * 128 + 8 * ch);
              *(LAS v4u*)(F.lds + AL_VC + row * AT_KS + 16 * ch) = *(const v4u*)(vg + (size_t)row * 128 + 8 * ch); }
          if (tidl < 64) *(LAS unsigned*)(F.lds + AL_SEL + 4 * tidl) = 0u; }
        __syncthreads();
        const int nv = sq >= 31 ? (sq - 31) / 16 + 1 : 0;
        AttnState st;
#pragma unroll
        for (int db = 0; db < 4; ++db)
#pragma unroll
            for (int r = 0; r < 16; ++r) st.o[db][r] = 0.f;
        st.m = -1e30f; st.l = 0.f;
        float prev = 0.f, alpha1 = 1.f;
        LAS float* imph = (LAS float*)(F.lds + AL_IMPH) + (hh * 64 + 32 * qh + l32) * 32;
#pragma unroll
        for (int stp = 0; stp < 2; ++stp) {
            attn_tile<AT_KS>(st, qf, F.lds + AL_KC + 64 * stp * AT_KS, F.lds + AL_VC + 128 * stp, l32, hi, true, [&](int kl) { return 64 * stp + kl < nv; },
                [&](const f32x16 (&p)[2], float alpha) {
                    if (stp == 1) alpha1 = alpha;
                    prev *= alpha;
#pragma unroll
                    for (int kb = 0; kb < 2; ++kb)
#pragma unroll
                        for (int q = 0; q < 4; ++q) {
                            const float bk = 0.5f * p[kb][4 * q + 3];
                            const float ak = p[kb][4 * q] + p[kb][4 * q + 1] + p[kb][4 * q + 2] + bk;
                            const float ob = __shfl_xor(bk, 32);
                            imph[16 * stp + 8 * kb + 2 * q + hi] = ak + (hi ? ob : prev);
                            prev = ob;
                        }
                });
        }
        const float inv = 1.0f / fmaxf(st.l, 1e-30f);
        if (hi == 0) { LAS float* fsc = (LAS float*)(F.lds + AL_FSC) + (hh * 64 + 32 * qh + l32) * 2; fsc[0] = alpha1 * inv; fsc[1] = inv; }
        const bf16* gl = (const bf16*)WSF(WS_PROJ) + (size_t)m * NPROJ + C_GL + head * 3;
        const float g1 = sigmoidf_(bf2f(gl[1]));
        const float g0 = sigmoidf_(bf2f(gl[0])) * inv;
        { float* op = (float*)WSF(WS_OACC) + (size_t)m * 1024 + head * 128 + 4 * hi;
#pragma unroll
          for (int db = 0; db < 4; ++db)
#pragma unroll
              for (int q = 0; q < 4; ++q) *(f32x4*)(op + 32 * db + 8 * q) = (f32x4){g0 * st.o[db][4 * q], g0 * st.o[db][4 * q + 1], g0 * st.o[db][4 * q + 2], g0 * st.o[db][4 * q + 3]}; }
        unsigned mymask;
        if (qb < 16) { mymask = (2u << qb) - 1u; __syncthreads(); }
        else {
            __syncthreads();
            LAS float* imph = (LAS float*)(F.lds + AL_IMPH); LAS float* imps = (LAS float*)(F.lds + AL_IMPS); LAS unsigned* selw = (LAS unsigned*)(F.lds + AL_SEL); LAS float* fsc = (LAS float*)(F.lds + AL_FSC);
            int tids = F.tid; asm volatile("" : "+v"(tids)); const int qq = tids >> 3, part = tids & 7;
#pragma unroll
            for (int u = 0; u < 4; ++u) { const int j = 4 * part + u;
                const int sc = j >> 4;
                const float v = ((imph[(0 * 64 + qq) * 32 + j] * fsc[(0 * 64 + qq) * 2 + sc] + imph[(1 * 64 + qq) * 32 + j] * fsc[(1 * 64 + qq) * 2 + sc]) + imph[(2 * 64 + qq) * 32 + j] * fsc[(2 * 64 + qq) * 2 + sc]) + imph[(3 * 64 + qq) * 32 + j] * fsc[(3 * 64 + qq) * 2 + sc];
                const bool forced = (j == 0) || (j == qb) || (j + 1 == qb);
                imps[qq * 32 + j] = forced ? __builtin_inff() : (j <= qb ? v : -__builtin_inff()); }
            __syncthreads();
            unsigned bits = 0u;
#pragma unroll
            for (int u = 0; u < 4; ++u) { const int j = 4 * part + u; const float sj = imps[qq * 32 + j]; int rank = 0;
#pragma unroll 8
                for (int k = 0; k < 32; ++k) { const float o = imps[qq * 32 + k]; rank += (o > sj || (o == sj && k < j)) ? 1 : 0; }
                if (rank < 16 && j <= qb) bits |= 1u << j; }
            if (bits) __hip_atomic_fetch_or(selw + qq, bits, __ATOMIC_RELAXED, __HIP_MEMORY_SCOPE_WORKGROUP);
            __syncthreads();
            mymask = selw[32 * qh + l32];
        }
        unsigned anym = mymask;
        if (qb >= 16) { LAS unsigned* selw = (LAS unsigned*)(F.lds + AL_SEL); anym = 0u;
#pragma unroll 8
            for (int k = 0; k < 64; ++k) anym |= selw[k]; }
        anym = __builtin_amdgcn_readfirstlane(anym);
        { int t2 = F.tid; asm volatile("" : "+v"(t2)); tidl = t2; l32 = t2 & 31; hi = (t2 >> 5) & 1; }
        load_q(qf, (const bf16*)WSF(WS_PROJ) + (size_t)m * NPROJ + C_Q + head * 128, hi);
        rope_q(qf, (const float*)WSF(WS_MISC + MS_ROPEC) + (size_t)m * 16, (const float*)WSF(WS_MISC + MS_ROPES) + (size_t)m * 16, hi);
#pragma unroll
        for (int db = 0; db < 4; ++db)
#pragma unroll
            for (int r = 0; r < 16; ++r) st.o[db][r] = 0.f;
        st.m = -1e30f; st.l = 0.f;
        const bf16* kg = (const bf16*)WSF(WS_KSR) + (size_t)(b * 2 + g) * S * 128; const bf16* vg = (const bf16*)WSF(WS_VST) + (size_t)(b * 2 + g) * 128 * S;
        __syncthreads();
        TileRegs tr; int buf = 0;
        int j = 0;
        tile_load(tr, kg, vg, tidl); tile_store(tr, F.lds + AL_K0, F.lds + AL_V0, tidl);
        __syncthreads();
        while (j <= qb) {
            int jn = j + 1; while (jn <= qb && !((anym >> jn) & 1u)) ++jn;
            if (jn <= qb) tile_load(tr, kg + (size_t)jn * 64 * 128, vg + 64 * jn, tidl);
            const bool selj = (mymask >> j) & 1u; const int sl = 32 * qh + l32;
            const bool nm = (j == qb) || !__all(selj);
            attn_tile<AT_VS>(st, qf, F.lds + (buf ? AL_K1 : AL_K0), F.lds + (buf ? AL_V1 : AL_V0), l32, hi, nm, [&](int kl) { return selj && (j < qb || kl <= sl); }, NoHook());
            if (jn <= qb) tile_store(tr, F.lds + (buf ? AL_K0 : AL_K1), F.lds + (buf ? AL_V0 : AL_V1), tidl);
            __syncthreads();
            buf ^= 1; j = jn;
        }
        const float il = g1 / st.l;
        asm volatile("s_waitcnt vmcnt(0)" ::: "memory");
        float* op = (float*)WSF(WS_OACC) + (size_t)m * 1024 + head * 128 + 4 * hi;
#pragma unroll
        for (int db = 0; db < 4; ++db)
#pragma unroll
            for (int q = 0; q < 4; ++q) { const f32x4 base = *(const f32x4*)(op + 32 * db + 8 * q);
                *(f32x4*)(op + 32 * db + 8 * q) = (f32x4){base.x + il * st.o[db][4 * q], base.y + il * st.o[db][4 * q + 1], base.z + il * st.o[db][4 * q + 2], base.w + il * st.o[db][4 * q + 3]}; }
    }
    __syncthreads();
}

__device__ __forceinline__ void attn_win(KA a, Frame& F) {
    const bf16* proj = (const bf16*)(a->ws + WS_PROJ); const float* oacc = (const float*)(a->ws + WS_OACC); bf16* omix = (bf16*)(a->ws + WS_OMIX);
    const bf16* kwr = (const bf16*)(a->ws + WS_KWR); const bf16* vwt = (const bf16*)(a->ws + WS_VWT);
    const float* rc = (const float*)(a->ws + WS_MISC + MS_ROPEC); const float* rs = (const float*)(a->ws + WS_MISC + MS_ROPES);
    const int hh = F.wave >> 1, qh = F.wave & 1;
    for (int item = F.vb; item < NB * 2 * 32; item += F.G) {
        int tidl = F.tid; asm volatile("" : "+v"(tidl)); const int l32 = tidl & 31, hi = (tidl >> 5) & 1;
        const int qb = item >> 3, g = item & 1, b = (item >> 1) & 3, head = g * 4 + hh;
        const int sl = 32 * qh + l32, sq = 64 * qb + sl, m = b * S + sq;
        bf16x8 qf[8];
        load_q(qf, proj + (size_t)m * NPROJ + C_Q + head * 128, hi);
        rope_q(qf, rc + (size_t)m * 16, rs + (size_t)m * 16, hi);
        AttnState st;
#pragma unroll
        for (int db = 0; db < 4; ++db)
#pragma unroll
            for (int r = 0; r < 16; ++r) st.o[db][r] = 0.f;
        st.m = -1e30f; st.l = 0.f;
        const bf16* kg = kwr + (size_t)(b * 2 + g) * S * 128; const bf16* vg = vwt + (size_t)(b * 2 + g) * 128 * S;
        const int j0 = qb >= 8 ? qb - 8 : 0;
        TileRegs tr; int buf = 0;
        __syncthreads();
        tile_load(tr, kg + (size_t)j0 * 64 * 128, vg + 64 * j0, tidl); tile_store(tr, F.lds + AL_K0, F.lds + AL_V0, tidl);
        __syncthreads();
        for (int j = j0; j <= qb; ++j) {
            if (j < qb) tile_load(tr, kg + (size_t)(j + 1) * 64 * 128, vg + 64 * (j + 1), tidl);
            const int rel = 64 * (qb - j) + sl;
            const bool nm = (j == qb) || (j + 8 <= qb);
            attn_tile<AT_VS>(st, qf, F.lds + (buf ? AL_K1 : AL_K0), F.lds + (buf ? AL_V1 : AL_V0), l32, hi, nm, [&](int kl) { return (unsigned)(rel - kl) < 512u; }, NoHook());
            if (j < qb) tile_store(tr, F.lds + (buf ? AL_K0 : AL_K1), F.lds + (buf ? AL_V0 : AL_V1), tidl);
            __syncthreads();
            buf ^= 1;
        }
        const float g2 = sigmoidf_(bf2f(proj[(size_t)m * NPROJ + C_GL + head * 3 + 2]));
        const float il = g2 / st.l;
        const float* ip = oacc + (size_t)m * 1024 + head * 128 + 4 * hi; bf16* op = omix + (size_t)m * D + head * 128 + 4 * hi;
#pragma unroll
        for (int db = 0; db < 4; ++db)
#pragma unroll
            for (int q = 0; q < 4; ++q) { const f32x4 base = *(const f32x4*)(ip + 32 * db + 8 * q);
                *(v2u*)(op + 32 * db + 8 * q) = (v2u){cvtpk(base.x + il * st.o[db][4 * q], base.y + il * st.o[db][4 * q + 1]), cvtpk(base.z + il * st.o[db][4 * q + 2], base.w + il * st.o[db][4 * q + 3])}; }
    }
    __syncthreads();
}

#define MFMA16(a, b, c) __builtin_amdgcn_mfma_f32_16x16x32_bf16((a), (b), (c), 0, 0, 0)
constexpr int CM_HS = 528;
__device__ __forceinline__ void cmp_mlp(KA a, Frame& F, int l) {
    for (int item = F.vb; item < 128; item += F.G) {
        int tidl = F.tid; asm volatile("" : "+v"(tidl));
        const int r = tidl & 15, quad = (tidl >> 4) & 3, w = F.wave;
        const int nt = item & 7, g = (item >> 3) & 1, b = (item >> 4) & 3, kv = item >> 6, lk = l * 2 + kv;
        const bf16* arow = (const bf16*)(a->ws + WS_PROJ) + (size_t)(b * S + 16 * (16 * nt + r)) * NPROJ + (kv ? C_VC : C_KC) + g * 128 + 8 * quad;
        const int kh = w >> 2, cq = w & 3;
        const bf16* w1a = (const bf16*)(a->ws + WS_W1T) + ((size_t)lk * 256 + 64 * cq + r) * 4096 + 8 * quad + 2048 * kh;
        f32x4 acc[4];
#pragma unroll
        for (int n = 0; n < 4; ++n) acc[n] = (f32x4){0.f, 0.f, 0.f, 0.f};
#pragma unroll 8
        for (int ks = 0; ks < 64; ++ks) { const int kg = 64 * kh + ks;
            const bf16x8 af = *(const bf16x8*)(arow + (size_t)(kg >> 2) * NPROJ + 32 * (kg & 3));
#pragma unroll
            for (int n = 0; n < 4; ++n) acc[n] = MFMA16(af, *(const bf16x8*)(w1a + (size_t)n * 16 * 4096 + 32 * ks), acc[n]);
        }
        float bias[4] = {0.f, 0.f, 0.f, 0.f};
        if (kh == 0) { const float* bp = (const float*)(a->ws + WS_B1P) + lk * 256 + 64 * cq + r;
#pragma unroll 1
            for (int kc = 0; kc < 16; ++kc) {
#pragma unroll
                for (int n = 0; n < 4; ++n) bias[n] += bp[kc * 4 * 256 + 16 * n]; } }
        LAS float* part = (LAS float*)(F.lds + 16384);
        __syncthreads();
        if (kh == 1) {
#pragma unroll
            for (int n = 0; n < 4; ++n)
#pragma unroll
                for (int i = 0; i < 4; ++i) part[(4 * quad + i) * 256 + 64 * cq + 16 * n + r] = acc[n][i]; }
        __syncthreads();
        if (kh == 0) {
#pragma unroll
            for (int n = 0; n < 4; ++n)
#pragma unroll
                for (int i = 0; i < 4; ++i) { const int col = 64 * cq + 16 * n + r;
                    *(LAS bf16*)(F.lds + (4 * quad + i) * CM_HS + 2 * col) = (bf16)(cvtpk(gelu_tanh(acc[n][i] + part[(4 * quad + i) * 256 + col] + bias[n]), 0.f) & 0xffffu); } }
        __syncthreads();
        const bf16* w2r = (const bf16*)(a->ws + WS_W2T) + ((size_t)lk * 128 + 16 * w + r) * 256 + 8 * quad;
        f32x4 acc2 = (f32x4){0.f, 0.f, 0.f, 0.f};
#pragma unroll
        for (int ks = 0; ks < 8; ++ks) { const bf16x8 af = *(const LAS bf16x8*)(F.lds + r * CM_HS + 2 * (32 * ks + 8 * quad)); const bf16x8 bfr = *(const bf16x8*)(w2r + 32 * ks); acc2 = MFMA16(af, bfr, acc2); }
        const int j = 16 * w + r; const float b2 = ((const float*)a->in[kv ? I_CVB2 : I_CKB2])[l * 128 + j];
        float o[4];
#pragma unroll
        for (int i = 0; i < 4; ++i) { const int n = 16 * nt + 4 * quad + i; o[i] = (n == NCMP) ? 0.f : acc2[i] + b2; }
        if (kv == 0) { bf16* kc = (bf16*)(a->ws + WS_KCB) + ((size_t)(b * 2 + g) * 128 + 16 * nt + 4 * quad) * 128 + j;
#pragma unroll
            for (int i = 0; i < 4; ++i) kc[(size_t)i * 128] = (bf16)(cvtpk(o[i], 0.f) & 0xffffu); }
        else { const int pos = (quad == 1) ? 8 : (quad == 2 ? 4 : 4 * quad);
            *(v2u*)((bf16*)(a->ws + WS_VCT) + ((size_t)(b * 2 + g) * 128 + j) * 128 + 16 * nt + pos) = (v2u){cvtpk(o[0], o[1]), cvtpk(o[2], o[3])}; }
    }
    __syncthreads();
}

constexpr int TK_RS = 129;
constexpr int TL_SC = 0, TL_LIST = 2 * 32 * TK_RS * 4, TL_END = TL_LIST + 8 * 2048;
__device__ __forceinline__ unsigned fkey(float v) { const unsigned u = __float_as_uint(v); return (u & 0x80000000u) ? ~u : (u | 0x80000000u); }
__device__ __forceinline__ int lane_rank(unsigned long long m) { return (int)__builtin_amdgcn_mbcnt_hi((unsigned)(m >> 32), __builtin_amdgcn_mbcnt_lo((unsigned)m, 0u)); }
__device__ __forceinline__ void peer_topk2(KA a, Frame& F, int l) {
    const bf16* pq = (const bf16*)(a->ws + WS_PQ); int* eidx = (int*)(a->ws + WS_EIDX); float* egate = (float*)(a->ws + WS_EGATE);
    const bf16* pkb = (const bf16*)(a->ws + WS_PKB) + (size_t)l * 8 * 2 * 128 * 128;
    LAS float* sc = (LAS float*)(F.lds + TL_SC);
    LAS float* lv = (LAS float*)(F.lds + TL_LIST + F.wave * 2048);
    const int l32 = F.lane & 31, hi = F.lane >> 5, p = F.wave >> 2, kb = F.wave & 3;
    for (int item = F.vb; item < (T / 32) * 8; item += F.G) {
        const int h = item & 7, t0 = (item >> 3) * 32;
        { const bf16* kr = pkb + ((size_t)(h * 2 + p) * 128 + 32 * kb + l32) * 128 + 8 * hi; const bf16* qr = pq + (size_t)(t0 + l32) * D + h * 256 + p * 128 + 8 * hi;
          f32x16 c;
#pragma unroll
          for (int r = 0; r < 16; ++r) c[r] = 0.f;
#pragma unroll
          for (int ks = 0; ks < 8; ++ks) c = MFMA32(*(const bf16x8*)(kr + 16 * ks), *(const bf16x8*)(qr + 16 * ks), c);
          __syncthreads();
          LAS float* dst = sc + (p * 32 + l32) * TK_RS + 32 * kb + 4 * hi;
#pragma unroll
          for (int r = 0; r < 16; ++r) dst[(r & 3) + 8 * (r >> 2)] = c[r]; }
        __syncthreads();
        {
            float v0[8], v1[8]; unsigned u0[8], u1[8], pre[8];
#pragma unroll
            for (int x = 0; x < 8; ++x) { const int tl = 4 * F.wave + (x >> 1), pp = x & 1;
                v0[x] = sc[(pp * 32 + tl) * TK_RS + F.lane]; v1[x] = sc[(pp * 32 + tl) * TK_RS + 64 + F.lane]; u0[x] = fkey(v0[x]); u1[x] = fkey(v1[x]); pre[x] = 0u; }
#pragma unroll 1
            for (int bit = 31; bit >= 0; --bit) {
#pragma unroll
                for (int x = 0; x < 8; ++x) { const unsigned cand = pre[x] | (1u << bit);
                    const int cnt = __popcll(__ballot(u0[x] >= cand)) + __popcll(__ballot(u1[x] >= cand));
                    if (cnt >= 16) pre[x] = cand; }
            }
#pragma unroll
            for (int x = 0; x < 8; ++x) {
                LAS float* lvx = lv + (x >> 1) * 128 + (x & 1) * 16; LAS int* lix = (LAS int*)(lvx + 32);
                const unsigned long long g0 = __ballot(u0[x] > pre[x]), g1 = __ballot(u1[x] > pre[x]), e0 = __ballot(u0[x] == pre[x]), e1 = __ballot(u1[x] == pre[x]);
                const int need = 16 - (__popcll(g0) + __popcll(g1));
                const bool s0 = (u0[x] > pre[x]) || (u0[x] == pre[x] && lane_rank(e0) < need);
                const bool s1 = (u1[x] > pre[x]) || (u1[x] == pre[x] && __popcll(e0) + lane_rank(e1) < need);
                const unsigned long long m0 = __ballot(s0), m1 = __ballot(s1);
                if (s0) { const int pos = lane_rank(m0); lvx[pos] = v0[x]; lix[pos] = F.lane; }
                if (s1) { const int pos = __popcll(m0) + lane_rank(m1); lvx[pos] = v1[x]; lix[pos] = F.lane + 64; }
            }
        }
        asm volatile("s_waitcnt lgkmcnt(0)" ::: "memory");
        {
            float cv[4][4]; unsigned cu[4][4], pre[4];
#pragma unroll
            for (int tt = 0; tt < 4; ++tt) { LAS float* lvx = lv + tt * 128; const float s2 = lvx[16 + (F.lane & 15)]; pre[tt] = 0u;
#pragma unroll
                for (int r = 0; r < 4; ++r) { cv[tt][r] = lvx[(F.lane >> 4) + 4 * r] + s2; cu[tt][r] = fkey(cv[tt][r]); } }
#pragma unroll 1
            for (int bit = 31; bit >= 0; --bit) {
#pragma unroll
                for (int tt = 0; tt < 4; ++tt) { const unsigned cand = pre[tt] | (1u << bit);
                    const int cnt = (__popcll(__ballot(cu[tt][0] >= cand)) + __popcll(__ballot(cu[tt][1] >= cand))) + (__popcll(__ballot(cu[tt][2] >= cand)) + __popcll(__ballot(cu[tt][3] >= cand)));
                    if (cnt >= 16) pre[tt] = cand; }
            }
#pragma unroll
            for (int tt = 0; tt < 4; ++tt) {
                LAS float* fvx = lv + tt * 128 + 64; LAS int* fcx = (LAS int*)(fvx + 16);
                int ngt = 0;
#pragma unroll
                for (int r = 0; r < 4; ++r) ngt += __popcll(__ballot(cu[tt][r] > pre[tt]));
                const int need = 16 - ngt; int eqb = 0, selb = 0;
#pragma unroll
                for (int r = 0; r < 4; ++r) {
                    const unsigned long long er = __ballot(cu[tt][r] == pre[tt]);
                    const bool sr = (cu[tt][r] > pre[tt]) || (cu[tt][r] == pre[tt] && eqb + lane_rank(er) < need);
                    eqb += __popcll(er);
                    const unsigned long long mr = __ballot(sr);
                    if (sr) { const int pos = selb + lane_rank(mr); fvx[pos] = cv[tt][r]; fcx[pos] = F.lane + 64 * r; }
                    selb += __popcll(mr);
                }
            }
        }
        asm volatile("s_waitcnt lgkmcnt(0)" ::: "memory");
        {
            const int tt = F.lane >> 4, kk = F.lane & 15; LAS float* lvx = lv + tt * 128; LAS int* lix = (LAS int*)(lvx + 32);
            const float bs = lvx[64 + kk]; const int bc = ((LAS int*)(lvx + 80))[kk];
            float mx = bs;
#pragma unroll
            for (int o = 1; o < 16; o <<= 1) mx = fmaxf(mx, __shfl_xor(mx, o));
            const float e = __expf(bs - mx); float sum = e;
#pragma unroll
            for (int o = 1; o < 16; o <<= 1) sum += __shfl_xor(sum, o);
            const size_t o = (size_t)(t0 + 4 * F.wave + tt) * 128 + h * 16 + kk; eidx[o] = lix[bc >> 4] * 128 + lix[16 + (bc & 15)]; egate[o] = e / sum;
        }
        asm volatile("s_waitcnt lgkmcnt(0)" ::: "memory");
    }
    __syncthreads();
}

template <int CTRL, int ROWMASK>
__device__ __forceinline__ float dpp_add(float v) {
    return v + __builtin_bit_cast(float, __builtin_amdgcn_update_dpp(0, __builtin_bit_cast(int, v), CTRL, ROWMASK, 0xf, true)); }
__device__ __forceinline__ float wave_sum_dpp(float v) {
    v = dpp_add<0xB1, 0xf>(v); v = dpp_add<0x4E, 0xf>(v); v = dpp_add<0x141, 0xf>(v); v = dpp_add<0x140, 0xf>(v);
    v = dpp_add<0x142, 0xa>(v); v = dpp_add<0x143, 0xc>(v);
    return __builtin_bit_cast(float, __builtin_amdgcn_readlane(__builtin_bit_cast(int, v), 63));
}
struct G8 { v4u u[2], v[2]; };
__device__ __forceinline__ void g8_load(G8& g, const unsigned char* pu8, const unsigned char* pv8, int e, int lane) {
    const unsigned char* ur = pu8 + (size_t)e * 2048 + 16 * lane; const unsigned char* vr = pv8 + (size_t)e * 2048 + 16 * lane;
    g.u[0] = *(const v4u*)ur; g.u[1] = *(const v4u*)(ur + 1024); g.v[0] = *(const v4u*)vr; g.v[1] = *(const v4u*)(vr + 1024);
}
template <bool LAST>
__device__ __forceinline__ void peer_gather8(KA a, Frame& F, int l, const float* x1, float* xo, const float* gate2) {
    const bf16* hb = (const bf16*)(a->ws + WS_H); const int* eidx = (const int*)(a->ws + WS_EIDX); const float* egate = (const float*)(a->ws + WS_EGATE);
    const unsigned char* pu8 = a->ws + WS_PU + (size_t)l * 16384 * 2048; const unsigned char* pv8 = a->ws + WS_PV + (size_t)l * 16384 * 2048;
    const int gw = F.vb * 8 + F.wave, NGW = F.G * 8;
    for (int t = gw; t < T; t += NGW) {
        f32x2 xf[2][8];
#pragma unroll
        for (int j = 0; j < 2; ++j) { const v4u w0 = *(const v4u*)(hb + (size_t)t * D + 1024 * j + 16 * F.lane), w1 = *(const v4u*)(hb + (size_t)t * D + 1024 * j + 16 * F.lane + 8);
            const unsigned ww[8] = {w0.x, w0.y, w0.z, w0.w, w1.x, w1.y, w1.z, w1.w};
#pragma unroll
            for (int q = 0; q < 8; ++q) xf[j][q] = (f32x2){__uint_as_float(ww[q] << 16), __uint_as_float(ww[q] & 0xffff0000u)}; }
        f32x2 acc[2][8];
#pragma unroll
        for (int j = 0; j < 2; ++j)
#pragma unroll
            for (int q = 0; q < 8; ++q) acc[j][q] = (f32x2){0.f, 0.f};
        const int* ei = eidx + (size_t)t * 128; const float* eg = egate + (size_t)t * 128;
        G8 buf[4];
#pragma unroll
        for (int s = 0; s < 4; ++s) g8_load(buf[s], pu8, pv8, __builtin_amdgcn_readfirstlane(ei[s]), F.lane);
#pragma unroll 1
        for (int k = 0; k < 128; k += 4) {
#pragma unroll
            for (int s = 0; s < 4; ++s) {
                const float gk = __uint_as_float(__builtin_amdgcn_readfirstlane(__float_as_uint(eg[k + s])));
                f32x2 d2 = (f32x2){0.f, 0.f};
#pragma unroll
                for (int j = 0; j < 2; ++j) { const unsigned uw[4] = {buf[s].u[j].x, buf[s].u[j].y, buf[s].u[j].z, buf[s].u[j].w};
#pragma unroll
                    for (int q = 0; q < 4; ++q) { d2 += __builtin_amdgcn_cvt_pk_f32_fp8((int)uw[q], false) * xf[j][2 * q]; d2 += __builtin_amdgcn_cvt_pk_f32_fp8((int)uw[q], true) * xf[j][2 * q + 1]; } }
                const float dsum = wave_sum_dpp(d2.x + d2.y) * (1.0f / 64.0f);
                const float cf = gk * gelu_tanh(dsum);
#pragma unroll
                for (int j = 0; j < 2; ++j) { const unsigned vw[4] = {buf[s].v[j].x, buf[s].v[j].y, buf[s].v[j].z, buf[s].v[j].w};
#pragma unroll
                    for (int q = 0; q < 4; ++q) { acc[j][2 * q] += __builtin_amdgcn_cvt_pk_f32_fp8((int)vw[q], false) * cf; acc[j][2 * q + 1] += __builtin_amdgcn_cvt_pk_f32_fp8((int)vw[q], true) * cf; } }
                if (k + 4 < 128) g8_load(buf[s], pu8, pv8, __builtin_amdgcn_readfirstlane(ei[k + 4 + s]), F.lane);
            }
        }
        const int b = t / S; const float* g2 = gate2 + (size_t)b * 12288;
        f32x4 o[2][4]; float ss = 0.f;
#pragma unroll
        for (int j = 0; j < 2; ++j)
#pragma unroll
            for (int q4 = 0; q4 < 4; ++q4) { const int c = 1024 * j + 16 * F.lane + 4 * q4;
                const f32x4 xv = *(const f32x4*)(x1 + (size_t)t * D + c), gv = *(const f32x4*)(g2 + c);
                const f32x4 av = (f32x4){acc[j][2 * q4].x, acc[j][2 * q4].y, acc[j][2 * q4 + 1].x, acc[j][2 * q4 + 1].y};
                o[j][q4] = xv + gv * av; ss += o[j][q4].x * o[j][q4].x + o[j][q4].y * o[j][q4].y + o[j][q4].z * o[j][q4].z + o[j][q4].w * o[j][q4].w; }
        float r = 1.0f;
        if (LAST) r = rsqrtf(wave_sum(ss) * (1.0f / D) + EPS);
#pragma unroll
        for (int j = 0; j < 2; ++j)
#pragma unroll
            for (int q4 = 0; q4 < 4; ++q4) { const int c = 1024 * j + 16 * F.lane + 4 * q4;
                if (LAST) *(f32x4*)(xo + (size_t)t * D + c) = (o[j][q4] * r) * *(const f32x4*)((const float*)a->in[I_FNORM] + c);
                else *(f32x4*)(xo + (size_t)t * D + c) = o[j][q4]; }
    }
}

constexpr int GL_LIST = 0, GL_END = 8 * 2048;
struct Gx { f32x2 x[2][8]; };
__device__ __forceinline__ void gx_load(Gx& g, const bf16* hrow, int lane) {
#pragma unroll
    for (int j = 0; j < 2; ++j) { const v4u w0 = *(const v4u*)(hrow + 1024 * j + 16 * lane), w1 = *(const v4u*)(hrow + 1024 * j + 16 * lane + 8);
        const unsigned ww[8] = {w0.x, w0.y, w0.z, w0.w, w1.x, w1.y, w1.z, w1.w};
#pragma unroll
        for (int q = 0; q < 8; ++q) g.x[j][q] = (f32x2){__uint_as_float(ww[q] << 16), __uint_as_float(ww[q] & 0xffff0000u)}; }
}
__device__ __forceinline__ void g8_pair(const G8& b, const Gx& xv, f32x2 (&acc)[2][8], float gk) {
    f32x2 d2 = (f32x2){0.f, 0.f};
#pragma unroll
    for (int j = 0; j < 2; ++j) { const unsigned uw[4] = {b.u[j].x, b.u[j].y, b.u[j].z, b.u[j].w};
#pragma unroll
        for (int q = 0; q < 4; ++q) { d2 += __builtin_amdgcn_cvt_pk_f32_fp8((int)uw[q], false) * xv.x[j][2 * q]; d2 += __builtin_amdgcn_cvt_pk_f32_fp8((int)uw[q], true) * xv.x[j][2 * q + 1]; }
        __builtin_amdgcn_sched_barrier(0); }
    const float dsum = wave_sum_dpp(d2.x + d2.y) * (1.0f / 64.0f);
    const float cf = gk * gelu_tanh(dsum);
#pragma unroll
    for (int j = 0; j < 2; ++j) { const unsigned vw[4] = {b.v[j].x, b.v[j].y, b.v[j].z, b.v[j].w};
#pragma unroll
        for (int q = 0; q < 4; ++q) { acc[j][2 * q] += __builtin_amdgcn_cvt_pk_f32_fp8((int)vw[q], false) * cf; acc[j][2 * q + 1] += __builtin_amdgcn_cvt_pk_f32_fp8((int)vw[q], true) * cf; }
        __builtin_amdgcn_sched_barrier(0); }
}
template <bool LAST>
__device__ __forceinline__ void g8_epilogue(KA a, int t, const f32x2 (&acc)[2][8], const float* x1, float* xo, const float* gate2, int lane, int lnext = 0) {
    const int b = t / S; const float* g2 = gate2 + (size_t)b * 12288;
    f32x4 o[2][4]; float ss = 0.f;
#pragma unroll
    for (int j = 0; j < 2; ++j)
#pragma unroll
        for (int q4 = 0; q4 < 4; ++q4) { const int c = 1024 * j + 16 * lane + 4 * q4;
            const f32x4 xv = *(const f32x4*)(x1 + (size_t)t * D + c), gv = *(const f32x4*)(g2 + c);
            const f32x4 av = (f32x4){acc[j][2 * q4].x, acc[j][2 * q4].y, acc[j][2 * q4 + 1].x, acc[j][2 * q4 + 1].y};
            o[j][q4] = xv + gv * av; ss += o[j][q4].x * o[j][q4].x + o[j][q4].y * o[j][q4].y + o[j][q4].z * o[j][q4].z + o[j][q4].w * o[j][q4].w; }
    const float r = rsqrtf(wave_sum_dpp(ss) * (1.0f / D) + EPS);
    const float* gn = LAST ? (const float*)a->in[I_FNORM] : (const float*)a->in[I_NMIX] + (size_t)(lnext) * D;
    const float* mp = (const float*)(a->ws + WS_MOD) + ((size_t)lnext * 4 + b) * 12288;
    bf16* hrow = (bf16*)(a->ws + WS_H) + (size_t)t * D;
#pragma unroll
    for (int j = 0; j < 2; ++j)
#pragma unroll
        for (int q4 = 0; q4 < 4; ++q4) { const int c = 1024 * j + 16 * lane + 4 * q4;
            const f32x4 y = (o[j][q4] * r) * *(const f32x4*)(gn + c);
            if (LAST) *(f32x4*)(xo + (size_t)t * D + c) = y;
            else { *(f32x4*)(xo + (size_t)t * D + c) = o[j][q4];
                const f32x4 hv = y * (*(const f32x4*)(mp + 2048 + c) + 1.0f) + *(const f32x4*)(mp + c);
                *(v2u*)(hrow + c) = (v2u){cvtpk(hv.x, hv.y), cvtpk(hv.z, hv.w)}; } }
}
template <bool LAST>
__device__ __forceinline__ void peer_gather_sorted(KA a, Frame& F, int l, const float* x1, float* xo, const float* gate2) {
    const bf16* hb = (const bf16*)(a->ws + WS_H); const int* eidx = (const int*)(a->ws + WS_EIDX); const float* egate = (const float*)(a->ws + WS_EGATE);
    const unsigned char* pu8 = a->ws + WS_PU + (size_t)l * 16384 * 2048; const unsigned char* pv8 = a->ws + WS_PV + (size_t)l * 16384 * 2048;
    LAS unsigned* lst = (LAS unsigned*)(F.lds + GL_LIST + F.wave * 2048);
    const int gw = F.vb * 8 + F.wave, NGW = F.G * 8;
    for (int tp = gw; tp < T / 2; tp += NGW) {
        const int t0 = 2 * tp;
        unsigned ev[4]; unsigned gv[4];
#pragma unroll
        for (int r = 0; r < 4; ++r) { const size_t o = (size_t)(t0 + (r >> 1)) * 128 + 64 * (r & 1) + F.lane; ev[r] = (unsigned)eidx[o] | ((unsigned)(r >> 1) << 16); gv[r] = __float_as_uint(egate[o]); }
        int base = 0;
#pragma unroll 1
        for (int bk = 0; bk < 32; ++bk) {
#pragma unroll
            for (int r = 0; r < 4; ++r) { const bool in = ((ev[r] & 0xffffu) >> 9) == (unsigned)bk; const unsigned long long m = __ballot(in);
                if (in) { const int pos = base + lane_rank(m); lst[2 * pos] = ev[r]; lst[2 * pos + 1] = gv[r]; }
                base += __popcll(m); }
        }
        asm volatile("s_waitcnt lgkmcnt(0)" ::: "memory");
        Gx xc; unsigned curtok = __builtin_amdgcn_readfirstlane(lst[0]) >> 16;
        gx_load(xc, hb + (size_t)(t0 + curtok) * D, F.lane);
        f32x2 acca[2][8], accb[2][8];
#pragma unroll
        for (int j = 0; j < 2; ++j)
#pragma unroll
            for (int q = 0; q < 8; ++q) { acca[j][q] = (f32x2){0.f, 0.f}; accb[j][q] = (f32x2){0.f, 0.f}; }
        constexpr int NPF = 2;
        G8 buf[NPF];
#pragma unroll
        for (int s = 0; s < NPF; ++s) g8_load(buf[s], pu8, pv8, (int)(__builtin_amdgcn_readfirstlane(lst[2 * s]) & 0xffffu), F.lane);
#pragma unroll 1
        for (int k = 0; k < 256; k += NPF) {
            if ((k & 15) == 0) __syncthreads();
#pragma unroll
            for (int s = 0; s < NPF; ++s) {
                const unsigned ent = __builtin_amdgcn_readfirstlane(lst[2 * (k + s)]); const float gk = __uint_as_float(__builtin_amdgcn_readfirstlane(lst[2 * (k + s) + 1]));
                const unsigned tok = ent >> 16;
                if (tok != curtok) { curtok = tok; gx_load(xc, hb + (size_t)(t0 + tok) * D, F.lane); }
                if (tok) g8_pair(buf[s], xc, accb, gk); else g8_pair(buf[s], xc, acca, gk);
                if (k + NPF < 256) g8_load(buf[s], pu8, pv8, (int)(__builtin_amdgcn_readfirstlane(lst[2 * (k + NPF + s)]) & 0xffffu), F.lane);
            }
        }
        g8_epilogue<LAST>(a, t0, acca, x1, xo, gate2, F.lane);
        g8_epilogue<LAST>(a, t0 + 1, accb, x1, xo, gate2, F.lane);
    }
    __syncthreads();
}

constexpr int GR_SLOTS = 4, GR_SLOTB = 4096, GR_WAVEB = GR_SLOTS * GR_SLOTB, GR_LIST = 8 * GR_WAVEB;
static_assert(GR_LIST + 8 * 2048 <= MISC_OFF, "gather LDS map");
template <int N> __device__ __forceinline__ void wait_vm() { asm volatile("s_waitcnt vmcnt(%0)" :: "n"(N) : "memory"); }
__device__ __forceinline__ void gr_issue(LAS unsigned char* slot, const unsigned char* pu8, const unsigned char* pv8, int e, int lane) {
    const unsigned char* ur = pu8 + (size_t)e * 2048 + 16 * lane; const unsigned char* vr = pv8 + (size_t)e * 2048 + 16 * lane;
    __builtin_amdgcn_global_load_lds((const unsigned*)ur, (LAS unsigned*)slot, 16, 0, 0);
    __builtin_amdgcn_global_load_lds((const unsigned*)(ur + 1024), (LAS unsigned*)(slot + 1024), 16, 0, 0);
    __builtin_amdgcn_global_load_lds((const unsigned*)vr, (LAS unsigned*)(slot + 2048), 16, 0, 0);
    __builtin_amdgcn_global_load_lds((const unsigned*)(vr + 1024), (LAS unsigned*)(slot + 3072), 16, 0, 0);
}

typedef _Float16 h2 __attribute__((ext_vector_type(2)));
struct Gh { h2 x[2][8]; };
__device__ __forceinline__ void gh_load(Gh& g, const bf16* hrow, int lane) {
#pragma unroll
    for (int j = 0; j < 2; ++j) { const v4u w0 = *(const v4u*)(hrow + 1024 * j + 16 * lane), w1 = *(const v4u*)(hrow + 1024 * j + 16 * lane + 8);
        const unsigned ww[8] = {w0.x, w0.y, w0.z, w0.w, w1.x, w1.y, w1.z, w1.w};
#pragma unroll
        for (int q = 0; q < 8; ++q) g.x[j][q] = (h2){(_Float16)__uint_as_float(ww[q] << 16), (_Float16)__uint_as_float(ww[q] & 0xffff0000u)}; }
}
__device__ __forceinline__ void gh_pair(const G8& b, const Gh& xv, h2 (&acc)[2][8], float gk) {
    h2 d2 = (h2){(_Float16)0.f, (_Float16)0.f};
#pragma unroll
    for (int j = 0; j < 2; ++j) { const unsigned uw[4] = {b.u[j].x, b.u[j].y, b.u[j].z, b.u[j].w};
#pragma unroll
        for (int q = 0; q < 4; ++q) { d2 = __builtin_elementwise_fma(__builtin_bit_cast(h2, __builtin_amdgcn_cvt_scalef32_pk_f16_fp8(uw[q], 1.0f, false)), xv.x[j][2 * q], d2);
                                      d2 = __builtin_elementwise_fma(__builtin_bit_cast(h2, __builtin_amdgcn_cvt_scalef32_pk_f16_fp8(uw[q], 1.0f, true)), xv.x[j][2 * q + 1], d2); } }
    const float dsum = wave_sum_dpp((float)d2.x + (float)d2.y) * (1.0f / 64.0f);
    const float cf = gk * gelu_tanh(dsum);
    const h2 cfh = (h2){(_Float16)cf, (_Float16)cf};
#pragma unroll
    for (int j = 0; j < 2; ++j) { const unsigned vw[4] = {b.v[j].x, b.v[j].y, b.v[j].z, b.v[j].w};
#pragma unroll
        for (int q = 0; q < 4; ++q) { acc[j][2 * q] = __builtin_elementwise_fma(__builtin_bit_cast(h2, __builtin_amdgcn_cvt_scalef32_pk_f16_fp8(vw[q], 1.0f, false)), cfh, acc[j][2 * q]);
                                      acc[j][2 * q + 1] = __builtin_elementwise_fma(__builtin_bit_cast(h2, __builtin_amdgcn_cvt_scalef32_pk_f16_fp8(vw[q], 1.0f, true)), cfh, acc[j][2 * q + 1]); } }
}
template <bool LAST>
__device__ __forceinline__ void gh_epilogue(KA a, int t, const h2 (&acc)[2][8], const float* x1, float* xo, const float* gate2, int lane, int lnext) {
    f32x2 accf[2][8];
#pragma unroll
    for (int j = 0; j < 2; ++j)
#pragma unroll
        for (int q = 0; q < 8; ++q) accf[j][q] = (f32x2){(float)acc[j][q].x, (float)acc[j][q].y};
    g8_epilogue<LAST>(a, t, accf, x1, xo, gate2, lane, lnext);
}
template <bool LAST>
__device__ __forceinline__ void peer_gather_ring(KA a, Frame& F, int l, const float* x1, float* xo, const float* gate2) {
    const bf16* hb = (const bf16*)(a->ws + WS_H); const int* eidx = (const int*)(a->ws + WS_EIDX); const float* egate = (const float*)(a->ws + WS_EGATE);
    const unsigned char* pu8 = a->ws + WS_PU + (size_t)l * 16384 * 2048; const unsigned char* pv8 = a->ws + WS_PV + (size_t)l * 16384 * 2048;
    LAS unsigned* lst = (LAS unsigned*)(F.lds + GR_LIST + F.wave * 2048);
    LAS unsigned char* ring = F.lds + F.wave * GR_WAVEB;
    const int gw = F.vb * 8 + F.wave, NGW = F.G * 8;
    for (int tq4 = gw; tq4 < T / 4; tq4 += NGW) {
        const int t0 = 4 * tq4;
        unsigned ev[8];
#pragma unroll
        for (int r = 0; r < 8; ++r) { const size_t o = (size_t)(t0 + (r >> 1)) * 128 + 64 * (r & 1) + F.lane;
            const _Float16 gh = (_Float16)egate[o]; ev[r] = (unsigned)eidx[o] | ((unsigned)(r >> 1) << 14) | ((unsigned)__builtin_bit_cast(unsigned short, gh) << 16); }
        int base = 0;
#pragma unroll 1
        for (int bk = 0; bk < 32; ++bk) {
#pragma unroll
            for (int r = 0; r < 8; ++r) { const bool in = ((ev[r] & 0x3fffu) >> 9) == (unsigned)bk; const unsigned long long m = __ballot(in);
                if (in) lst[base + lane_rank(m)] = ev[r];
                base += __popcll(m); }
        }
        Gh x0, x1r, x2, x3;
        gh_load(x0, hb + (size_t)t0 * D, F.lane); gh_load(x1r, hb + (size_t)(t0 + 1) * D, F.lane); gh_load(x2, hb + (size_t)(t0 + 2) * D, F.lane); gh_load(x3, hb + (size_t)(t0 + 3) * D, F.lane);
        asm volatile("s_waitcnt vmcnt(0) lgkmcnt(0)" ::: "memory");
        h2 ac0[2][8], ac1[2][8], ac2[2][8], ac3[2][8];
#pragma unroll
        for (int j = 0; j < 2; ++j)
#pragma unroll
            for (int q = 0; q < 8; ++q) { const h2 z = (h2){(_Float16)0.f, (_Float16)0.f}; ac0[j][q] = z; ac1[j][q] = z; ac2[j][q] = z; ac3[j][q] = z; }
#pragma unroll
        for (int s = 0; s < GR_SLOTS; ++s) gr_issue(ring + s * GR_SLOTB, pu8, pv8, (int)(__builtin_amdgcn_readfirstlane(lst[s]) & 0x3fffu), F.lane);
#define GR_STEP(XV, ACC) do { \
            if ((k & 15) == 0) asm volatile("s_barrier" ::: "memory");     \
            const float gk = (float)__builtin_bit_cast(_Float16, (unsigned short)(ent >> 16)); \
            if (k + GR_SLOTS <= 512) wait_vm<4 * (GR_SLOTS - 1)>(); else wait_vm<0>();         \
            G8 b_; const LAS unsigned char* sp = ring + (k & (GR_SLOTS - 1)) * GR_SLOTB + 16 * F.lane; \
            b_.u[0] = *(const LAS v4u*)sp; b_.u[1] = *(const LAS v4u*)(sp + 1024); b_.v[0] = *(const LAS v4u*)(sp + 2048); b_.v[1] = *(const LAS v4u*)(sp + 3072); \
            asm volatile("s_waitcnt lgkmcnt(0)" ::: "memory");            \
            if (k + GR_SLOTS < 512) gr_issue(ring + (k & (GR_SLOTS - 1)) * GR_SLOTB, pu8, pv8, (int)(__builtin_amdgcn_readfirstlane(lst[k + GR_SLOTS]) & 0x3fffu), F.lane); \
            gh_pair(b_, XV, ACC, gk); \
            ++k; ent = (k < 512) ? __builtin_amdgcn_readfirstlane(lst[k]) : 0xffffu; } while (0)
        int k = 0; unsigned ent = __builtin_amdgcn_readfirstlane(lst[0]);
#pragma unroll 1
        while (k < 512) {
#pragma unroll 1
            while (((ent >> 14) & 3u) == 0u && k < 512) GR_STEP(x0, ac0);
#pragma unroll 1
            while (((ent >> 14) & 3u) == 1u && k < 512) GR_STEP(x1r, ac1);
#pragma unroll 1
            while (((ent >> 14) & 3u) == 2u && k < 512) GR_STEP(x2, ac2);
#pragma unroll 1
            while (((ent >> 14) & 3u) == 3u && k < 512) GR_STEP(x3, ac3);
        }
#undef GR_STEP
        gh_epilogue<LAST>(a, t0, ac0, x1, xo, gate2, F.lane, l + 1);
        gh_epilogue<LAST>(a, t0 + 1, ac1, x1, xo, gate2, F.lane, l + 1);
        gh_epilogue<LAST>(a, t0 + 2, ac2, x1, xo, gate2, F.lane, l + 1);
        gh_epilogue<LAST>(a, t0 + 3, ac3, x1, xo, gate2, F.lane, l + 1);
    }
    asm volatile("s_waitcnt vmcnt(0)" ::: "memory");
    __syncthreads();
}

#ifndef PROBE_FN
#define PROBE_FN 0
#endif
#ifdef SKIP0
#define SK0(...)
#else
#define SK0(...) __VA_ARGS__
#endif
#ifdef SKIP1
#define SK1(...)
#else
#define SK1(...) __VA_ARGS__
#endif
#ifdef SKIP2
#define SK2(...)
#else
#define SK2(...) __VA_ARGS__
#endif
#ifdef SKIP3
#define SK3(...)
#else
#define SK3(...) __VA_ARGS__
#endif
#ifdef SKIP4
#define SK4(...)
#else
#define SK4(...) __VA_ARGS__
#endif
#ifdef SKIP5
#define SK5(...)
#else
#define SK5(...) __VA_ARGS__
#endif
#ifdef SKIP6
#define SK6(...)
#else
#define SK6(...) __VA_ARGS__
#endif

constexpr int NKIND = 12;
#define FRESH() ({ KA _p = (KA)__builtin_amdgcn_kernarg_segment_ptr(); asm volatile("" : "+s"(_p)); _p; })
template <int KIND>
__device__ __forceinline__ void run_phase(Frame& F, unsigned char* ws, const int l) {
    float* mod = (float*)(ws + WS_MOD);
    bf16* Hb = (bf16*)(ws + WS_H); bf16* proj = (bf16*)(ws + WS_PROJ); bf16* omix = (bf16*)(ws + WS_OMIX); bf16* pq = (bf16*)(ws + WS_PQ);
    float* XA = (float*)(ws + WS_XA); float* XB = (float*)(ws + WS_XB);
    const float* mod_l = mod + (size_t)l * 4 * 12288;
    if constexpr (KIND == 0) { SK0(p0_prologue(FRESH(), F);) }
    if constexpr (KIND == 1) { if (l == 0) norm_phase<true>(F, ws, (const float*)FRESH()->in[I_X], (const float*)FRESH()->in[I_NMIX], 0, 0, 2048, Hb); }
    if constexpr (KIND == 2) {
        pg8::Gemm g{Hb, (const bf16*)(ws + WS_WINT) + (size_t)l * NPROJ * D, T, NPROJ, D}; pg8::StaticOrder So; So.init(T, NPROJ, F.G, (int)blockIdx.x);
        pg8::EpiStoreBf16 E{proj, NPROJ};
        pg8::gemm_phase<pg8::EpiStoreBf16, pg8::StaticOrder, PG8_ALIGN, PG8_SP2>(F.lds, g, So, E);
    }
    if constexpr (KIND == 3) { SK3(attn_prep(FRESH(), F);) SK1(cmp_mlp(FRESH(), F, l);) SK2(hgrn_local(FRESH(), F, l);)
        if (F.G == 256) { if (F.vb >= 128) peer_convert(FRESH(), l, (F.vb - 128) * (PC_U3 / 128), (F.vb - 127) * (PC_U3 / 128), F.wave, F.lane); }
        else { const int per = (PC_U3 + F.G - 1) / F.G; const int u0 = F.vb * per; peer_convert(FRESH(), l, u0 < PC_U3 ? u0 : PC_U3, u0 + per < PC_U3 ? u0 + per : PC_U3, F.wave, F.lane); }
#if PROBE_FN == 31
        __syncthreads(); attn_prep(FRESH(), F);
#elif PROBE_FN == 32
        __syncthreads(); cmp_mlp(FRESH(), F, l);
#elif PROBE_FN == 33
        __syncthreads(); hgrn_local(FRESH(), F, l);
#endif
    }
    if constexpr (KIND == 4) { }
    if constexpr (KIND == 5) { SK2(hgrn_scan(FRESH(), F);) SK3(attn_cmp_sel(FRESH(), F);)
        if (F.G == 256) {
            const int qb = F.vb >> 3, bg = F.vb & 7;
            if (qb < 16) { const int wst = 8 * (16 * qb - qb * (qb - 1) / 2) + bg * (16 - qb); const int u0 = PC_U3 + 42 * wst, u1 = u0 + 42 * (16 - qb);
                peer_convert(FRESH(), l, u0 < PC_UNITS ? u0 : PC_UNITS, u1 < PC_UNITS ? u1 : PC_UNITS, F.wave, F.lane); } }
        else { const int per = (PC_UNITS - PC_U3 + F.G - 1) / F.G; const int u0 = PC_U3 + F.vb * per; peer_convert(FRESH(), l, u0 < PC_UNITS ? u0 : PC_UNITS, u0 + per < PC_UNITS ? u0 + per : PC_UNITS, F.wave, F.lane); }
#if PROBE_FN == 51
        __syncthreads(); hgrn_scan(FRESH(), F);
#elif PROBE_FN == 52
        __syncthreads(); attn_cmp_sel(FRESH(), F);
#endif
    }
    if constexpr (KIND == 6) { SK4(attn_win(FRESH(), F);) SK2(hgrn_out(FRESH(), F, l);)
#if PROBE_FN == 61
        __syncthreads(); attn_win(FRESH(), F);
#elif PROBE_FN == 62
        __syncthreads(); hgrn_out(FRESH(), F, l);
#endif
    }
    if constexpr (KIND == 7) {
        pg8::Gemm g{omix, (const bf16*)(ws + WS_WOUTT) + (size_t)l * D * D, T, D, D}; pg8::StaticOrder So; So.init(T, D, F.G, (int)blockIdx.x);
        pg8::EpiResGate E{(l == 0) ? (const float*)FRESH()->in[I_X] : XB, XA, D, mod_l + 2 * 2048, 12288, S};
        pg8::gemm_phase<pg8::EpiResGate, pg8::StaticOrder, PG8_ALIGN, PG8_SP2>(F.lds, g, So, E);
    }
    if constexpr (KIND == 8) norm_phase<false>(F, ws, XA, (const float*)FRESH()->in[I_NFFN] + l * D, l, 3 * 2048, 4 * 2048, Hb);
    if constexpr (KIND == 9) {
        pg8::Gemm g{Hb, (const bf16*)(ws + WS_WQT) + (size_t)l * D * D, T, D, D}; pg8::StaticOrder So; So.init(T, D, F.G, (int)blockIdx.x);
        pg8::EpiStoreBf16 E{pq, D};
        pg8::gemm_phase<pg8::EpiStoreBf16, pg8::StaticOrder, PG8_ALIGN, PG8_SP2>(F.lds, g, So, E);
    }
    if constexpr (KIND == 10) { SK5(peer_topk2(FRESH(), F, l);) }
    if constexpr (KIND == 11) {
        SK6(if (l == DEPTH - 1) peer_gather_ring<true>(FRESH(), F, l, XA, FRESH()->out, mod_l + 5 * 2048);
        else peer_gather_ring<false>(FRESH(), F, l, XA, XB, mod_l + 5 * 2048);)
    }
}
__device__ __forceinline__ void frame_init(Frame& F, unsigned char* lds_raw) {
    F.lds = (LAS unsigned char*)lds_raw;
    { int t_ = threadIdx.x; asm volatile("" : "+v"(t_)); F.tid = t_; } F.lane = F.tid & 63; F.wave = __builtin_amdgcn_readfirstlane(F.tid >> 6);
    { int gx = gridDim.x, bx = blockIdx.x; asm volatile("" : "+s"(gx), "+s"(bx));
      F.G = gx; F.vb = (gx % 8 == 0) ? (bx % 8) * (gx / 8) + bx / 8 : bx; }
}
#if !MK_ONE_LAUNCH
template <int KIND>
__global__ void __launch_bounds__(512, 2) k_phase(Args a) {
    extern __shared__ __attribute__((aligned(16))) unsigned char lds_raw[];
    Frame F; frame_init(F, lds_raw);
    run_phase<KIND>(F, a.ws, a.layer);
}
#else
extern __shared__ __attribute__((aligned(16))) unsigned char lds_dyn[];
__device__ __noinline__ void grid_sync(unsigned* barw, unsigned x) {
    XcdBarrier b; b.bar = barw; b.x = x; b.st = (volatile LAS unsigned*)((LAS unsigned char*)lds_dyn + MISC_OFF) + 8;
    xcd_barrier(b);
#if PROBE_FN == 99
    xcd_barrier(b);
#endif
}
template <int KIND>
__device__ __forceinline__ void phase_fn(unsigned char* ws, int l) {
    asm volatile("" : "+s"(ws));
    Frame F; frame_init(F, lds_dyn);
    run_phase<KIND>(F, ws, l);
#ifdef PROBE_REP_KIND
    if constexpr (KIND == PROBE_REP_KIND) { __syncthreads(); run_phase<KIND>(F, ws, l); }
#endif
}
__global__ void __launch_bounds__(512, 2) trunk_fwd(Args a) {
    LAS unsigned char* lds = (LAS unsigned char*)lds_dyn;
    volatile LAS unsigned* MISC = (volatile LAS unsigned*)(lds + MISC_OFF);
    if (threadIdx.x < 32) MISC[threadIdx.x] = 0u;
    __syncthreads();
    unsigned char* ws = a.ws;
    XcdBarrier bar = xcd_barrier_post((unsigned*)(ws + WS_CTL) + CW_BAR, MISC + 8);
    phase_fn<0>(ws, 0); grid_sync(bar.bar, bar.x);
#pragma unroll
    for (int l = 0; l < DEPTH; ++l) {
        if (l == 0) { phase_fn<1>(ws, l); grid_sync(bar.bar, bar.x); }
        phase_fn<2>(ws, l); grid_sync(bar.bar, bar.x);
        phase_fn<3>(ws, l); grid_sync(bar.bar, bar.x);
        phase_fn<5>(ws, l); grid_sync(bar.bar, bar.x);
        phase_fn<6>(ws, l); grid_sync(bar.bar, bar.x);
        phase_fn<7>(ws, l); grid_sync(bar.bar, bar.x);
        phase_fn<8>(ws, l); grid_sync(bar.bar, bar.x);
        phase_fn<9>(ws, l); grid_sync(bar.bar, bar.x);
        phase_fn<10>(ws, l); grid_sync(bar.bar, bar.x);
        phase_fn<11>(ws, l); if (l + 1 < DEPTH) grid_sync(bar.bar, bar.x);
    }
}
#endif

template <class KF> static bool prep_kernel(KF kf) {
    if (hipFuncSetAttribute((const void*)kf, hipFuncAttributeMaxDynamicSharedMemorySize, LDS_BYTES) != hipSuccess) { fprintf(stderr, "kernel_launch: hipFuncSetAttribute failed\n"); return false; }
    return true;
}
extern "C" void kernel_launch(void* const* d_in, const int* in_sizes, int n_in, void* d_out, int out_size, void* d_ws, size_t ws_size, hipStream_t stream) {
    static int grid = 0;
    if (grid == 0) {
        if (n_in != 26 || out_size != T * D || ws_size < WS_END) { fprintf(stderr, "kernel_launch: unexpected problem (n_in %d, out %d, ws %zu, need %zu)\n", n_in, out_size, ws_size, (size_t)WS_END); grid = -1; return; }
        int dev = 0, cus = 0;
        if (hipGetDevice(&dev) != hipSuccess || hipDeviceGetAttribute(&cus, hipDeviceAttributeMultiprocessorCount, dev) != hipSuccess) { grid = -1; return; }
        bool ok = true;
#if MK_ONE_LAUNCH
        ok = prep_kernel(trunk_fwd);
        int per_cu = 0;
        if (hipOccupancyMaxActiveBlocksPerMultiprocessor(&per_cu, (const void*)trunk_fwd, 512, LDS_BYTES) != hipSuccess || per_cu < 1) { fprintf(stderr, "kernel_launch: occupancy query says %d\n", per_cu); }
#else
        ok = prep_kernel(k_phase<0>) && prep_kernel(k_phase<1>) && prep_kernel(k_phase<2>) && prep_kernel(k_phase<3>) && prep_kernel(k_phase<4>) && prep_kernel(k_phase<5>) && prep_kernel(k_phase<6>)
          && prep_kernel(k_phase<7>) && prep_kernel(k_phase<8>) && prep_kernel(k_phase<9>) && prep_kernel(k_phase<10>) && prep_kernel(k_phase<11>);
#endif
        (void)hipGetLastError();
        if (!ok) { grid = -1; return; }
        grid = cus;
    }
    if (grid < 0) return;
    (void)hipMemsetAsync((char*)d_ws + WS_CTL, 0, CTL_ZERO_BYTES, stream);
    Args a{};
    for (int i = 0; i < 26; ++i) a.in[i] = d_in[i];
    a.out = (float*)d_out; a.ws = (unsigned char*)d_ws; a.layer = 0; a.pad = 0;
#if MK_ONE_LAUNCH
    hipLaunchKernelGGL(trunk_fwd, dim3(grid), dim3(512), LDS_BYTES, stream, a);
#else
    hipLaunchKernelGGL(k_phase<0>, dim3(grid), dim3(512), LDS_BYTES, stream, a);
    for (int l = 0; l < DEPTH; ++l) { a.layer = l;
        hipLaunchKernelGGL(k_phase<1>, dim3(grid), dim3(512), LDS_BYTES, stream, a);
        hipLaunchKernelGGL(k_phase<2>, dim3(grid), dim3(512), LDS_BYTES, stream, a);
        hipLaunchKernelGGL(k_phase<3>, dim3(grid), dim3(512), LDS_BYTES, stream, a);
        hipLaunchKernelGGL(k_phase<5>, dim3(grid), dim3(512), LDS_BYTES, stream, a);
        hipLaunchKernelGGL(k_phase<6>, dim3(grid), dim3(512), LDS_BYTES, stream, a);
        hipLaunchKernelGGL(k_phase<7>, dim3(grid), dim3(512), LDS_BYTES, stream, a);
        hipLaunchKernelGGL(k_phase<8>, dim3(grid), dim3(512), LDS_BYTES, stream, a);
        hipLaunchKernelGGL(k_phase<9>, dim3(grid), dim3(512), LDS_BYTES, stream, a);
        hipLaunchKernelGGL(k_phase<10>, dim3(grid), dim3(512), LDS_BYTES, stream, a);
        hipLaunchKernelGGL(k_phase<11>, dim3(grid), dim3(512), LDS_BYTES, stream, a);
    }
#endif
}
```
